# Optimizing an MI355X kernel written in HIP

```python
import math
import jax, jax.numpy as jnp
from jax import lax
import numpy as np

D_MODEL = 1024
BATCH = 4
SEQ = 8192
DEPTH = 1

ATT_WIDTH = D_MODEL // 2
HEAD_DIM = 64
N_ATT_HEADS = ATT_WIDTH // HEAD_DIM
SSM_WIDTH = D_MODEL - ATT_WIDTH
SSM_GROUP = 16
N_SSM_GROUPS = SSM_WIDTH // SSM_GROUP
SSM_STATE = 64
MIX_WIDTH = ATT_WIDTH + SSM_WIDTH
DILATED_PATTERNS = ((128, 1), (512, 4), (2048, 16))
ATT_BLOCK = 128
N_BUCKETS = 32
MAX_DISTANCE = 2048
N_EXPERTS = 256
TOP_K = 8
N_EXPERT_GROUPS = 8
TOPK_GROUPS = 4
EXPERT_FF = 256
SHARED_FF = 256
ROUTED_SCALE = 2.5
MOE_BLOCK = 128
ALPHA = (2 * DEPTH) ** 0.25
BETA = (8 * DEPTH) ** -0.25
EPS = 1e-5
NEG_INF = -1e30

kernel_name = 'hybrid_dilated_s5_moe_block'


def layer_norm(x, g, b):
    xf = x.astype(jnp.float32)
    mu = jnp.mean(xf, -1, keepdims=True)
    var = jnp.mean(jnp.square(xf - mu), -1, keepdims=True)
    return ((xf - mu) * lax.rsqrt(var + EPS) * g + b).astype(x.dtype)


def rms_norm(x, g):
    xf = x.astype(jnp.float32)
    return (xf * lax.rsqrt(jnp.mean(jnp.square(xf), -1, keepdims=True) + EPS) * g).astype(x.dtype)


def t5_bucket(dist):
    exact = N_BUCKETS // 2
    large = exact + (jnp.log(jnp.maximum(dist, 1).astype(jnp.float32) / exact)
                     / math.log(MAX_DISTANCE / exact) * (N_BUCKETS - exact)).astype(jnp.int32)
    return jnp.where(dist < exact, dist, jnp.minimum(large, N_BUCKETS - 1))


def dilated_window_pattern(q, k, v, rel_bias, window, dilation):
    bsz, seq, heads, hd = q.shape
    n_strided = seq // dilation
    n_blocks = -(-n_strided // ATT_BLOCK)
    padded = n_blocks * ATT_BLOCK

    def strided_blocks(t):
        t = t.reshape(bsz, n_strided, dilation, heads, hd)
        t = jnp.pad(t, ((0, 0), (0, padded - n_strided), (0, 0), (0, 0), (0, 0)))
        return t.reshape(bsz, n_blocks, ATT_BLOCK, dilation, heads, hd)

    def with_previous(t):
        prev = jnp.pad(t[:, :-1], ((0, 0), (1, 0), (0, 0), (0, 0), (0, 0), (0, 0)))
        return jnp.concatenate([prev, t], axis=2)

    qb = strided_blocks(q)
    kb = with_previous(strided_blocks(k))
    vb = with_previous(strided_blocks(v))
    qi = jnp.arange(ATT_BLOCK)[:, None]
    ki = jnp.arange(2 * ATT_BLOCK)[None, :]
    rel = qi + ATT_BLOCK - ki
    band = (rel >= 0) & (rel <= window // dilation)
    key_ok = (jnp.arange(n_blocks)[:, None] * ATT_BLOCK - ATT_BLOCK + ki) >= 0
    mask = band[None] & key_ok[:, None, :]
    bias = jnp.transpose(rel_bias[t5_bucket(jnp.maximum(rel, 0) * dilation)], (2, 0, 1)).astype(jnp.float32)
    s = jnp.einsum('bnqrhd,bnkrhd->bnrhqk', qb, kb).astype(jnp.float32) * HEAD_DIM ** -0.5 + bias
    s = jnp.where(mask[None, :, None, None], s, NEG_INF)
    m = jnp.max(s, -1, keepdims=True)
    p = jnp.exp(s - m)
    l = jnp.sum(p, -1)
    o = jnp.einsum('bnrhqk,bnkrhd->bnqrhd', p, vb.astype(jnp.float32))
    l_t = jnp.transpose(l, (0, 1, 4, 2, 3))
    o = o / l_t[..., None]
    lse = jnp.transpose(m[..., 0], (0, 1, 4, 2, 3)) + jnp.log(l_t)
    o = o.reshape(bsz, padded, dilation, heads, hd)[:, :n_strided].reshape(bsz, seq, heads, hd)
    lse = lse.reshape(bsz, padded, dilation, heads)[:, :n_strided].reshape(bsz, seq, heads)
    return o, lse


def dilated_attention(q, k, v, rel_bias):
    outs, lses = zip(*[dilated_window_pattern(q, k, v, rel_bias, w, d) for w, d in DILATED_PATTERNS])
    wts = jax.nn.softmax(jnp.stack(lses), axis=0)
    return jnp.sum(wts[..., None] * jnp.stack(outs), axis=0)


def s5_layer(u, a_re, a_im, b_re, b_im, c_re, c_im, d_skip, log_dt, w_glu, b_glu):
    bsz, seq, _ = u.shape
    f32 = jnp.float32
    uf = u.astype(f32).reshape(bsz, seq, N_SSM_GROUPS, SSM_GROUP)
    a = lax.complex(a_re.astype(f32), a_im.astype(f32))
    dt = jnp.exp(log_dt.astype(f32))[:, None]
    a_bar = jnp.exp(dt * a)
    b_bar = ((a_bar - 1.0) / a)[:, :, None] * lax.complex(b_re.astype(f32), b_im.astype(f32))
    c_mat = lax.complex(c_re.astype(f32), c_im.astype(f32))
    bu = jnp.einsum('bsgc,gpc->bsgp', uf.astype(jnp.complex64), b_bar)
    decay = jnp.broadcast_to(a_bar, bu.shape)

    def combine(e1, e2):
        a1, h1 = e1
        a2, h2 = e2
        return a1 * a2, a2 * h1 + h2

    _, state = lax.associative_scan(combine, (decay, bu), axis=1)
    y = jnp.einsum('bsgp,gcp->bsgc', state, c_mat).real + d_skip.astype(f32) * uf
    y = jax.nn.gelu(y.reshape(bsz, seq, SSM_WIDTH))
    y = y * jax.nn.sigmoid(y @ w_glu.astype(f32) + b_glu.astype(f32))
    return y.astype(u.dtype)


def parallel_mixer(h, w_in, rel_bias, a_re, a_im, b_re, b_im, c_re, c_im, d_skip, log_dt,
                   w_glu, b_glu, g_att, g_ssm, w_out):
    bsz, seq, _ = h.shape
    proj = h @ w_in
    q, k, v, u = jnp.split(proj, [ATT_WIDTH, 2 * ATT_WIDTH, 3 * ATT_WIDTH], axis=-1)
    heads = lambda t: t.reshape(bsz, seq, N_ATT_HEADS, HEAD_DIM)
    att = dilated_attention(heads(q), heads(k), heads(v), rel_bias).reshape(bsz, seq, ATT_WIDTH).astype(h.dtype)
    ssm = s5_layer(u, a_re, a_im, b_re, b_im, c_re, c_im, d_skip, log_dt, w_glu, b_glu)
    merged = jnp.concatenate([rms_norm(att, g_att), rms_norm(ssm, g_ssm)], axis=-1)
    return merged @ w_out


def moe_ffn(h, w_router, router_bias, w_e_gate, w_e_up, w_e_down, w_s_gate, w_s_up, w_s_down):
    bsz, seq, d = h.shape
    n_tok = bsz * seq
    xt = h.reshape(n_tok, d)
    scores = jax.nn.sigmoid((xt @ w_router).astype(jnp.float32))
    biased = scores + router_bias.astype(jnp.float32)
    grouped = biased.reshape(n_tok, N_EXPERT_GROUPS, N_EXPERTS // N_EXPERT_GROUPS)
    group_score = jnp.sum(lax.top_k(grouped, 2)[0], -1)
    _, top_groups = lax.top_k(group_score, TOPK_GROUPS)
    group_ok = jnp.any(top_groups[:, :, None] == jnp.arange(N_EXPERT_GROUPS)[None, None, :], axis=1)
    masked = jnp.where(group_ok[:, :, None], grouped, -jnp.inf).reshape(n_tok, N_EXPERTS)
    _, expert_idx = lax.top_k(masked, TOP_K)
    gate = jnp.take_along_axis(scores, expert_idx, axis=1)
    gate = gate / jnp.sum(gate, -1, keepdims=True) * ROUTED_SCALE
    n_assign = n_tok * TOP_K
    flat_e = expert_idx.reshape(-1)
    order = jnp.argsort(flat_e)
    sorted_e = flat_e[order]
    sorted_tok = (order // TOP_K).astype(jnp.int32)
    sorted_gate = gate.reshape(-1)[order]
    counts = jnp.bincount(flat_e, length=N_EXPERTS)
    padded_counts = (counts + MOE_BLOCK - 1) // MOE_BLOCK * MOE_BLOCK
    padded_end = jnp.cumsum(padded_counts)
    padded_start = padded_end - padded_counts
    start = jnp.cumsum(counts) - counts
    dest = padded_start[sorted_e] + jnp.arange(n_assign) - start[sorted_e]
    n_blocks = -(-n_assign // MOE_BLOCK) + N_EXPERTS
    n_rows = n_blocks * MOE_BLOCK
    row_tok = jnp.full((n_rows,), n_tok, jnp.int32).at[dest].set(sorted_tok)
    row_gate = jnp.zeros((n_rows,), jnp.float32).at[dest].set(sorted_gate)
    block_expert = jnp.minimum(jnp.searchsorted(padded_end, jnp.arange(n_blocks) * MOE_BLOCK, side='right'),
                               N_EXPERTS - 1)
    x_pad = jnp.concatenate([xt, jnp.zeros((1, d), xt.dtype)], axis=0)

    def expert_block(args):
        rows, g, e = args
        xb = x_pad[rows]
        hid = jax.nn.silu(xb @ w_e_gate[e]) * (xb @ w_e_up[e])
        return (hid @ w_e_down[e]) * g[:, None].astype(xb.dtype)

    routed = lax.map(expert_block, (row_tok.reshape(n_blocks, MOE_BLOCK),
                                    row_gate.reshape(n_blocks, MOE_BLOCK), block_expert))
    routed = jax.ops.segment_sum(routed.reshape(n_rows, d), row_tok, num_segments=n_tok + 1)[:n_tok]
    shared = (jax.nn.silu(xt @ w_s_gate) * (xt @ w_s_up)) @ w_s_down
    return (routed + shared).reshape(bsz, seq, d)


def setup_inputs(seed: int = 0) -> dict:
    key = jax.random.key(seed)
    ks = jax.random.split(key, 32)
    f32 = jnp.float32

    def nrm(k, shape, scale):
        return jax.random.normal(k, shape, f32) * scale

    L, G, P, GC = DEPTH, N_SSM_GROUPS, SSM_STATE, SSM_GROUP
    n_idx = jnp.arange(P, dtype=f32)
    return {
        'x': nrm(ks[0], (BATCH, SEQ, D_MODEL), 1.0),
        'c': nrm(ks[1], (BATCH, D_MODEL), 1.0),
        'rel_bias': nrm(ks[2], (N_BUCKETS, N_ATT_HEADS), 0.5),
        'w_ada': nrm(ks[3], (L, D_MODEL, 6 * D_MODEL), 0.5 * D_MODEL ** -0.5),
        'b_ada': nrm(ks[4], (L, 6 * D_MODEL), 0.02),
        'w_in': nrm(ks[5], (L, D_MODEL, 3 * ATT_WIDTH + SSM_WIDTH), D_MODEL ** -0.5),
        'ssm_a_re': -0.5 + nrm(ks[6], (L, G, P), 0.01),
        'ssm_a_im': math.pi * n_idx + nrm(ks[7], (L, G, P), 0.01),
        'ssm_b_re': nrm(ks[8], (L, G, P, GC), (2 * GC) ** -0.5),
        'ssm_b_im': nrm(ks[9], (L, G, P, GC), (2 * GC) ** -0.5),
        'ssm_c_re': nrm(ks[10], (L, G, GC, P), (2 * P) ** -0.5),
        'ssm_c_im': nrm(ks[11], (L, G, GC, P), (2 * P) ** -0.5),
        'ssm_d': nrm(ks[12], (L, G, GC), 0.5),
        'ssm_log_dt': jax.random.uniform(ks[13], (L, G), f32, math.log(0.001), math.log(0.1)),
        'w_glu': nrm(ks[14], (L, SSM_WIDTH, SSM_WIDTH), SSM_WIDTH ** -0.5),
        'b_glu': nrm(ks[15], (L, SSM_WIDTH), 0.02),
        'g_att': 1.0 + nrm(ks[16], (L, ATT_WIDTH), 0.02),
        'g_ssm': 1.0 + nrm(ks[17], (L, SSM_WIDTH), 0.02),
        'w_out': nrm(ks[18], (L, MIX_WIDTH, D_MODEL), BETA * MIX_WIDTH ** -0.5),
        'ln1_g': 1.0 + nrm(ks[19], (L, D_MODEL), 0.02),
        'ln1_b': nrm(ks[20], (L, D_MODEL), 0.02),
        'w_router': nrm(ks[21], (L, D_MODEL, N_EXPERTS), D_MODEL ** -0.5),
        'router_bias': nrm(ks[22], (L, N_EXPERTS), 0.01),
        'w_e_gate': nrm(ks[23], (L, N_EXPERTS, D_MODEL, EXPERT_FF), D_MODEL ** -0.5),
        'w_e_up': nrm(ks[24], (L, N_EXPERTS, D_MODEL, EXPERT_FF), D_MODEL ** -0.5),
        'w_e_down': nrm(ks[25], (L, N_EXPERTS, EXPERT_FF, D_MODEL), BETA * EXPERT_FF ** -0.5),
        'w_s_gate': nrm(ks[26], (L, D_MODEL, SHARED_FF), D_MODEL ** -0.5),
        'w_s_up': nrm(ks[27], (L, D_MODEL, SHARED_FF), D_MODEL ** -0.5),
        'w_s_down': nrm(ks[28], (L, SHARED_FF, D_MODEL), BETA * SHARED_FF ** -0.5),
        'ln2_g': 1.0 + nrm(ks[29], (L, D_MODEL), 0.02),
        'ln2_b': nrm(ks[30], (L, D_MODEL), 0.02),
    }


def reference(x, c, rel_bias, w_ada, b_ada, w_in, ssm_a_re, ssm_a_im, ssm_b_re, ssm_b_im,
              ssm_c_re, ssm_c_im, ssm_d, ssm_log_dt, w_glu, b_glu, g_att, g_ssm, w_out,
              ln1_g, ln1_b, w_router, router_bias, w_e_gate, w_e_up, w_e_down,
              w_s_gate, w_s_up, w_s_down, ln2_g, ln2_b):
    for layer in range(DEPTH):
        ada = jax.nn.silu(c) @ w_ada[layer] + b_ada[layer]
        shift1, scale1, gate1, shift2, scale2, gate2 = jnp.split(ada[:, None, :], 6, axis=-1)
        h = x * (1.0 + scale1) + shift1
        mix = parallel_mixer(h, w_in[layer], rel_bias, ssm_a_re[layer], ssm_a_im[layer],
                             ssm_b_re[layer], ssm_b_im[layer], ssm_c_re[layer], ssm_c_im[layer],
                             ssm_d[layer], ssm_log_dt[layer], w_glu[layer], b_glu[layer],
                             g_att[layer], g_ssm[layer], w_out[layer])
        x = layer_norm(ALPHA * x + gate1 * mix, ln1_g[layer], ln1_b[layer])
        h = x * (1.0 + scale2) + shift2
        ffn = moe_ffn(h, w_router[layer], router_bias[layer], w_e_gate[layer], w_e_up[layer],
                      w_e_down[layer], w_s_gate[layer], w_s_up[layer], w_s_down[layer])
        x = layer_norm(ALPHA * x + gate2 * ffn, ln2_g[layer], ln2_b[layer])
    return x
```

```cpp
#include <hip/hip_runtime.h>
#include <hip/hip_cooperative_groups.h>
#include <cstdio>
#include <cstdint>
namespace cg = cooperative_groups;

#ifndef FUSED
#define FUSED 0
#endif

#define DI __device__ __forceinline__
typedef unsigned short bf16_t;
typedef short bf16x8 __attribute__((ext_vector_type(8)));
typedef float f32x2 __attribute__((ext_vector_type(2)));
typedef float f32x4 __attribute__((ext_vector_type(4)));
typedef float f32x16 __attribute__((ext_vector_type(16)));
typedef unsigned u32x2 __attribute__((ext_vector_type(2)));
typedef unsigned u32x4 __attribute__((ext_vector_type(4)));
typedef __bf16 bf16v2 __attribute__((ext_vector_type(2)));

#define MFMA16(a, b, c) __builtin_amdgcn_mfma_f32_16x16x32_bf16((a), (b), (c), 0, 0, 0)
#define MFMA32(a, b, c) __builtin_amdgcn_mfma_f32_32x32x16_bf16((a), (b), (c), 0, 0, 0)
#define LDS_FENCE() asm volatile("s_waitcnt lgkmcnt(0)" ::: "memory")

constexpr int D = 1024, BATCH = 4, SEQ = 8192, T = BATCH * SEQ, NPROJ = 2048;
constexpr int NTHR = 512;
constexpr int NEXP = 256, TOPK = 8;
constexpr float ALPHA = 1.189207115002721f;
constexpr float EPS = 1e-5f;
constexpr float NEG = -1e30f;

constexpr size_t MiB = 1u << 20;
constexpr size_t WS_CNT = 0;
constexpr size_t WS_ADA = 64 * 1024;
constexpr size_t WS_ABAR = 192 * 1024;
constexpr size_t WS_ABARL = 208 * 1024;
constexpr size_t WS_BCAT = 256 * 1024;
constexpr size_t WS_CCAT = 384 * 1024;
constexpr size_t WS_WIN = 2 * MiB;
constexpr size_t WS_WGLU = 6 * MiB;
constexpr size_t WS_WR = 6 * MiB + 512 * 1024;
constexpr size_t WS_WOUT = 7 * MiB;
constexpr size_t WS_WSGU = 9 * MiB;
constexpr size_t WS_WSD = 10 * MiB;
constexpr size_t WS_EGATE = 11 * MiB;
constexpr size_t WS_HID = 13 * MiB;
constexpr size_t WS_BINS = 29 * MiB;
constexpr size_t WS_H2 = 61 * MiB;
constexpr size_t WS_WEGU = 125 * MiB;
constexpr size_t WS_WED = 381 * MiB;
constexpr size_t WS_SLOT = 509 * MiB;
constexpr size_t WS_QKVU = 509 * MiB;
constexpr size_t WS_MERGED = 637 * MiB;
constexpr size_t WS_YGL = 701 * MiB;
constexpr size_t WS_SCORES = 733 * MiB;
constexpr size_t WS_E = 765 * MiB;
constexpr size_t WS_END = 1021 * MiB;

constexpr int LDP = 72;
constexpr int GEMM_LDS = (128 + 256) * LDP * 2;
constexpr int MISC_OFF = 57344;
constexpr int SSM_WAVE_LDS = 32 * 132 * 4;
constexpr int CIN_OFF = 8 * SSM_WAVE_LDS;
constexpr int LDS_BYTES = 148 * 1024;

struct Params {
    const float *x, *c, *rel_bias, *w_ada, *b_ada, *w_in, *a_re, *a_im, *b_re, *b_im, *c_re, *c_im, *ssm_d, *log_dt, *w_glu, *b_glu, *g_att, *g_ssm, *w_out,
        *ln1_g, *ln1_b, *w_router, *router_bias, *w_e_gate, *w_e_up, *w_e_down, *w_s_gate, *w_s_up, *w_s_down, *ln2_g, *ln2_b;
    float* out;
    unsigned char* ws;
};

DI unsigned pk2(float a, float b) { f32x2 f = {a, b}; bf16v2 r = __builtin_convertvector(f, bf16v2); return __builtin_bit_cast(unsigned, r); }
DI bf16_t f2bf(float a) { return (bf16_t)(pk2(a, 0.f) & 0xffffu); }
DI float bflo(unsigned w) { return __uint_as_float(w << 16); }
DI float bfhi(unsigned w) { return __uint_as_float(w & 0xffff0000u); }
DI float sigmoidf_(float x) { return 1.f / (1.f + __expf(-x)); }
DI float siluf_(float x) { return x / (1.f + __expf(-x)); }
DI float gelu_tanh(float x) { const float u = 0.7978845608028654f * (x + 0.044715f * x * x * x); const float e = __expf(2.f * u); const float th = 1.f - 2.f / (e + 1.f); return 0.5f * x * (1.f + th); }
DI float wave_sum(float v) {
#pragma unroll
    for (int o = 1; o < 64; o <<= 1) v += __shfl_xor(v, o);
    return v;
}

struct ALoadBf16 {
    const bf16_t *p0, *p1; bool v0, v1; u32x4 r0, r1;
    DI void issue(int k) { r0 = v0 ? *(const u32x4*)(p0 + k) : (u32x4){0u, 0u, 0u, 0u}; r1 = v1 ? *(const u32x4*)(p1 + k) : (u32x4){0u, 0u, 0u, 0u}; }
    DI void finish(u32x4 (&ra)[2]) { ra[0] = r0; ra[1] = r1; }
};
struct ALoadX {
    const float *p0, *p1, *sc, *sh; f32x4 a0, a1, b0, b1, s0, s1, h0, h1;
    DI void issue(int k) {
        a0 = *(const f32x4*)(p0 + k); a1 = *(const f32x4*)(p0 + k + 4); b0 = *(const f32x4*)(p1 + k); b1 = *(const f32x4*)(p1 + k + 4);
        s0 = *(const f32x4*)(sc + k); s1 = *(const f32x4*)(sc + k + 4); h0 = *(const f32x4*)(sh + k); h1 = *(const f32x4*)(sh + k + 4);
    }
    DI void finish(u32x4 (&ra)[2]) {
        const f32x4 x0 = a0 * (1.f + s0) + h0, x1 = a1 * (1.f + s1) + h1, y0 = b0 * (1.f + s0) + h0, y1 = b1 * (1.f + s1) + h1;
        ra[0] = (u32x4){pk2(x0[0], x0[1]), pk2(x0[2], x0[3]), pk2(x1[0], x1[1]), pk2(x1[2], x1[3])};
        ra[1] = (u32x4){pk2(y0[0], y0[1]), pk2(y0[2], y0[3]), pk2(y1[0], y1[1]), pk2(y1[2], y1[3])};
    }
};
struct ALoadMerged {
    const bf16_t *p0, *p1; const float *gatt, *gssm; float rsa0, rsa1, rss0, rss1; u32x4 r0, r1; f32x4 g0, g1; float q0, q1;
    DI void issue(int k) {
        r0 = *(const u32x4*)(p0 + k); r1 = *(const u32x4*)(p1 + k);
        const float* g = (k < 512) ? (gatt + k) : (gssm + (k - 512));
        g0 = *(const f32x4*)g; g1 = *(const f32x4*)(g + 4);
        q0 = (k < 512) ? rsa0 : rss0; q1 = (k < 512) ? rsa1 : rss1;
    }
    DI void finish(u32x4 (&ra)[2]) {
#pragma unroll
        for (int i = 0; i < 2; ++i) {
            const u32x4 r = i ? r1 : r0; const float q = i ? q1 : q0;
            ra[i] = (u32x4){pk2(bflo(r[0]) * q * g0[0], bfhi(r[0]) * q * g0[1]), pk2(bflo(r[1]) * q * g0[2], bfhi(r[1]) * q * g0[3]),
                            pk2(bflo(r[2]) * q * g1[0], bfhi(r[2]) * q * g1[1]), pk2(bflo(r[3]) * q * g1[2], bfhi(r[3]) * q * g1[3])};
        }
    }
};

template <class AL, class EP>
DI void gemm_tile(char* lds, AL& al, const bf16_t* __restrict__ Bt, const int K, const EP& ep) {
    bf16_t* As = (bf16_t*)lds; bf16_t* Bs = As + 128 * LDP;
    int tid = threadIdx.x; asm volatile("" : "+v"(tid));
    const int lane = tid & 63, wid = tid >> 6, wr = wid >> 2, wc = wid & 3, fr = lane & 15, fq = lane >> 4;
    const int lrow = tid >> 3, lch = tid & 7;
    f32x4 acc[4][4];
#pragma unroll
    for (int m = 0; m < 4; ++m)
#pragma unroll
        for (int n = 0; n < 4; ++n) acc[m][n] = (f32x4){0.f, 0.f, 0.f, 0.f};
    u32x4 ra[2], rb[4];
    const bf16_t* bp = Bt + (size_t)lrow * K + lch * 8;
    const size_t bstep = (size_t)64 * K;
    const int nk = K >> 6;
    al.issue(0);
#pragma unroll
    for (int i = 0; i < 4; ++i) rb[i] = *(const u32x4*)(bp + i * bstep);
    for (int kt = 0; kt < nk; ++kt) {
        al.finish(ra);
        __syncthreads();
#pragma unroll
        for (int i = 0; i < 2; ++i) *(u32x4*)(As + (lrow + 64 * i) * LDP + lch * 8) = ra[i];
#pragma unroll
        for (int i = 0; i < 4; ++i) *(u32x4*)(Bs + (lrow + 64 * i) * LDP + lch * 8) = rb[i];
        __syncthreads();
        if (kt + 1 < nk) {
            al.issue((kt + 1) * 64);
#pragma unroll
            for (int i = 0; i < 4; ++i) rb[i] = *(const u32x4*)(bp + i * bstep + (kt + 1) * 64);
        }
#pragma unroll
        for (int ks = 0; ks < 2; ++ks) {
            bf16x8 af[4], bq[4];
#pragma unroll
            for (int m = 0; m < 4; ++m) af[m] = *(const bf16x8*)(As + (wr * 64 + m * 16 + fr) * LDP + ks * 32 + fq * 8);
#pragma unroll
            for (int n = 0; n < 4; ++n) bq[n] = *(const bf16x8*)(Bs + (wc * 64 + n * 16 + fr) * LDP + ks * 32 + fq * 8);
#pragma unroll
            for (int m = 0; m < 4; ++m)
#pragma unroll
                for (int n = 0; n < 4; ++n) acc[m][n] = MFMA16(bq[n], af[m], acc[m][n]);
        }
    }
    ep(acc, wr * 64 + fr, wc * 64 + fq * 4, wc);
}

struct EpiBf16 {
    bf16_t* O; int ld;
    DI void operator()(const f32x4 (&acc)[4][4], int r0, int c0, int) const {
#pragma unroll
        for (int m = 0; m < 4; ++m)
#pragma unroll
            for (int n = 0; n < 4; ++n) { const f32x4 v = acc[m][n]; *(u32x2*)(O + (size_t)(r0 + 16 * m) * ld + c0 + 16 * n) = (u32x2){pk2(v[0], v[1]), pk2(v[2], v[3])}; }
    }
};
struct EpiGlu {
    const bf16_t* ygl; bf16_t* O; const float* bias; float* psq; int pn;
    DI void operator()(const f32x4 (&acc)[4][4], int r0, int c0, int wc) const {
        const int fq = (threadIdx.x & 63) >> 4;
#pragma unroll
        for (int m = 0; m < 4; ++m) {
            const int row = r0 + 16 * m; float ss = 0.f;
#pragma unroll
            for (int n = 0; n < 4; ++n) {
                const int col = c0 + 16 * n; const f32x4 z = acc[m][n] + *(const f32x4*)(bias + col);
                const u32x2 yw = *(const u32x2*)(ygl + (size_t)row * 512 + col);
                const float o0 = bflo(yw[0]) * sigmoidf_(z[0]), o1 = bfhi(yw[0]) * sigmoidf_(z[1]), o2 = bflo(yw[1]) * sigmoidf_(z[2]), o3 = bfhi(yw[1]) * sigmoidf_(z[3]);
                ss += o0 * o0 + o1 * o1 + o2 * o2 + o3 * o3;
                *(u32x2*)(O + (size_t)row * 1024 + col) = (u32x2){pk2(o0, o1), pk2(o2, o3)};
            }
            ss += __shfl_xor(ss, 16); ss += __shfl_xor(ss, 32);
            if (fq == 0) psq[row * 8 + pn * 4 + wc] = ss;
            asm volatile("" ::: "memory");
        }
    }
};
struct EpiOutProj {
    const float* xp; float* vout; const float* gate;
    DI void operator()(const f32x4 (&acc)[4][4], int r0, int c0, int) const {
        f32x4 g[4];
#pragma unroll
        for (int n = 0; n < 4; ++n) g[n] = *(const f32x4*)(gate + c0 + 16 * n);
#pragma unroll
        for (int m = 0; m < 4; ++m) {
            const size_t o = (size_t)(r0 + 16 * m) * 1024 + c0; f32x4 xv[4];
#pragma unroll
            for (int n = 0; n < 4; ++n) xv[n] = *(const f32x4*)(xp + o + 16 * n);
#pragma unroll
            for (int n = 0; n < 4; ++n) *(f32x4*)(vout + o + 16 * n) = ALPHA * xv[n] + g[n] * acc[m][n];
            asm volatile("" ::: "memory");
        }
    }
};
struct EpiSigmoidF32 {
    float* O;
    DI void operator()(const f32x4 (&acc)[4][4], int r0, int c0, int) const {
#pragma unroll
        for (int m = 0; m < 4; ++m)
#pragma unroll
            for (int n = 0; n < 4; ++n) { const f32x4 v = acc[m][n]; *(f32x4*)(O + (size_t)(r0 + 16 * m) * 256 + c0 + 16 * n) = (f32x4){sigmoidf_(v[0]), sigmoidf_(v[1]), sigmoidf_(v[2]), sigmoidf_(v[3])}; }
    }
};
struct EpiSiluMul {
    bf16_t* H; int cb;
    DI void operator()(const f32x4 (&acc)[4][4], int r0, int c0, int wc) const {
        const int fq = (threadIdx.x & 63) >> 4;
#pragma unroll
        for (int m = 0; m < 4; ++m)
#pragma unroll
            for (int n = 0; n < 2; ++n) {
                const f32x4 g = acc[m][n], u = acc[m][n + 2];
                *(u32x2*)(H + (size_t)(r0 + 16 * m) * 256 + 128 * cb + 32 * wc + 16 * n + 4 * fq) = (u32x2){pk2(siluf_(g[0]) * u[0], siluf_(g[1]) * u[1]), pk2(siluf_(g[2]) * u[2], siluf_(g[3]) * u[3])};
            }
    }
};
struct EpiSharedDown {
    float* io; const float* gate;
    DI void operator()(const f32x4 (&acc)[4][4], int r0, int c0, int) const {
        f32x4 g[4];
#pragma unroll
        for (int n = 0; n < 4; ++n) g[n] = *(const f32x4*)(gate + c0 + 16 * n);
#pragma unroll
        for (int m = 0; m < 4; ++m) {
            float* p = io + (size_t)(r0 + 16 * m) * 1024 + c0; f32x4 xv[4];
#pragma unroll
            for (int n = 0; n < 4; ++n) xv[n] = *(const f32x4*)(p + 16 * n);
#pragma unroll
            for (int n = 0; n < 4; ++n) *(f32x4*)(p + 16 * n) = ALPHA * xv[n] + g[n] * acc[m][n];
            asm volatile("" ::: "memory");
        }
    }
};
struct EpiExpertDown {
    bf16_t* slot; const int* rowslot; const float* rowgate; int coff;
    DI void operator()(const f32x4 (&acc)[4][4], int r0, int c0, int) const {
#pragma unroll
        for (int m = 0; m < 4; ++m) {
            const int row = r0 + 16 * m; const int s = rowslot[row]; const float g = rowgate[row];
            if (s >= 0) {
#pragma unroll
                for (int n = 0; n < 4; ++n) { const f32x4 v = acc[m][n] * g; *(u32x2*)(slot + (size_t)s * 1024 + coff + c0 + 16 * n) = (u32x2){pk2(v[0], v[1]), pk2(v[2], v[3])}; }
            }
        }
    }
};

DI void sincos_d(double ang, double& s, double& c) {
    const double r = ang * 0.63661977236758134308; const double q = __builtin_rint(r);
    const double y = (ang - q * 1.57079632679489655800) - q * 6.12323399573676603587e-17;
    const double y2 = y * y;
    double sp = -1.0 / 1307674368000.0; sp = sp * y2 + 1.0 / 6227020800.0; sp = sp * y2 - 1.0 / 39916800.0; sp = sp * y2 + 1.0 / 362880.0; sp = sp * y2 - 1.0 / 5040.0; sp = sp * y2 + 1.0 / 120.0; sp = sp * y2 - 1.0 / 6.0; sp = sp * y2 + 1.0;
    const double sy = y * sp;
    double cp = 1.0 / 87178291200.0; cp = cp * y2 - 1.0 / 479001600.0; cp = cp * y2 + 1.0 / 3628800.0; cp = cp * y2 - 1.0 / 40320.0; cp = cp * y2 + 1.0 / 720.0; cp = cp * y2 - 1.0 / 24.0; cp = cp * y2 + 0.5; const double cy = 1.0 - y2 * cp;
    const int qi = ((int)q) & 3;
    s = (qi == 0) ? sy : (qi == 1) ? cy : (qi == 2) ? -sy : -cy;
    c = (qi == 0) ? cy : (qi == 1) ? -sy : (qi == 2) ? -cy : sy;
}
DI void ssm_tables(const Params& P, int g, int p) {
    float* ABAR = (float*)(P.ws + WS_ABAR); float* ABARL = (float*)(P.ws + WS_ABARL); bf16_t* BCAT = (bf16_t*)(P.ws + WS_BCAT); bf16_t* CCAT = (bf16_t*)(P.ws + WS_CCAT);
    const double dt = (double)expf(P.log_dt[g]);
    const double ar = P.a_re[g * 64 + p], ai = P.a_im[g * 64 + p];
    double sn, cs; sincos_d(dt * ai, sn, cs);
    const double mag = (double)expf((float)(dt * ar));
    const double abr = mag * cs, abi = mag * sn;
    ABAR[g * 128 + p] = (float)abr; ABAR[g * 128 + 64 + p] = (float)abi;
    double snL, csL; sincos_d(128.0 * dt * ai, snL, csL);
    const double magL = (double)expf((float)(128.0 * dt * ar));
    ABARL[g * 128 + p] = (float)(magL * csL); ABARL[g * 128 + 64 + p] = (float)(magL * snL);
    const double xr = abr - 1.0, xi = abi, den = ar * ar + ai * ai;
    const double qr = (xr * ar + xi * ai) / den, qi = (xi * ar - xr * ai) / den;
    for (int c = 0; c < 16; ++c) {
        const double br = P.b_re[(g * 64 + p) * 16 + c], bi = P.b_im[(g * 64 + p) * 16 + c];
        BCAT[(g * 128 + p) * 16 + c] = f2bf((float)(qr * br - qi * bi));
        BCAT[(g * 128 + 64 + p) * 16 + c] = f2bf((float)(qr * bi + qi * br));
        CCAT[(g * 16 + c) * 128 + p] = f2bf(P.c_re[(g * 16 + c) * 64 + p]);
        CCAT[(g * 16 + c) * 128 + 64 + p] = f2bf(-P.c_im[(g * 16 + c) * 64 + p]);
    }
}
DI void ada_item(const Params& P, char* lds, int item) {
    float* red = (float*)lds; const int tid = threadIdx.x, lane = tid & 63, wid = tid >> 6;
    const int n = item * 64 + lane, k0 = wid * 128;
    float a0 = 0.f, a1 = 0.f, a2 = 0.f, a3 = 0.f;
#pragma unroll 8
    for (int k = k0; k < k0 + 128; ++k) {
        const float w = P.w_ada[(size_t)k * 6144 + n];
        a0 += siluf_(P.c[k]) * w; a1 += siluf_(P.c[1024 + k]) * w; a2 += siluf_(P.c[2048 + k]) * w; a3 += siluf_(P.c[3072 + k]) * w;
    }
    red[(wid * 4 + 0) * 64 + lane] = a0; red[(wid * 4 + 1) * 64 + lane] = a1; red[(wid * 4 + 2) * 64 + lane] = a2; red[(wid * 4 + 3) * 64 + lane] = a3;
    __syncthreads();
    if (tid < 256) {
        const int b = tid >> 6, l = tid & 63; float s = 0.f;
#pragma unroll
        for (int w = 0; w < 8; ++w) s += red[(w * 4 + b) * 64 + l];
        ((float*)(P.ws + WS_ADA))[b * 6144 + item * 64 + l] = s + P.b_ada[item * 64 + l];
    }
    __syncthreads();
}
DI void tr_item(const float* __restrict__ W, int K, int N, bf16_t* __restrict__ WT, int item, float* scr, int lane, int mode, int s, bool qscale) {
    const int nblk = N >> 5, kb = item / nblk, nb = item % nblk, k0 = 64 * kb, n0 = 32 * nb;
#pragma unroll 8
    for (int i = 0; i < 32; ++i) { const int kk = 2 * i + (lane >> 5); scr[kk * 33 + (lane & 31)] = W[(size_t)(k0 + kk) * N + n0 + (lane & 31)]; }
    LDS_FENCE();
    const int c = lane & 7; const float sc = (qscale && n0 < 512) ? 0.125f : 1.f;
#pragma unroll
    for (int j = 0; j < 4; ++j) {
        const int n = (lane >> 3) + 8 * j; const float* sp = scr + (8 * c) * 33 + n;
        const u32x4 o = (u32x4){pk2(sp[0] * sc, sp[33] * sc), pk2(sp[66] * sc, sp[99] * sc), pk2(sp[132] * sc, sp[165] * sc), pk2(sp[198] * sc, sp[231] * sc)};
        const int nn = n0 + n; const int drow = mode ? (64 * (nn >> 5) + 32 * s + (nn & 31)) : nn;
        *(u32x4*)(WT + (size_t)drow * K + k0 + 8 * c) = o;
    }
    LDS_FENCE();
}
DI void p0_prologue(const Params& P, char* lds) {
    const int tid = threadIdx.x, lane = tid & 63, wid = tid >> 6, G = gridDim.x;
    if (blockIdx.x == 0 && tid < 256) ((int*)(P.ws + WS_CNT))[tid] = 0;
    { const int gt = blockIdx.x * NTHR + tid; if (gt < 2048) ssm_tables(P, gt >> 6, gt & 63); }
    for (int item = blockIdx.x; item < 96; item += G) ada_item(P, lds, item);
    float* scr = (float*)(lds + wid * 8448);
    const int gw = blockIdx.x * 8 + wid, NGW = G * 8;
    constexpr int I_IN = 1024, I_GLU = 128, I_OUT = 512, I_R = 128, I_SG = 128, I_SU = 128, I_SD = 128, I_SMALL = I_IN + I_GLU + I_OUT + I_R + I_SG + I_SU + I_SD;
    constexpr int I_EXP = 3 * 256 * 128;
    for (int it = gw; it < I_SMALL + I_EXP; it += NGW) {
        int r = it;
        if (r < I_IN) { tr_item(P.w_in, 1024, 2048, (bf16_t*)(P.ws + WS_WIN), r, scr, lane, 0, 0, true); continue; } r -= I_IN;
        if (r < I_GLU) { tr_item(P.w_glu, 512, 512, (bf16_t*)(P.ws + WS_WGLU), r, scr, lane, 0, 0, false); continue; } r -= I_GLU;
        if (r < I_OUT) { tr_item(P.w_out, 1024, 1024, (bf16_t*)(P.ws + WS_WOUT), r, scr, lane, 0, 0, false); continue; } r -= I_OUT;
        if (r < I_R) { tr_item(P.w_router, 1024, 256, (bf16_t*)(P.ws + WS_WR), r, scr, lane, 0, 0, false); continue; } r -= I_R;
        if (r < I_SG) { tr_item(P.w_s_gate, 1024, 256, (bf16_t*)(P.ws + WS_WSGU), r, scr, lane, 1, 0, false); continue; } r -= I_SG;
        if (r < I_SU) { tr_item(P.w_s_up, 1024, 256, (bf16_t*)(P.ws + WS_WSGU), r, scr, lane, 1, 1, false); continue; } r -= I_SU;
        if (r < I_SD) { tr_item(P.w_s_down, 256, 1024, (bf16_t*)(P.ws + WS_WSD), r, scr, lane, 0, 0, false); continue; } r -= I_SD;
        const int kind = r / 32768, e = (r % 32768) >> 7, sub = r & 127;
        if (kind == 0) tr_item(P.w_e_gate + (size_t)e * 262144, 1024, 256, (bf16_t*)(P.ws + WS_WEGU) + (size_t)e * 524288, sub, scr, lane, 1, 0, false);
        else if (kind == 1) tr_item(P.w_e_up + (size_t)e * 262144, 1024, 256, (bf16_t*)(P.ws + WS_WEGU) + (size_t)e * 524288, sub, scr, lane, 1, 1, false);
        else tr_item(P.w_e_down + (size_t)e * 262144, 256, 1024, (bf16_t*)(P.ws + WS_WED) + (size_t)e * 262144, sub, scr, lane, 0, 0, false);
    }
}

DI void p1_inproj(const Params& P, char* lds) {
    const int tid = threadIdx.x, lrow = tid >> 3, lch = tid & 7, G = gridDim.x;
    const float* ADA = (const float*)(P.ws + WS_ADA);
    for (int pm = blockIdx.x; pm < 256; pm += G) {
        const int b = pm >> 6;
        for (int pn = 0; pn < 8; ++pn) {
            ALoadX al; al.p0 = P.x + (size_t)(pm * 128 + lrow) * 1024 + lch * 8; al.p1 = al.p0 + 64 * 1024; al.sc = ADA + b * 6144 + 1024 + lch * 8; al.sh = ADA + b * 6144 + lch * 8;
            EpiBf16 ep{(bf16_t*)(P.ws + WS_QKVU) + (size_t)(pm * 128) * NPROJ + pn * 256, NPROJ};
            gemm_tile(lds, al, (const bf16_t*)(P.ws + WS_WIN) + (size_t)(pn * 256) * 1024, 1024, ep);
        }
    }
}

DI int t5_bucket(int dist) {
    if (dist < 16) return dist;
    const float v = logf((float)dist / 16.0f) / 4.852030263919617f * 16.0f;
    int l = 16 + (int)v; return l < 31 ? l : 31;
}
DI void attn_unit(const Params& P, char* lds, int unit) {
    int tid = threadIdx.x; asm volatile("" : "+v"(tid));
    const int lane = tid & 63, wid = __builtin_amdgcn_readfirstlane(tid >> 6), c = lane & 31, hh = lane >> 5;
    const int b = unit >> 8, qb = (unit >> 3) & 31, h = unit & 7, t0 = qb * 256;
    float* st = (float*)lds;
    float* bt = st + 256 * 68;
    bf16_t* vsw = (bf16_t*)(bt + 3 * 132) + wid * (32 * LDP);
    const bf16_t* qkv = (const bf16_t*)(P.ws + WS_QKVU) + (size_t)(b * SEQ) * NPROJ;
    for (int i = tid; i < 3 * 129; i += NTHR) { const int p = i / 129, j = i % 129; const int dist = j << (2 * p); bt[p * 132 + j] = P.rel_bias[t5_bucket(dist) * 8 + h]; }
    __syncthreads();
    for (int p = 0; p < 3; ++p) {
        const int ntask = (p == 2) ? 2 : 1;
        for (int ti = 0; ti < ntask; ++ti) {
            int d, r, lqb;
            if (p == 0) { d = 1; r = 0; lqb = 32 * wid; } else if (p == 1) { d = 4; r = wid >> 1; lqb = 32 * (wid & 1); } else { d = 16; r = 2 * wid + ti; lqb = 0; }
            const float* btp = bt + p * 132;
            const int qidx = d * (lqb + c) + r; const bool qvalid = qidx < 256; const int qic = qvalid ? qidx : 255;
            bf16x8 qf[4];
            { const bf16_t* qrow = qkv + (size_t)(t0 + qic) * NPROJ + h * 64 + 8 * hh;
#pragma unroll
              for (int s = 0; s < 4; ++s) qf[s] = *(const bf16x8*)(qrow + 16 * s); }
            float m = NEG, l = 0.f; f32x16 o0, o1;
#pragma unroll
            for (int i = 0; i < 16; ++i) { o0[i] = 0.f; o1[i] = 0.f; }
            if (p > 0 && qvalid) {
                const float* sp = st + qidx * 68; m = sp[64]; l = hh ? 0.f : sp[65];
#pragma unroll
                for (int g = 0; g < 4; ++g) { const f32x4 a = *(const f32x4*)(sp + 8 * g + 4 * hh), bb = *(const f32x4*)(sp + 32 + 8 * g + 4 * hh);
                    o0[4 * g] = a[0]; o0[4 * g + 1] = a[1]; o0[4 * g + 2] = a[2]; o0[4 * g + 3] = a[3]; o1[4 * g] = bb[0]; o1[4 * g + 1] = bb[1]; o1[4 * g + 2] = bb[2]; o1[4 * g + 3] = bb[3]; }
            }
            for (int ch = 0; ch < 5; ++ch) {
                const int lk0 = lqb - 128 + 32 * ch;
                if (t0 + d * (lk0 + 31) + r < 0) continue;
                int tk = t0 + d * (lk0 + c) + r; tk = tk < 0 ? 0 : (tk > SEQ - 1 ? SEQ - 1 : tk);
                const bf16_t* krow = qkv + (size_t)tk * NPROJ + 512 + h * 64 + 8 * hh;
                bf16x8 kf[4];
#pragma unroll
                for (int s = 0; s < 4; ++s) kf[s] = *(const bf16x8*)(krow + 16 * s);
                const bf16_t* vrow = qkv + (size_t)tk * NPROJ + 1024 + h * 64 + 32 * hh;
                bf16x8 vv[4];
#pragma unroll
                for (int i = 0; i < 4; ++i) vv[i] = *(const bf16x8*)(vrow + 8 * i);
                f32x16 sa;
#pragma unroll
                for (int i = 0; i < 16; ++i) sa[i] = 0.f;
#pragma unroll
                for (int s = 0; s < 4; ++s) sa = MFMA32(kf[s], qf[s], sa);
                LDS_FENCE();
#pragma unroll
                for (int i = 0; i < 4; ++i) *(bf16x8*)(vsw + c * LDP + 32 * hh + 8 * i) = vv[i];
                float sc[16]; float mx = NEG;
#pragma unroll
                for (int i = 0; i < 16; ++i) {
                    const int kr = (i & 3) + 8 * (i >> 2) + 4 * hh; const int j = c + 128 - 32 * ch - kr;
                    const bool ok = (j >= 0) && (j <= 128) && (t0 + d * (lk0 + kr) + r >= 0);
                    const int jc = j < 0 ? 0 : (j > 128 ? 128 : j);
                    const float v = ok ? sa[i] + btp[jc] : NEG; sc[i] = v; mx = fmaxf(mx, v);
                }
                mx = fmaxf(mx, __shfl_xor(mx, 32));
                const float mn = fmaxf(m, mx), alpha = __expf(m - mn); m = mn;
                float ps = 0.f;
#pragma unroll
                for (int i = 0; i < 16; ++i) { sc[i] = __expf(sc[i] - mn); ps += sc[i]; }
                l = l * alpha + ps;
#pragma unroll
                for (int i = 0; i < 16; ++i) { o0[i] *= alpha; o1[i] *= alpha; }
                LDS_FENCE();
#pragma unroll
                for (int s = 0; s < 2; ++s) {
                    const u32x4 pw = (u32x4){pk2(sc[8 * s], sc[8 * s + 1]), pk2(sc[8 * s + 2], sc[8 * s + 3]), pk2(sc[8 * s + 4], sc[8 * s + 5]), pk2(sc[8 * s + 6], sc[8 * s + 7])};
                    const bf16x8 pf = __builtin_bit_cast(bf16x8, pw);
#pragma unroll
                    for (int dt = 0; dt < 2; ++dt) {
                        bf16x8 vf;
#pragma unroll
                        for (int j = 0; j < 8; ++j) { const int key = 16 * s + 8 * (j >> 2) + 4 * hh + (j & 3); vf[j] = (short)vsw[key * LDP + 32 * dt + c]; }
                        if (dt == 0) o0 = MFMA32(vf, pf, o0); else o1 = MFMA32(vf, pf, o1);
                    }
                }
            }
            l += __shfl_xor(l, 32);
            if (qvalid) {
                float* sp = st + qidx * 68;
                if (hh == 0) { sp[64] = m; sp[65] = l; }
#pragma unroll
                for (int g = 0; g < 4; ++g) { *(f32x4*)(sp + 8 * g + 4 * hh) = (f32x4){o0[4 * g], o0[4 * g + 1], o0[4 * g + 2], o0[4 * g + 3]}; *(f32x4*)(sp + 32 + 8 * g + 4 * hh) = (f32x4){o1[4 * g], o1[4 * g + 1], o1[4 * g + 2], o1[4 * g + 3]}; }
            }
        }
        __syncthreads();
    }
    {
        const int q = tid >> 1, half = tid & 1; const float* sp = st + q * 68; const float inv = 1.f / sp[65];
        bf16_t* op = (bf16_t*)(P.ws + WS_MERGED) + (size_t)(b * SEQ + t0 + q) * 1024 + h * 64 + 32 * half;
#pragma unroll
        for (int i = 0; i < 4; ++i) { const f32x4 a = *(const f32x4*)(sp + 32 * half + 8 * i), bb = *(const f32x4*)(sp + 32 * half + 8 * i + 4);
            *(u32x4*)(op + 8 * i) = (u32x4){pk2(a[0] * inv, a[1] * inv), pk2(a[2] * inv, a[3] * inv), pk2(bb[0] * inv, bb[1] * inv), pk2(bb[2] * inv, bb[3] * inv)}; }
    }
    __syncthreads();
}

template <bool FINAL>
DI void ssm_task(const Params& P, float* buf, int b, int k, int g, int lane, float s_re, float s_im) {
    const int c32 = lane & 31, hh = lane >> 5, fr = lane & 15, fq = lane >> 4;
    const float* ABAR = (const float*)(P.ws + WS_ABAR);
    const float a_re = ABAR[g * 128 + lane], a_im = ABAR[g * 128 + 64 + lane];
    bf16x8 bq[4];
#pragma unroll
    for (int tau = 0; tau < 4; ++tau) bq[tau] = *(const bf16x8*)((const bf16_t*)(P.ws + WS_BCAT) + (size_t)(g * 128 + 32 * tau + c32) * 16 + 8 * hh);
    bf16x8 cq[4]; f32x4 dsk = (f32x4){0.f, 0.f, 0.f, 0.f};
    if (FINAL) {
#pragma unroll
        for (int s = 0; s < 4; ++s) cq[s] = *(const bf16x8*)((const bf16_t*)(P.ws + WS_CCAT) + (size_t)(g * 16 + fr) * 128 + 32 * s + 8 * fq);
        dsk = *(const f32x4*)(P.ssm_d + g * 16 + 4 * fq);
    }
    const bf16_t* ubase = (const bf16_t*)(P.ws + WS_QKVU) + (size_t)(b * SEQ + k * 128) * NPROJ + 1536 + 16 * g;
    for (int sub = 0; sub < 4; ++sub) {
        const bf16x8 uf = *(const bf16x8*)(ubase + (size_t)(32 * sub + c32) * NPROJ + 8 * hh);
        LDS_FENCE();
#pragma unroll
        for (int tau = 0; tau < 4; ++tau) {
            f32x16 z;
#pragma unroll
            for (int i = 0; i < 16; ++i) z[i] = 0.f;
            z = MFMA32(uf, bq[tau], z);
#pragma unroll
            for (int i = 0; i < 16; ++i) buf[((i & 3) + 8 * (i >> 2) + 4 * hh) * 132 + 32 * tau + c32] = z[i];
        }
        LDS_FENCE();
#pragma unroll 4
        for (int t = 0; t < 32; ++t) {
            const float re = buf[t * 132 + lane], im = buf[t * 132 + 64 + lane];
            const float nr = a_re * s_re - a_im * s_im + re, ni = a_re * s_im + a_im * s_re + im; s_re = nr; s_im = ni;
            if (FINAL) { bf16_t* sb = (bf16_t*)(buf + t * 132); sb[lane] = f2bf(s_re); sb[64 + lane] = f2bf(s_im); }
        }
        if (FINAL) {
            LDS_FENCE();
#pragma unroll
            for (int tt = 0; tt < 2; ++tt) {
                f32x4 y = (f32x4){0.f, 0.f, 0.f, 0.f};
#pragma unroll
                for (int s = 0; s < 4; ++s) { const bf16x8 sf = *(const bf16x8*)((const bf16_t*)(buf + (16 * tt + fr) * 132) + 32 * s + 8 * fq); y = MFMA16(cq[s], sf, y); }
                const int tl = 32 * sub + 16 * tt + fr;
                const u32x2 uw = *(const u32x2*)(ubase + (size_t)tl * NPROJ + 4 * fq);
                const float v0 = gelu_tanh(y[0] + dsk[0] * bflo(uw[0])), v1 = gelu_tanh(y[1] + dsk[1] * bfhi(uw[0])), v2 = gelu_tanh(y[2] + dsk[2] * bflo(uw[1])), v3 = gelu_tanh(y[3] + dsk[3] * bfhi(uw[1]));
                *(u32x2*)((bf16_t*)(P.ws + WS_YGL) + (size_t)(b * SEQ + k * 128 + tl) * 512 + 16 * g + 4 * fq) = (u32x2){pk2(v0, v1), pk2(v2, v3)};
            }
        }
    }
    if (!FINAL) { float* E = (float*)(P.ws + WS_E) + (size_t)((b * 64 + k) * 32 + g) * 128; E[lane] = s_re; E[64 + lane] = s_im; }
    LDS_FENCE();
}

DI void p2_mixer(const Params& P, char* lds) {
    const int tid = threadIdx.x, lane = tid & 63, wid = tid >> 6, G = gridDim.x;
    for (int item = blockIdx.x; item < 2048; item += G) {
        if (item < 1024) attn_unit(P, lds, item);
        else { const int wt = (item - 1024) * 8 + wid; ssm_task<false>(P, (float*)(lds + wid * SSM_WAVE_LDS), wt >> 11, (wt >> 5) & 63, wt & 31, lane, 0.f, 0.f); __syncthreads(); }
    }
}

DI void route_token(const float* srow, const float* rbias, int lane, int& e_out, float& g_out) {
    const f32x4 s4 = *(const f32x4*)(srow + 4 * lane); const f32x4 rb = *(const f32x4*)(rbias + 4 * lane);
    float w0 = s4[0] + rb[0], w1 = s4[1] + rb[1], w2 = s4[2] + rb[2], w3 = s4[3] + rb[3];
    float m1, m2;
    { const float a = fmaxf(w0, w1), bb = fminf(w0, w1), cc = fmaxf(w2, w3), dd = fminf(w2, w3); m1 = fmaxf(a, cc); m2 = fmaxf(fminf(a, cc), fmaxf(bb, dd)); }
#pragma unroll
    for (int off = 1; off < 8; off <<= 1) { const float o1 = __shfl_xor(m1, off), o2 = __shfl_xor(m2, off); const float n1 = fmaxf(m1, o1), n2 = fmaxf(fminf(m1, o1), fmaxf(m2, o2)); m1 = n1; m2 = n2; }
    const float gs = m1 + m2; const int mygrp = lane >> 3; int rank = 0;
#pragma unroll
    for (int j = 0; j < 8; ++j) { const float gj = __shfl(gs, 8 * j); rank += ((gj > gs) || (gj == gs && j < mygrp)) ? 1 : 0; }
    const float NINF = -__builtin_inff();
    if (rank >= 4) { w0 = NINF; w1 = NINF; w2 = NINF; w3 = NINF; }
    int my_e = 0; float my_s = 0.f;
#pragma unroll 1
    for (int k = 0; k < TOPK; ++k) {
        float bv = w0; int bi = 0;
        if (w1 > bv) { bv = w1; bi = 1; } if (w2 > bv) { bv = w2; bi = 2; } if (w3 > bv) { bv = w3; bi = 3; }
        int idx = 4 * lane + bi;
#pragma unroll
        for (int off = 32; off >= 1; off >>= 1) { const float ov = __shfl_xor(bv, off); const int oi = __shfl_xor(idx, off); if (ov > bv || (ov == bv && oi < idx)) { bv = ov; idx = oi; } }
        const int owner = idx >> 2, sub = idx & 3;
        const float mys = sub == 0 ? s4[0] : (sub == 1 ? s4[1] : (sub == 2 ? s4[2] : s4[3]));
        const float sval = __shfl(mys, owner);
        if (lane == owner) { if (sub == 0) w0 = NINF; else if (sub == 1) w1 = NINF; else if (sub == 2) w2 = NINF; else w3 = NINF; }
        if (lane == k) { my_e = idx; my_s = sval; }
    }
    float sum = (lane < 8) ? my_s : 0.f;
    sum += __shfl_xor(sum, 1); sum += __shfl_xor(sum, 2); sum += __shfl_xor(sum, 4);
    e_out = my_e; g_out = my_s / sum * 2.5f;
}

DI void p3_panel(const Params& P, char* lds, int pm) {
    int tid = threadIdx.x; asm volatile("" : "+v"(tid));
    const int lane = tid & 63, wid = __builtin_amdgcn_readfirstlane(tid >> 6), lrow = tid >> 3, lch = tid & 7;
    const int b = pm >> 6, kch = pm & 63, row0 = pm * 128;
    const float* ADA = (const float*)(P.ws + WS_ADA) + b * 6144;
    float* misc = (float*)(lds + MISC_OFF);
    float* rs_att = misc; float* rs_ssm = misc + 128; float* psq = misc + 256;
    int* hist = (int*)(misc + 1280); int* base = hist + 256; int* hist2 = base + 256; int* rt_e = hist2 + 256; float* rt_g = (float*)(rt_e + 1024);
    bf16_t* MERGED = (bf16_t*)(P.ws + WS_MERGED) + (size_t)row0 * 1024;
    bf16_t* YGL = (bf16_t*)(P.ws + WS_YGL) + (size_t)row0 * 512;
    bf16_t* H2 = (bf16_t*)(P.ws + WS_H2) + (size_t)row0 * 1024;
    bf16_t* HID = (bf16_t*)(P.ws + WS_HID) + (size_t)blockIdx.x * (128 * 256);
    float* SC = (float*)(P.ws + WS_SCORES) + (size_t)row0 * 256;
    float* vrow0 = P.out + (size_t)row0 * 1024;

    {
        const float* ABARL = (const float*)(P.ws + WS_ABARL); const float* E = (const float*)(P.ws + WS_E);
        float cr[4], ci[4], lr[4], li[4];
#pragma unroll
        for (int i = 0; i < 4; ++i) { const int g = wid + 8 * i; cr[i] = 0.f; ci[i] = 0.f; lr[i] = ABARL[g * 128 + lane]; li[i] = ABARL[g * 128 + 64 + lane]; }
        for (int k0 = 0; k0 < kch; k0 += 4) {
            float er[4][4], ei[4][4];
#pragma unroll
            for (int j = 0; j < 4; ++j)
#pragma unroll
                for (int i = 0; i < 4; ++i) {
                    const int kk = k0 + j; const bool ok = kk < kch; const float* ep = E + (size_t)((b * 64 + (ok ? kk : 0)) * 32 + wid + 8 * i) * 128;
                    er[j][i] = ok ? ep[lane] : 0.f; ei[j][i] = ok ? ep[64 + lane] : 0.f;
                }
#pragma unroll
            for (int j = 0; j < 4; ++j)
                if (k0 + j < kch) {
#pragma unroll
                    for (int i = 0; i < 4; ++i) { const float nr = lr[i] * cr[i] - li[i] * ci[i] + er[j][i], ni = lr[i] * ci[i] + li[i] * cr[i] + ei[j][i]; cr[i] = nr; ci[i] = ni; }
                }
        }
        float* cst = (float*)(lds + CIN_OFF) + wid * 512;
#pragma unroll
        for (int i = 0; i < 4; ++i) { cst[i * 128 + lane] = cr[i]; cst[i * 128 + 64 + lane] = ci[i]; }
        LDS_FENCE();
#pragma unroll 1
        for (int i = 0; i < 4; ++i) ssm_task<true>(P, (float*)(lds + wid * SSM_WAVE_LDS), b, kch, wid + 8 * i, lane, cst[i * 128 + lane], cst[i * 128 + 64 + lane]);
    }
    __syncthreads();
    for (int r = wid * 16; r < wid * 16 + 16; ++r) {
        const u32x4 w = *(const u32x4*)(MERGED + (size_t)r * 1024 + lane * 8); float ss = 0.f;
#pragma unroll
        for (int i = 0; i < 4; ++i) { const float a = bflo(w[i]), bb = bfhi(w[i]); ss += a * a + bb * bb; }
        ss = wave_sum(ss); if (lane == 0) rs_att[r] = rsqrtf(ss * (1.f / 512.f) + EPS);
    }
    for (int pn = 0; pn < 2; ++pn) {
        ALoadBf16 al; al.p0 = YGL + (size_t)lrow * 512 + lch * 8; al.p1 = al.p0 + 64 * 512; al.v0 = true; al.v1 = true;
        EpiGlu ep{YGL + pn * 256, MERGED + 512 + pn * 256, P.b_glu + pn * 256, psq, pn};
        gemm_tile(lds, al, (const bf16_t*)(P.ws + WS_WGLU) + (size_t)(pn * 256) * 512, 512, ep);
    }
    __syncthreads();
    if (tid < 128) { float s = 0.f;
#pragma unroll
        for (int i = 0; i < 8; ++i) s += psq[tid * 8 + i];
        rs_ssm[tid] = rsqrtf(s * (1.f / 512.f) + EPS); }
    __syncthreads();
    for (int pn = 0; pn < 4; ++pn) {
        ALoadMerged al; al.p0 = MERGED + (size_t)lrow * 1024 + lch * 8; al.p1 = al.p0 + 64 * 1024; al.gatt = P.g_att + lch * 8; al.gssm = P.g_ssm + lch * 8;
        al.rsa0 = rs_att[lrow]; al.rsa1 = rs_att[lrow + 64]; al.rss0 = rs_ssm[lrow]; al.rss1 = rs_ssm[lrow + 64];
        EpiOutProj ep{P.x + (size_t)row0 * 1024 + pn * 256, vrow0 + pn * 256, ADA + 2048 + pn * 256};
        gemm_tile(lds, al, (const bf16_t*)(P.ws + WS_WOUT) + (size_t)(pn * 256) * 1024, 1024, ep);
    }
    __syncthreads();
    for (int r = wid * 16; r < wid * 16 + 16; ++r) {
        float* vp = vrow0 + (size_t)r * 1024 + 4 * lane; f32x4 v[4]; float s = 0.f;
#pragma unroll
        for (int j = 0; j < 4; ++j) { v[j] = *(const f32x4*)(vp + 256 * j); s += (v[j][0] + v[j][1]) + (v[j][2] + v[j][3]); }
        const float mean = wave_sum(s) * (1.f / 1024.f); float q = 0.f;
#pragma unroll
        for (int j = 0; j < 4; ++j) { v[j] = v[j] - mean; q += (v[j][0] * v[j][0] + v[j][1] * v[j][1]) + (v[j][2] * v[j][2] + v[j][3] * v[j][3]); }
        const float rstd = rsqrtf(wave_sum(q) * (1.f / 1024.f) + EPS);
#pragma unroll
        for (int j = 0; j < 4; ++j) {
            const int col = 4 * lane + 256 * j;
            const f32x4 x1 = v[j] * rstd * *(const f32x4*)(P.ln1_g + col) + *(const f32x4*)(P.ln1_b + col);
            *(f32x4*)(vp + 256 * j) = x1;
            const f32x4 hv = x1 * (1.f + *(const f32x4*)(ADA + 4096 + col)) + *(const f32x4*)(ADA + 3072 + col);
            *(u32x2*)(H2 + (size_t)r * 1024 + col) = (u32x2){pk2(hv[0], hv[1]), pk2(hv[2], hv[3])};
        }
    }
    if (tid < 256) hist[tid] = 0;
    __syncthreads();
    {
        ALoadBf16 al; al.p0 = H2 + (size_t)lrow * 1024 + lch * 8; al.p1 = al.p0 + 64 * 1024; al.v0 = true; al.v1 = true;
        EpiSigmoidF32 ep{SC};
        gemm_tile(lds, al, (const bf16_t*)(P.ws + WS_WR), 1024, ep);
    }
    __syncthreads();
    for (int tl = wid * 16; tl < wid * 16 + 16; ++tl) {
        int e; float gte; route_token(SC + (size_t)tl * 256, P.router_bias, lane, e, gte);
        if (lane < 8) { rt_e[tl * 8 + lane] = e; rt_g[tl * 8 + lane] = gte; atomicAdd(&hist[e], 1); }
    }
    __syncthreads();
    if (tid < 256) { const int cnt = hist[tid]; base[tid] = cnt ? atomicAdd((int*)(P.ws + WS_CNT) + tid, cnt) : 0; hist2[tid] = 0; }
    __syncthreads();
    for (int a = tid; a < 1024; a += NTHR) {
        const int e = rt_e[a]; const int pos = base[e] + atomicAdd(&hist2[e], 1); const int slot = (row0 + (a >> 3)) * 8 + (a & 7);
        ((int*)(P.ws + WS_BINS))[(size_t)e * T + pos] = slot; ((float*)(P.ws + WS_EGATE))[slot] = rt_g[a];
    }
    for (int cb = 0; cb < 2; ++cb) {
        ALoadBf16 al; al.p0 = H2 + (size_t)lrow * 1024 + lch * 8; al.p1 = al.p0 + 64 * 1024; al.v0 = true; al.v1 = true;
        EpiSiluMul ep{HID, cb};
        gemm_tile(lds, al, (const bf16_t*)(P.ws + WS_WSGU) + (size_t)(cb * 256) * 1024, 1024, ep);
    }
    __syncthreads();
    for (int pn = 0; pn < 4; ++pn) {
        ALoadBf16 al; al.p0 = HID + (size_t)lrow * 256 + lch * 8; al.p1 = al.p0 + 64 * 256; al.v0 = true; al.v1 = true;
        EpiSharedDown ep{vrow0 + pn * 256, ADA + 5120 + pn * 256};
        gemm_tile(lds, al, (const bf16_t*)(P.ws + WS_WSD) + (size_t)(pn * 256) * 256, 256, ep);
    }
    __syncthreads();
}
DI void p3_panels(const Params& P, char* lds) { for (int pm = blockIdx.x; pm < 256; pm += gridDim.x) p3_panel(P, lds, pm); }

DI void p5_experts(const Params& P, char* lds) {
    int tid = threadIdx.x; asm volatile("" : "+v"(tid));
    const int lrow = tid >> 3, lch = tid & 7, G = gridDim.x;
    int* tstart = (int*)(lds + MISC_OFF); int* rowslot = tstart + 260; float* rowgate = (float*)(rowslot + 128);
    const int* gcount = (const int*)(P.ws + WS_CNT);
    if (tid == 0) { int s = 0; for (int e = 0; e < NEXP; ++e) { tstart[e] = s; s += (gcount[e] + 127) >> 7; } tstart[NEXP] = s; }
    __syncthreads();
    const int ntiles = tstart[NEXP];
    const int vb = (G % 8 == 0) ? (int)(blockIdx.x % 8) * (G / 8) + (int)(blockIdx.x / 8) : (int)blockIdx.x;
    bf16_t* HID = (bf16_t*)(P.ws + WS_HID) + (size_t)blockIdx.x * (128 * 256);
    const bf16_t* H2 = (const bf16_t*)(P.ws + WS_H2);
    for (int tile = vb; tile < ntiles; tile += G) {
        int lo = 0, hi = NEXP;
        while (hi - lo > 1) { const int mid = (lo + hi) >> 1; if (tstart[mid] <= tile) lo = mid; else hi = mid; }
        const int e = lo, rb = tile - tstart[e]; const int cnt = gcount[e]; const int nvalid = (cnt - rb * 128) < 128 ? (cnt - rb * 128) : 128;
        __syncthreads();
        if (tid < 128) { const int s = tid < nvalid ? ((const int*)(P.ws + WS_BINS))[(size_t)e * T + rb * 128 + tid] : -1; rowslot[tid] = s; rowgate[tid] = s >= 0 ? ((const float*)(P.ws + WS_EGATE))[s] : 0.f; }
        __syncthreads();
        const int s0 = rowslot[lrow], s1 = rowslot[lrow + 64];
        for (int cb = 0; cb < 2; ++cb) {
            ALoadBf16 al; al.v0 = s0 >= 0; al.v1 = s1 >= 0; al.p0 = H2 + (size_t)(al.v0 ? (s0 >> 3) : 0) * 1024 + lch * 8; al.p1 = H2 + (size_t)(al.v1 ? (s1 >> 3) : 0) * 1024 + lch * 8;
            EpiSiluMul ep{HID, cb};
            gemm_tile(lds, al, (const bf16_t*)(P.ws + WS_WEGU) + ((size_t)e * 512 + cb * 256) * 1024, 1024, ep);
        }
        __syncthreads();
        for (int pn = 0; pn < 4; ++pn) {
            ALoadBf16 al; al.p0 = HID + (size_t)lrow * 256 + lch * 8; al.p1 = al.p0 + 64 * 256; al.v0 = true; al.v1 = true;
            EpiExpertDown ep{(bf16_t*)(P.ws + WS_SLOT), rowslot, rowgate, pn * 256};
            gemm_tile(lds, al, (const bf16_t*)(P.ws + WS_WED) + ((size_t)e * 1024 + pn * 256) * 256, 256, ep);
        }
    }
}

DI void p6_combine(const Params& P) {
    const int tid = threadIdx.x, lane = tid & 63, wid = tid >> 6;
    const bf16_t* SLOT = (const bf16_t*)(P.ws + WS_SLOT);
    for (int row = blockIdx.x * 8 + wid; row < T; row += gridDim.x * 8) {
        const float* ADA = (const float*)(P.ws + WS_ADA) + (row >> 13) * 6144 + 5120;
        float f[16];
#pragma unroll
        for (int i = 0; i < 16; ++i) f[i] = 0.f;
#pragma unroll
        for (int s = 0; s < 8; ++s)
#pragma unroll
            for (int j = 0; j < 2; ++j) { const u32x4 w = *(const u32x4*)(SLOT + ((size_t)row * 8 + s) * 1024 + 512 * j + lane * 8);
#pragma unroll
                for (int i = 0; i < 4; ++i) { f[8 * j + 2 * i] += bflo(w[i]); f[8 * j + 2 * i + 1] += bfhi(w[i]); } }
        float* op = P.out + (size_t)row * 1024; float z[16]; float sm = 0.f;
#pragma unroll
        for (int j = 0; j < 2; ++j)
#pragma unroll
            for (int i = 0; i < 2; ++i) { const int col = 512 * j + lane * 8 + 4 * i; const f32x4 zs = *(const f32x4*)(op + col); const f32x4 g = *(const f32x4*)(ADA + col);
#pragma unroll
                for (int q = 0; q < 4; ++q) { const float v = zs[q] + g[q] * f[8 * j + 4 * i + q]; z[8 * j + 4 * i + q] = v; sm += v; } }
        const float mean = wave_sum(sm) * (1.f / 1024.f); float qv = 0.f;
#pragma unroll
        for (int i = 0; i < 16; ++i) { z[i] -= mean; qv += z[i] * z[i]; }
        const float rstd = rsqrtf(wave_sum(qv) * (1.f / 1024.f) + EPS);
#pragma unroll
        for (int j = 0; j < 2; ++j)
#pragma unroll
            for (int i = 0; i < 2; ++i) { const int col = 512 * j + lane * 8 + 4 * i; const f32x4 g = *(const f32x4*)(P.ln2_g + col), bb = *(const f32x4*)(P.ln2_b + col);
                *(f32x4*)(op + col) = (f32x4){z[8 * j + 4 * i] * rstd * g[0] + bb[0], z[8 * j + 4 * i + 1] * rstd * g[1] + bb[1], z[8 * j + 4 * i + 2] * rstd * g[2] + bb[2], z[8 * j + 4 * i + 3] * rstd * g[3] + bb[3]}; }
    }
}

#if FUSED
__global__ void __launch_bounds__(NTHR) fwd_megakernel(Params P) {
    extern __shared__ __attribute__((aligned(16))) char lds[];
    cg::grid_group grid = cg::this_grid();
    p0_prologue(P, lds);
    grid.sync();
    p1_inproj(P, lds);
    grid.sync();
    p2_mixer(P, lds);
    grid.sync();
    p3_panels(P, lds);
    grid.sync();
    p5_experts(P, lds);
    grid.sync();
    p6_combine(P);
}
#else
template <int PH>
__global__ void __launch_bounds__(NTHR) phase_kernel(Params P) {
    extern __shared__ __attribute__((aligned(16))) char lds[];
    if (PH == 0) p0_prologue(P, lds);
    if (PH == 1) p1_inproj(P, lds);
    if (PH == 2) p2_mixer(P, lds);
    if (PH == 3) p3_panels(P, lds);
    if (PH == 5) p5_experts(P, lds);
    if (PH == 6) p6_combine(P);
}
#endif

extern "C" void kernel_launch(void* const* d_in, const int* in_sizes, int n_in, void* d_out, int out_size, void* d_ws, size_t ws_size, hipStream_t stream) {
    static int grid = 0;
    if (grid == 0) {
        if (n_in != 31 || out_size != T * D || ws_size < WS_END) { fprintf(stderr, "kernel_launch: unexpected problem (n_in %d, out %d, ws %zu < %zu)\n", n_in, out_size, ws_size, (size_t)WS_END); grid = -1; return; }
        int dev = 0, cus = 0, per_cu = 0;
        hipGetDevice(&dev); hipDeviceGetAttribute(&cus, hipDeviceAttributeMultiprocessorCount, dev);
#if FUSED
        hipFuncSetAttribute((const void*)fwd_megakernel, hipFuncAttributeMaxDynamicSharedMemorySize, LDS_BYTES);
        hipOccupancyMaxActiveBlocksPerMultiprocessor(&per_cu, (const void*)fwd_megakernel, NTHR, LDS_BYTES);
#else
        hipFuncSetAttribute((const void*)phase_kernel<0>, hipFuncAttributeMaxDynamicSharedMemorySize, LDS_BYTES);
        hipFuncSetAttribute((const void*)phase_kernel<1>, hipFuncAttributeMaxDynamicSharedMemorySize, LDS_BYTES);
        hipFuncSetAttribute((const void*)phase_kernel<2>, hipFuncAttributeMaxDynamicSharedMemorySize, LDS_BYTES);
        hipFuncSetAttribute((const void*)phase_kernel<3>, hipFuncAttributeMaxDynamicSharedMemorySize, LDS_BYTES);
        hipFuncSetAttribute((const void*)phase_kernel<5>, hipFuncAttributeMaxDynamicSharedMemorySize, LDS_BYTES);
        hipFuncSetAttribute((const void*)phase_kernel<6>, hipFuncAttributeMaxDynamicSharedMemorySize, LDS_BYTES);
        per_cu = 1;
#endif
        if (per_cu < 1) { fprintf(stderr, "kernel_launch: occupancy query says %d blocks per CU\n", per_cu); grid = -1; return; }
        grid = cus * 1;
        if (grid > 256) grid = 256;
    }
    if (grid < 0) return;
    Params p{};
    const float** pf = (const float**)&p;
    for (int i = 0; i < 31; ++i) pf[i] = (const float*)d_in[i];
    p.out = (float*)d_out; p.ws = (unsigned char*)d_ws;
#if FUSED
    void* args[] = {&p};
    hipError_t e = hipLaunchCooperativeKernel((const void*)fwd_megakernel, dim3(grid), dim3(NTHR), args, LDS_BYTES, stream);
    if (e != hipSuccess) fprintf(stderr, "cooperative launch failed: %s (grid %d)\n", hipGetErrorString(e), grid);
#else
    hipLaunchKernelGGL(phase_kernel<0>, dim3(grid), dim3(NTHR), LDS_BYTES, stream, p);
    hipLaunchKernelGGL(phase_kernel<1>, dim3(grid), dim3(NTHR), LDS_BYTES, stream, p);
    hipLaunchKernelGGL(phase_kernel<2>, dim3(grid), dim3(NTHR), LDS_BYTES, stream, p);
    hipLaunchKernelGGL(phase_kernel<3>, dim3(grid), dim3(NTHR), LDS_BYTES, stream, p);
    hipLaunchKernelGGL(phase_kernel<5>, dim3(grid), dim3(NTHR), LDS_BYTES, stream, p);
    hipLaunchKernelGGL(phase_kernel<6>, dim3(grid), dim3(NTHR), LDS_BYTES, stream, p);
#endif
}
```

```cpp
#include <hip/hip_runtime.h>
#include <cstdio>
#include <cstdint>

#define DI __device__ __forceinline__
typedef unsigned short bf16_t;
typedef short bf16x8 __attribute__((ext_vector_type(8)));
typedef float f32x2 __attribute__((ext_vector_type(2)));
typedef float f32x4 __attribute__((ext_vector_type(4)));
typedef float f32x16 __attribute__((ext_vector_type(16)));
typedef unsigned u32x2 __attribute__((ext_vector_type(2)));
typedef unsigned u32x4 __attribute__((ext_vector_type(4)));
typedef __bf16 bf16v2 __attribute__((ext_vector_type(2)));

#define MFMA16(a, b, c) __builtin_amdgcn_mfma_f32_16x16x32_bf16((a), (b), (c), 0, 0, 0)
#define MFMA32(a, b, c) __builtin_amdgcn_mfma_f32_32x32x16_bf16((a), (b), (c), 0, 0, 0)
#define LDS_FENCE() asm volatile("s_waitcnt lgkmcnt(0)" ::: "memory")

constexpr int D = 1024, BATCH = 4, SEQ = 8192, T = BATCH * SEQ, NPROJ = 2048;
constexpr int NTHR = 512;
constexpr int NEXP = 256, TOPK = 8;
constexpr float ALPHA = 1.189207115002721f;
constexpr float EPS = 1e-5f;
constexpr float NEG = -1e30f;
constexpr float OUT_SCALE = 64.f;

constexpr size_t MiB = 1u << 20;
constexpr size_t WS_CNT = 0;
constexpr size_t WS_ADACNT = 2048;
constexpr size_t WS_BAR = 16384;
constexpr size_t WS_ADA = 64 * 1024;
constexpr size_t WS_ABAR = 192 * 1024;
constexpr size_t WS_ABARL = 208 * 1024;
constexpr size_t WS_BCAT = 256 * 1024;
constexpr size_t WS_CCAT = 384 * 1024;
constexpr size_t WS_WIN = 2 * MiB;
constexpr size_t WS_WGLU = 6 * MiB;
constexpr size_t WS_WR = 6 * MiB + 512 * 1024;
constexpr size_t WS_WSGU = 7 * MiB;
constexpr size_t WS_WOUT = 8 * MiB;
constexpr size_t WS_WSD = 10 * MiB;
constexpr size_t WS_EIDX = 11 * MiB;
constexpr size_t WS_EPOS = 12 * MiB;
constexpr size_t WS_HIDS = 14 * MiB;
constexpr size_t WS_BINS = 30 * MiB;
constexpr size_t WS_BING = 62 * MiB;
constexpr size_t WS_H2 = 94 * MiB;
constexpr size_t WS_WEGU = 158 * MiB;
constexpr size_t WS_WED = 414 * MiB;
constexpr size_t WS_H1 = 542 * MiB;
constexpr size_t WS_QKVU = 606 * MiB;
constexpr size_t WS_MERGED = 734 * MiB;
constexpr size_t WS_YGL = 798 * MiB;
constexpr size_t WS_SCORES = 830 * MiB;
constexpr size_t WS_E = 862 * MiB;
constexpr size_t WS_ATTSQ = 866 * MiB;
constexpr size_t WS_SSQ = 867 * MiB;
constexpr size_t WS_RS = 868 * MiB;
constexpr size_t WS_HIDALL = 542 * MiB;
constexpr size_t WS_OUTA = 158 * MiB;
constexpr size_t WS_OUTB = 670 * MiB;
constexpr size_t WS_XZ = 926 * MiB;
constexpr size_t WS_END = 1022 * MiB;

constexpr int LDP = 72;
constexpr int GEMM_LDS = (128 + 256) * LDP * 2;
constexpr int MISC_OFF = 57344;
constexpr int SSM_PITCH = 36;
constexpr int SSM_WAVE_LDS = 128 * SSM_PITCH * 4;
constexpr int P5TAB_OFF = 131072;
constexpr int BARLDS_OFF = 148 * 1024;
constexpr int LDS_BYTES = 148 * 1024 + 64;

struct Params {
    const float *x, *c, *rel_bias, *w_ada, *b_ada, *w_in, *a_re, *a_im, *b_re, *b_im, *c_re, *c_im, *ssm_d, *log_dt, *w_glu, *b_glu, *g_att, *g_ssm, *w_out,
        *ln1_g, *ln1_b, *w_router, *router_bias, *w_e_gate, *w_e_up, *w_e_down, *w_s_gate, *w_s_up, *w_s_down, *ln2_g, *ln2_b;
    float* out;
    unsigned char* ws;
};

DI int opaque_tid() { int t = threadIdx.x; asm volatile("" : "+v"(t)); return t; }
DI unsigned pk2(float a, float b) { f32x2 f = {a, b}; bf16v2 r = __builtin_convertvector(f, bf16v2); return __builtin_bit_cast(unsigned, r); }
DI bf16_t f2bf(float a) { return (bf16_t)(pk2(a, 0.f) & 0xffffu); }
DI float bflo(unsigned w) { return __uint_as_float(w << 16); }
DI float bfhi(unsigned w) { return __uint_as_float(w & 0xffff0000u); }
DI float sigmoidf_(float x) { return __builtin_amdgcn_rcpf(1.f + __expf(-x)); }
DI float siluf_(float x) { return x * __builtin_amdgcn_rcpf(1.f + __expf(-x)); }
DI float gelu_tanh(float x) { const float u = 0.7978845608028654f * (x + 0.044715f * x * x * x); const float e = __expf(2.f * u); const float th = 1.f - 2.f * __builtin_amdgcn_rcpf(e + 1.f); return 0.5f * x * (1.f + th); }
template <int CTRL> DI float dppf(float v) { return __builtin_bit_cast(float, __builtin_amdgcn_update_dpp(0, __builtin_bit_cast(int, v), CTRL, 0xF, 0xF, true)); }
DI float rdlane(float v, int l) { return __builtin_bit_cast(float, __builtin_amdgcn_readlane(__builtin_bit_cast(int, v), l)); }
constexpr int DPP_X1 = 0xB1, DPP_X2 = 0x4E, DPP_HM = 0x141, DPP_RM = 0x140;
DI float xsum16(float x) { auto t = __builtin_amdgcn_permlane16_swap(__float_as_uint(x), __float_as_uint(x), false, false); return __uint_as_float(t[0]) + __uint_as_float(t[1]); }
DI float xsum32(float x) { auto t = __builtin_amdgcn_permlane32_swap(__float_as_uint(x), __float_as_uint(x), false, false); return __uint_as_float(t[0]) + __uint_as_float(t[1]); }
DI float xmax32(float x) { auto t = __builtin_amdgcn_permlane32_swap(__float_as_uint(x), __float_as_uint(x), false, false); return fmaxf(__uint_as_float(t[0]), __uint_as_float(t[1])); }
DI float wave_sum(float v) {
    v += dppf<DPP_X1>(v); v += dppf<DPP_X2>(v); v += dppf<DPP_HM>(v); v += dppf<DPP_RM>(v); v = xsum16(v); return xsum32(v);
}

#define LAS __attribute__((address_space(3)))
#define XB_TMO      128
#define XB_XCNT(j)  (256  + 64 * (j))
#define XB_XSUB(j)  (1280 + 64 * (j))
#define XB_XGEN(j)  (2304 + 64 * (j))
#define XB_TOP      3328
#define XB_TOPGEN   3392
#define XB_SPIN_CAP (1u << 18)
DI unsigned xb_ld(unsigned* p) { return __hip_atomic_load(p, __ATOMIC_RELAXED, __HIP_MEMORY_SCOPE_AGENT); }
DI unsigned xb_add(unsigned* p, unsigned v) { return __hip_atomic_fetch_add(p, v, __ATOMIC_RELAXED, __HIP_MEMORY_SCOPE_AGENT); }
DI unsigned xb_xcc_id() { return (unsigned)__builtin_amdgcn_s_getreg((3 << 11) | 20) & 0xFu; }
#define XB_SPIN(cond, bar) do { unsigned _sp = 0; while (cond) { __builtin_amdgcn_s_sleep(1); \
    if ((++_sp & 255u) == 0u) { if (xb_ld(&(bar)[XB_TMO])) break; if (_sp > XB_SPIN_CAP) { atomicAdd(&(bar)[XB_TMO], 1u); break; } } } } while (0)
struct XcdBarrier { unsigned* bar; unsigned x; volatile LAS unsigned* st; };
DI XcdBarrier xcd_barrier_post(unsigned* bar, volatile LAS unsigned* st) {
    XcdBarrier b; b.bar = bar; b.x = xb_xcc_id(); b.st = st;
    if (threadIdx.x == 0) (void)xb_add(&bar[XB_XCNT(b.x)], 1u);
    return b;
}
DI void xcd_barrier_complete(unsigned* bar, unsigned x, unsigned& nloc, unsigned& nx) {
    const unsigned G = gridDim.x * gridDim.y * gridDim.z;
    unsigned sum, cnt, mine, sp = 0u;
    for (;;) {
        sum = 0u; cnt = 0u; mine = 0u;
#pragma unroll
        for (unsigned j = 0; j < 16; ++j) { const unsigned c = xb_ld(&bar[XB_XCNT(j)]); sum += c; cnt += (c > 0u) ? 1u : 0u; mine = (j == x) ? c : mine; }
        if (sum == G) break;
        __builtin_amdgcn_s_sleep(1);
        if ((++sp & 255u) == 0u) { if (xb_ld(&bar[XB_TMO])) break; if (sp > XB_SPIN_CAP) { atomicAdd(&bar[XB_TMO], 1u); break; } }
    }
    nloc = mine > 0u ? mine : 1u; nx = cnt > 0u ? cnt : 1u;
}
DI void xcd_barrier(const XcdBarrier& b) {
    asm volatile("s_waitcnt vmcnt(0)" ::: "memory");
    __syncthreads();
    if (threadIdx.x == 0) {
        unsigned* bar = b.bar;
        __builtin_amdgcn_s_waitcnt(0);
        unsigned nloc = b.st[0], nx = b.st[1];
        if (nloc == 0u) { xcd_barrier_complete(bar, b.x, nloc, nx); b.st[0] = nloc; b.st[1] = nx; }
        const unsigned old = xb_add(&bar[XB_XSUB(b.x)], 1u);
        const unsigned gen = old / nloc;
        if (old + 1u == (gen + 1u) * nloc) {
            __builtin_amdgcn_fence(__ATOMIC_RELEASE, "agent");
            asm volatile("s_waitcnt vmcnt(0)" ::: "memory");
            const unsigned og = xb_add(&bar[XB_TOP], 1u);
            const unsigned tg = og / nx;
            if (og + 1u == (tg + 1u) * nx) xb_add(&bar[XB_TOPGEN], 1u);
            else XB_SPIN(xb_ld(&bar[XB_TOPGEN]) == tg, bar);
            __builtin_amdgcn_fence(__ATOMIC_ACQUIRE, "agent");
            xb_add(&bar[XB_XGEN(b.x)], 1u);
            asm volatile("s_waitcnt vmcnt(0)" ::: "memory");
        } else {
            XB_SPIN(xb_ld(&bar[XB_XGEN(b.x)]) == gen, bar);
            __builtin_amdgcn_fence(__ATOMIC_ACQUIRE, "agent");
            asm volatile("s_waitcnt vmcnt(0)" ::: "memory");
        }
    }
    __syncthreads();
}

namespace pg8 {
constexpr int BM = 256, BK = 64, HALF = 128, HTB = HALF * BK * 2, STAGE_BYTES = 8 * HTB;
DI int lds_byte(int r, int c) { const int st = (r >> 4) * 2 + (c >> 5), rr = r & 15, cc = c & 31, ob = rr * 64 + cc * 2; return st * 1024 + (ob ^ (((ob >> 9) & 1) << 5)); }
DI void stage_rc(int b, int& R, int& C) { const int st = b / 1024, sb = b % 1024, swz = sb ^ (((sb >> 9) & 1) << 5); R = (st >> 1) * 16 + swz / 64; C = (st & 1) * 32 + (swz % 64) / 2; }
DI int perm32(int rho) { const int n = rho >> 4, i = rho & 15; return 8 * (i >> 2) + 4 * n + (i & 3); }
struct Unit { const char* A; const char* B; int pm, pn, rows, aux; };

template <class Epi, class Sched, bool GATHER>
DI void gemm_phase(LAS unsigned char* lds, const int K, const Sched& S, const Epi& E) {
    int tid = threadIdx.x; asm volatile("" : "+v"(tid));
    const int wid = __builtin_amdgcn_readfirstlane(tid >> 6), lane = tid & 63, wr = wid >> 2, wc = wid & 3, fr = lane & 15, fq = lane >> 4;
    const int nt = K / BK;
    unsigned voffA[2], voffB[2]; int Rr[2], Cc[2];
#pragma unroll
    for (int i = 0; i < 2; ++i) { int R, C; stage_rc(tid * 16 + i * 8192, R, C); const int Rb = (R & ~31) + perm32(R & 31); Rr[i] = R; Cc[i] = C;
        voffA[i] = (unsigned)(R * K + C) * 2u; voffB[i] = (unsigned)(Rb * K + C) * 2u; }
    const size_t kstep = (size_t)(BK * 2);
    const size_t hstep = (size_t)HALF * K * 2;
    const unsigned ldsw = (unsigned)wid * 1024u;
    const int aoff = lds_byte(wr * 64 + fr, fq * 8), boff = lds_byte(wc * 32 + fr, fq * 8);
#define PG8_SA(b, h) (((b) * 2 + (h)) * HTB)
#define PG8_SB(b, h) ((4 + (b) * 2 + (h)) * HTB)
#define PG8_STAGE(bufoff, gbase, voff) do { _Pragma("unroll") for (int _i = 0; _i < 2; ++_i) \
        __builtin_amdgcn_global_load_lds((const unsigned*)((const char*)(gbase) + (voff)[_i]), (LAS unsigned*)(lds + (bufoff) + ldsw + _i * 8192), 16, 0, 0); } while (0)
#define PG8_STAGEA(bufoff, gbase, h, nx) do { if constexpr (GATHER) { unsigned _o[2]; _o[0] = (nx) ? na[h][0] : ga[h][0]; _o[1] = (nx) ? na[h][1] : ga[h][1]; PG8_STAGE(bufoff, gbase, _o); } \
        else { PG8_STAGE(bufoff, (gbase) + (h) * hstep, voffA); } } while (0)
#define PG8_LDA(dst, b, h) do { _Pragma("unroll") for (int m = 0; m < 4; ++m) _Pragma("unroll") for (int k = 0; k < 2; ++k) dst[m][k] = *(const LAS bf16x8*)(lds + PG8_SA(b, h) + aoff + m * 2048 + k * 1024); } while (0)
#define PG8_LDB(dst, b, h) do { _Pragma("unroll") for (int n = 0; n < 2; ++n) _Pragma("unroll") for (int k = 0; k < 2; ++k) dst[n][k] = *(const LAS bf16x8*)(lds + PG8_SB(b, h) + boff + n * 2048 + k * 1024); } while (0)
#define PG8_MMA(ai, bj, At, Bt) do { __builtin_amdgcn_s_setprio(1); _Pragma("unroll") for (int m = 0; m < 4; ++m) _Pragma("unroll") for (int n = 0; n < 2; ++n) _Pragma("unroll") for (int k = 0; k < 2; ++k) \
        acc[ai][bj][m][n] = __builtin_amdgcn_mfma_f32_16x16x32_bf16(Bt[n][k], At[m][k], acc[ai][bj][m][n], 0, 0, 0); __builtin_amdgcn_s_setprio(0); } while (0)
#define PG8_WAIT_V(n) asm volatile("s_waitcnt vmcnt(" #n ")" ::: "memory")
#define PG8_WAIT_L(n) asm volatile("s_waitcnt lgkmcnt(" #n ")" ::: "memory")
#define PG8_BAR __builtin_amdgcn_s_barrier()
#define PG8_SCHED __builtin_amdgcn_sched_barrier(0)
    Unit cur, nxt; int ui = 0;
    if (!S.next(0, cur)) return;
    f32x4 acc[2][2][4][2];
#pragma unroll
    for (int a = 0; a < 2; ++a)
#pragma unroll
        for (int b = 0; b < 2; ++b)
#pragma unroll
            for (int m = 0; m < 4; ++m)
#pragma unroll
                for (int n = 0; n < 2; ++n) acc[a][b][m][n] = (f32x4){0.f, 0.f, 0.f, 0.f};
    bf16x8 At[4][2], B0[2][2], B1[2][2];
    const char* cA = cur.A; const char* cB = cur.B;
    if constexpr (Epi::PREP) E.prep(cur, tid);
    unsigned ga[2][2], na[2][2];
    if constexpr (GATHER) {
#pragma unroll
        for (int h = 0; h < 2; ++h)
#pragma unroll
            for (int i = 0; i < 2; ++i) { ga[h][i] = S.row_off(cur, 128 * h + Rr[i]) + (unsigned)Cc[i] * 2u; na[h][i] = ga[h][i]; }
    }
    PG8_STAGE(PG8_SB(0, 0), cB, voffB); PG8_STAGE(PG8_SB(0, 1), cB + hstep, voffB); PG8_STAGEA(PG8_SA(0, 0), cA, 0, false); PG8_STAGEA(PG8_SA(0, 1), cA, 1, false);
    if (wr == 1) PG8_BAR;
    PG8_WAIT_V(2); PG8_BAR;
    PG8_STAGE(PG8_SB(1, 0), cB + kstep, voffB); PG8_STAGEA(PG8_SA(1, 0), cA + kstep, 0, false); PG8_STAGE(PG8_SB(1, 1), cB + hstep + kstep, voffB);
    PG8_WAIT_V(6); PG8_BAR;
    for (;;) {
        const bool has_next = S.next(ui + 1, nxt);
        if constexpr (Epi::PREP) { if (has_next) E.prep(nxt, tid); }
        const char* nA = has_next ? nxt.A : cA; const char* nB = has_next ? nxt.B : cB;
        if constexpr (GATHER) {
            if (has_next) {
#pragma unroll
                for (int h = 0; h < 2; ++h)
#pragma unroll
                    for (int i = 0; i < 2; ++i) na[h][i] = S.row_off(nxt, 128 * h + Rr[i]) + (unsigned)Cc[i] * 2u;
            }
        }
        const bool do0 = !Sched::RAGGED || cur.rows > 64 * wr, do1 = !Sched::RAGGED || cur.rows > 128 + 64 * wr;
#pragma unroll 1
        for (int t = 0; t < nt; t += 2) {
            const bool last = (t == nt - 2);
            const char* a1 = cA + (size_t)(t + 1) * kstep;
            const char* a2 = last ? nA : cA + (size_t)(t + 2) * kstep; const char* b2 = last ? nB : cB + (size_t)(t + 2) * kstep;
            const char* a3 = a2 + kstep; const char* b3 = b2 + kstep;
            PG8_LDB(B0, 0, 0); PG8_LDB(B1, 0, 1); PG8_SCHED; PG8_LDA(At, 0, 0); PG8_STAGEA(PG8_SA(1, 1), a1, 1, false);
            PG8_WAIT_V(8); PG8_WAIT_L(0); PG8_BAR; if (do0) { PG8_MMA(0, 0, At, B0); PG8_MMA(0, 1, At, B1); } PG8_BAR; PG8_SCHED;
            PG8_LDA(At, 0, 1); PG8_STAGE(PG8_SB(0, 0), b2, voffB); PG8_STAGE(PG8_SB(0, 1), b2 + hstep, voffB); PG8_STAGEA(PG8_SA(0, 0), a2, 0, last);
            PG8_WAIT_V(8); PG8_WAIT_L(0); PG8_BAR; if (do1) { PG8_MMA(1, 0, At, B0); PG8_MMA(1, 1, At, B1); } PG8_BAR; PG8_SCHED;
            PG8_LDB(B0, 1, 0); PG8_LDB(B1, 1, 1); PG8_SCHED; PG8_LDA(At, 1, 0); PG8_STAGEA(PG8_SA(0, 1), a2, 1, last);
            PG8_WAIT_V(8); PG8_WAIT_L(0); PG8_BAR; if (do0) { PG8_MMA(0, 0, At, B0); PG8_MMA(0, 1, At, B1); } PG8_BAR; PG8_SCHED;
            PG8_LDA(At, 1, 1); PG8_STAGE(PG8_SB(1, 0), b3, voffB); PG8_STAGE(PG8_SB(1, 1), b3 + hstep, voffB); PG8_STAGEA(PG8_SA(1, 0), a3, 0, last);
            PG8_WAIT_V(8); PG8_WAIT_L(0); PG8_BAR; if (do1) { PG8_MMA(1, 0, At, B0); PG8_MMA(1, 1, At, B1); } PG8_BAR; PG8_SCHED;
            if constexpr (Epi::MID) { if (t == nt / 2 - 2) E.mid(acc, cur, wr, wc, fr, fq); }
        }
        if (wr == 0) PG8_BAR;
        E(acc, cur, wr, wc, fr, fq);
        if (!has_next) break;
#pragma unroll
        for (int a = 0; a < 2; ++a)
#pragma unroll
            for (int b = 0; b < 2; ++b)
#pragma unroll
                for (int m = 0; m < 4; ++m)
#pragma unroll
                    for (int n = 0; n < 2; ++n) acc[a][b][m][n] = (f32x4){0.f, 0.f, 0.f, 0.f};
        cur = nxt; cA = nA; cB = nB; ++ui;
        if constexpr (GATHER) {
#pragma unroll
            for (int h = 0; h < 2; ++h)
#pragma unroll
                for (int i = 0; i < 2; ++i) ga[h][i] = na[h][i];
        }
        if (wr == 1) PG8_BAR;
    }
    PG8_WAIT_V(0);
    PG8_BAR;
#undef PG8_SA
#undef PG8_SB
#undef PG8_STAGE
#undef PG8_STAGEA
#undef PG8_LDA
#undef PG8_LDB
#undef PG8_MMA
#undef PG8_WAIT_V
#undef PG8_WAIT_L
#undef PG8_BAR
#undef PG8_SCHED
}

struct DenseOrder {
    static constexpr bool RAGGED = false;
    const char* A; const char* Bt; int K, nM, nN, nwg, G, c;
    DI void init(const void* A_, const void* Bt_, int M, int N, int K_, int G_, int c_) { A = (const char*)A_; Bt = (const char*)Bt_; K = K_; nM = M / BM; nN = N / BM; nwg = nM * nN; G = G_; c = c_; }
    DI bool next(int i, Unit& u) const {
        const long L = (long)i * G + c; if (L >= nwg) return false;
        int wgid = (int)L; { const int q = nwg / 8, r = nwg % 8, xcd = wgid % 8, off = wgid / 8; wgid = (xcd < r ? xcd * (q + 1) : r * (q + 1) + (xcd - r) * q) + off; }
        const int nig = 8 * nN, gid = wgid / nig, fm = gid * 8, gsz = (nM - fm) < 8 ? (nM - fm) : 8;
        u.pm = fm + ((wgid % nig) % gsz); u.pn = (wgid % nig) / gsz; u.rows = 256; u.aux = i % 3;
        u.A = A + (size_t)u.pm * 256 * K * 2; u.B = Bt + (size_t)u.pn * 256 * K * 2; return true;
    }
    DI unsigned row_off(const Unit&, int) const { return 0u; }
};
struct EpiStoreBf16 {
    static constexpr bool MID = false, PREP = false;
    bf16_t* O; int ld;
    DI void operator()(const f32x4 (&acc)[2][2][4][2], const Unit& u, int wr, int wc, int fr, int fq) const {
        bf16_t* base = O + (size_t)(u.pm * 256 + wr * 64 + fr) * ld + u.pn * 256 + wc * 32 + 8 * fq;
#pragma unroll
        for (int ai = 0; ai < 2; ++ai)
#pragma unroll
            for (int m = 0; m < 4; ++m) { bf16_t* rowp = base + (size_t)(ai * HALF + m * 16) * ld;
#pragma unroll
                for (int bj = 0; bj < 2; ++bj) { const f32x4 v0 = acc[ai][bj][m][0], v1 = acc[ai][bj][m][1];
                    *(u32x4*)(rowp + bj * HALF) = (u32x4){pk2(v0[0], v0[1]), pk2(v0[2], v0[3]), pk2(v1[0], v1[1]), pk2(v1[2], v1[3])}; } }
    }
};
}

DI void sincos_d(double ang, double& s, double& c) {
    const double r = ang * 0.63661977236758134308; const double q = __builtin_rint(r);
    const double y = (ang - q * 1.57079632679489655800) - q * 6.12323399573676603587e-17;
    const double y2 = y * y;
    double sp = -1.0 / 1307674368000.0; sp = sp * y2 + 1.0 / 6227020800.0; sp = sp * y2 - 1.0 / 39916800.0; sp = sp * y2 + 1.0 / 362880.0; sp = sp * y2 - 1.0 / 5040.0; sp = sp * y2 + 1.0 / 120.0; sp = sp * y2 - 1.0 / 6.0; sp = sp * y2 + 1.0;
    const double sy = y * sp;
    double cp = 1.0 / 87178291200.0; cp = cp * y2 - 1.0 / 479001600.0; cp = cp * y2 + 1.0 / 3628800.0; cp = cp * y2 - 1.0 / 40320.0; cp = cp * y2 + 1.0 / 720.0; cp = cp * y2 - 1.0 / 24.0; cp = cp * y2 + 0.5; const double cy = 1.0 - y2 * cp;
    const int qi = ((int)q) & 3;
    s = (qi == 0) ? sy : (qi == 1) ? cy : (qi == 2) ? -sy : -cy;
    c = (qi == 0) ? cy : (qi == 1) ? -sy : (qi == 2) ? -cy : sy;
}
DI void ssm_tables(const Params& P, int g, int p) {
    float* ABAR = (float*)(P.ws + WS_ABAR); float* ABARL = (float*)(P.ws + WS_ABARL); bf16_t* BCAT = (bf16_t*)(P.ws + WS_BCAT); bf16_t* CCAT = (bf16_t*)(P.ws + WS_CCAT);
    const double dt = (double)expf(P.log_dt[g]);
    const double ar = P.a_re[g * 64 + p], ai = P.a_im[g * 64 + p];
    double sn, cs; sincos_d(dt * ai, sn, cs);
    const double mag = (double)expf((float)(dt * ar));
    const double abr = mag * cs, abi = mag * sn;
    ABAR[g * 128 + p] = (float)abr; ABAR[g * 128 + 64 + p] = (float)abi;
    double snL, csL; sincos_d(128.0 * dt * ai, snL, csL);
    const double magL = (double)expf((float)(128.0 * dt * ar));
    ABARL[g * 128 + p] = (float)(magL * csL); ABARL[g * 128 + 64 + p] = (float)(magL * snL);
    const double xr = abr - 1.0, xi = abi, den = ar * ar + ai * ai;
    const double qr = (xr * ar + xi * ai) / den, qi = (xi * ar - xr * ai) / den;
    for (int c = 0; c < 16; ++c) {
        const double br = P.b_re[(g * 64 + p) * 16 + c], bi = P.b_im[(g * 64 + p) * 16 + c];
        BCAT[(g * 128 + p) * 16 + c] = f2bf((float)(qr * br - qi * bi));
        BCAT[(g * 128 + 64 + p) * 16 + c] = f2bf((float)(qr * bi + qi * br));
        CCAT[(g * 16 + c) * 128 + p] = f2bf(P.c_re[(g * 16 + c) * 64 + p]);
        CCAT[(g * 16 + c) * 128 + 64 + p] = f2bf(-P.c_im[(g * 16 + c) * 64 + p]);
    }
}
DI void ada_item(const Params& P, char* lds, int item) {
    float* red = (float*)lds; const int tid = opaque_tid(), lane = tid & 63, wid = tid >> 6;
    const int n = item * 64 + lane, k0 = wid * 128;
    float a0 = 0.f, a1 = 0.f, a2 = 0.f, a3 = 0.f;
#pragma unroll 1
    for (int kb = k0; kb < k0 + 128; kb += 32) {
        float w[32];
#pragma unroll
        for (int j = 0; j < 32; ++j) w[j] = P.w_ada[(size_t)(kb + j) * 6144 + n];
#pragma unroll
        for (int j = 0; j < 32; ++j) { const int k = kb + j; a0 += siluf_(P.c[k]) * w[j]; a1 += siluf_(P.c[1024 + k]) * w[j]; a2 += siluf_(P.c[2048 + k]) * w[j]; a3 += siluf_(P.c[3072 + k]) * w[j]; }
    }
    red[(wid * 4 + 0) * 64 + lane] = a0; red[(wid * 4 + 1) * 64 + lane] = a1; red[(wid * 4 + 2) * 64 + lane] = a2; red[(wid * 4 + 3) * 64 + lane] = a3;
    __syncthreads();
    if (tid < 256) {
        const int b = tid >> 6, l = tid & 63; float s = 0.f;
#pragma unroll
        for (int w = 0; w < 8; ++w) s += red[(w * 4 + b) * 64 + l];
        ((float*)(P.ws + WS_ADA))[b * 6144 + item * 64 + l] = s + P.b_ada[item * 64 + l];
    }
    asm volatile("s_waitcnt vmcnt(0)" ::: "memory");
    __syncthreads();
    if (tid == 0) {
        __builtin_amdgcn_fence(__ATOMIC_RELEASE, "agent"); asm volatile("s_waitcnt vmcnt(0)" ::: "memory");
        __hip_atomic_fetch_add((unsigned*)(P.ws + WS_ADACNT), 1u, __ATOMIC_RELAXED, __HIP_MEMORY_SCOPE_AGENT);
    }
}
DI void tr_item(const float* __restrict__ W, int K, int N, bf16_t* __restrict__ WT, int item, float* scr, int lane, int mode, int s, bool qscale, const float* ks0 = nullptr, const float* ks1 = nullptr) {
    const int nblk = N >> 6, kb = item / nblk, nb = item % nblk, k0 = 64 * kb, n0 = 64 * nb;
    const float* src = W + (size_t)(k0 + (lane >> 4)) * N + n0 + 4 * (lane & 15);
    f32x4 wv[16];
#pragma unroll
    for (int i = 0; i < 16; ++i) wv[i] = *(const f32x4*)(src + (size_t)(4 * i) * N);
    if (ks0) {
#pragma unroll
        for (int i = 0; i < 16; ++i) { const int k = k0 + 4 * i + (lane >> 4); wv[i] = wv[i] * ((k < 512) ? ks0[k] : ks1[k - 512]); }
    }
#pragma unroll
    for (int i = 0; i < 16; ++i) { float* d = scr + (4 * i + (lane >> 4)) * 65 + 4 * (lane & 15); d[0] = wv[i][0]; d[1] = wv[i][1]; d[2] = wv[i][2]; d[3] = wv[i][3]; }
    LDS_FENCE();
    const int c = lane & 7; const float sc = (qscale && n0 < 512) ? 0.125f : 1.f;
#pragma unroll
    for (int j = 0; j < 8; ++j) {
        const int n = (lane >> 3) + 8 * j; const float* sp = scr + (8 * c) * 65 + n;
        const u32x4 o = (u32x4){pk2(sp[0] * sc, sp[65] * sc), pk2(sp[130] * sc, sp[195] * sc), pk2(sp[260] * sc, sp[325] * sc), pk2(sp[390] * sc, sp[455] * sc)};
        const int nn = n0 + n; const int drow = mode == 0 ? nn : (mode == 1 ? (64 * (nn >> 5) + 32 * s + (nn & 31)) : (mode == 2 ? (256 * (nn >> 7) + 128 * s + (nn & 127)) :
            ((nn & ~255) + 128 * ((nn >> 3) & 1) + 32 * ((nn >> 6) & 3) + 8 * ((nn >> 4) & 3) + (nn & 7))));
        *(u32x4*)(WT + (size_t)drow * K + k0 + 8 * c) = o;
    }
    LDS_FENCE();
}
constexpr int CI_IN = 512, CI_GLU = 64, CI_OUT = 256, CI_R = 64, CI_SG = 64, CI_SU = 64, CI_SD = 64, CI_SMALL = CI_IN + CI_GLU + CI_OUT + CI_R + CI_SG + CI_SU + CI_SD;
DI void conv_item(const Params& P, int r, float* scr, int lane) {
    if (r < CI_IN) { tr_item(P.w_in, 1024, 2048, (bf16_t*)(P.ws + WS_WIN), r, scr, lane, 0, 0, true); return; } r -= CI_IN;
    if (r < CI_GLU) { tr_item(P.w_glu, 512, 512, (bf16_t*)(P.ws + WS_WGLU), r, scr, lane, 0, 0, false); return; } r -= CI_GLU;
    if (r < CI_OUT) { tr_item(P.w_out, 1024, 1024, (bf16_t*)(P.ws + WS_WOUT), r, scr, lane, 0, 0, false, P.g_att, P.g_ssm); return; } r -= CI_OUT;
    if (r < CI_R) { tr_item(P.w_router, 1024, 256, (bf16_t*)(P.ws + WS_WR), r, scr, lane, 0, 0, false); return; } r -= CI_R;
    if (r < CI_SG) { tr_item(P.w_s_gate, 1024, 256, (bf16_t*)(P.ws + WS_WSGU), r, scr, lane, 2, 0, false); return; } r -= CI_SG;
    if (r < CI_SU) { tr_item(P.w_s_up, 1024, 256, (bf16_t*)(P.ws + WS_WSGU), r, scr, lane, 2, 1, false); return; } r -= CI_SU;
    if (r < CI_SD) tr_item(P.w_s_down, 256, 1024, (bf16_t*)(P.ws + WS_WSD), r, scr, lane, 0, 0, false);
}
DI void p0_prologue(const Params& P, char* lds) {
    const int tid = opaque_tid(), lane = tid & 63, wid = tid >> 6, G = gridDim.x;
    { const int gt = blockIdx.x * NTHR + tid; if (gt < 2048) ssm_tables(P, gt >> 6, gt & 63); }
    for (int item = blockIdx.x; item < 96; item += G) ada_item(P, lds, item);
    float* scr = (float*)(lds + wid * 16640);
    const int gw = blockIdx.x * 8 + wid, NGW = G * 8;
    if (blockIdx.x >= 96 || G <= 96) { const int w0 = (G > 96) ? gw - 96 * 8 : gw, nw = (G > 96) ? (G - 96) * 8 : NGW; for (int it = w0; it < CI_SMALL; it += nw) conv_item(P, it, scr, lane); }
    if (tid == 0) {
        unsigned* ctr = (unsigned*)(P.ws + WS_ADACNT); unsigned sp = 0;
        while (__hip_atomic_load(ctr, __ATOMIC_RELAXED, __HIP_MEMORY_SCOPE_AGENT) < 96u) { __builtin_amdgcn_s_sleep(2); if (++sp > (1u << 22)) break; }
        __builtin_amdgcn_fence(__ATOMIC_ACQUIRE, "agent"); asm volatile("s_waitcnt vmcnt(0)" ::: "memory");
    }
    __syncthreads();
    {
        const float* ADA = (const float*)(P.ws + WS_ADA); bf16_t* H1 = (bf16_t*)(P.ws + WS_H1);
        for (int row = gw; row < T; row += NGW) {
            const float* xr = P.x + (size_t)row * 1024 + 4 * lane; const float* ad = ADA + (row >> 13) * 6144 + 4 * lane;
#pragma unroll
            for (int j = 0; j < 4; ++j) {
                const f32x4 xv = *(const f32x4*)(xr + 256 * j), sc = *(const f32x4*)(ad + 1024 + 256 * j), sh = *(const f32x4*)(ad + 256 * j);
                const f32x4 hv = xv * (1.f + sc) + sh;
                *(u32x2*)(H1 + (size_t)row * 1024 + 4 * lane + 256 * j) = (u32x2){pk2(hv[0], hv[1]), pk2(hv[2], hv[3])};
            }
        }
    }
}

DI void p1_inproj(const Params& P, char* lds) {
    pg8::DenseOrder S; S.init(P.ws + WS_H1, P.ws + WS_WIN, T, NPROJ, 1024, gridDim.x, blockIdx.x);
    pg8::EpiStoreBf16 E{(bf16_t*)(P.ws + WS_QKVU), NPROJ};
    pg8::gemm_phase<pg8::EpiStoreBf16, pg8::DenseOrder, false>((LAS unsigned char*)lds, 1024, S, E);
}

constexpr int CONV_NT = 3 * 256 * 16, CONV_TP = 257, FILL_TILES_PER_WG = 8;
struct ConvTile { const float* src; bf16_t* WT; int pitch, K, k0, n0, mode, s; };
DI ConvTile conv_tile(const Params& P, int t) {
    const int kind = t / 4096, e = (t % 4096) >> 4, sub = t & 15;
    if (kind < 2) return ConvTile{(kind ? P.w_e_up : P.w_e_gate) + (size_t)e * 262144 + (size_t)(64 * sub) * 256, (bf16_t*)(P.ws + WS_WEGU) + (size_t)e * 524288, 256, 1024, 64 * sub, 0, 2, kind};
    return ConvTile{P.w_e_down + (size_t)e * 262144 + (size_t)(64 * (sub >> 2)) * 1024 + 256 * (sub & 3), (bf16_t*)(P.ws + WS_WED) + (size_t)e * 262144, 1024, 256, 64 * (sub >> 2), 256 * (sub & 3), 3, 0};
}
DI void conv_tile_load(const ConvTile& d, int wid, int lane, f32x4 (&w)[8]) {
#pragma unroll
    for (int i = 0; i < 8; ++i) w[i] = __builtin_nontemporal_load((const f32x4*)(d.src + (size_t)(8 * wid + i) * d.pitch + 4 * lane));
}
DI void conv_experts_block(const Params& P, char* lds, int t, const int NT, const int stride) {
    const int tid = opaque_tid(), lane = tid & 63, wid = tid >> 6;
    if (t >= NT) return;
    float* buf0 = (float*)lds; float* buf1 = buf0 + 64 * CONV_TP;
    ConvTile d = conv_tile(P, t); f32x4 w[8]; conv_tile_load(d, wid, lane, w);
    int par = 0;
    for (;;) {
        float* buf = par ? buf1 : buf0;
#pragma unroll
        for (int i = 0; i < 8; ++i) { float* p = buf + (8 * wid + i) * CONV_TP + 4 * lane; p[0] = w[i][0]; p[1] = w[i][1]; p[2] = w[i][2]; p[3] = w[i][3]; }
        const int tn = t + stride; const ConvTile dn = conv_tile(P, tn < NT ? tn : t);
        conv_tile_load(dn, wid, lane, w);
        __syncthreads();
        const int c = lane & 7;
#pragma unroll
        for (int it = 0; it < 4; ++it) {
            const int n = 8 * wid + (lane >> 3) + 64 * it; const float* sp = buf + (8 * c) * CONV_TP + n;
            const u32x4 o = (u32x4){pk2(sp[0], sp[CONV_TP]), pk2(sp[2 * CONV_TP], sp[3 * CONV_TP]), pk2(sp[4 * CONV_TP], sp[5 * CONV_TP]), pk2(sp[6 * CONV_TP], sp[7 * CONV_TP])};
            const int nn = d.n0 + n; const int drow = d.mode == 2 ? (256 * (nn >> 7) + 128 * d.s + (nn & 127)) : ((nn & ~255) + 128 * ((nn >> 3) & 1) + 32 * ((nn >> 6) & 3) + 8 * ((nn >> 4) & 3) + (nn & 7));
            *(u32x4*)(d.WT + (size_t)drow * d.K + d.k0 + 8 * c) = o;
        }
        t = tn; if (t >= NT) break;
        d = dn; par ^= 1;
    }
    __syncthreads();
}
DI int fill_blocks() { const int G = gridDim.x, rounds = (384 + G - 1) / G; return rounds * G - 384; }
DI void p1_inproj_and_experts(const Params& P, char* lds) {
    const bool conv_first = ((blockIdx.x >> 3) & 1) == 0;
    const int nb = fill_blocks(), fill = (nb > 0 && nb < (int)gridDim.x) ? nb * FILL_TILES_PER_WG : 0;
    if (conv_first) conv_experts_block(P, lds, blockIdx.x, CONV_NT - fill, gridDim.x);
    p1_inproj(P, lds);
    if (!conv_first) conv_experts_block(P, lds, blockIdx.x, CONV_NT - fill, gridDim.x);
}

DI int t5_bucket(int dist) {
    if (dist < 16) return dist;
    const float v = logf((float)dist / 16.0f) / 4.852030263919617f * 16.0f;
    int l = 16 + (int)v; return l < 31 ? l : 31;
}
struct VFrag { u32x2 r[8]; };
DI VFrag v_tr_read(unsigned addr) {
    VFrag f;
    asm volatile("ds_read_b64_tr_b16 %0, %8\n\tds_read_b64_tr_b16 %1, %8 offset:1152\n\tds_read_b64_tr_b16 %2, %8 offset:64\n\tds_read_b64_tr_b16 %3, %8 offset:1216\n\t"
                 "ds_read_b64_tr_b16 %4, %8 offset:2304\n\tds_read_b64_tr_b16 %5, %8 offset:3456\n\tds_read_b64_tr_b16 %6, %8 offset:2368\n\tds_read_b64_tr_b16 %7, %8 offset:3520\n\ts_waitcnt lgkmcnt(0)"
                 : "=&v"(f.r[0]), "=&v"(f.r[1]), "=&v"(f.r[2]), "=&v"(f.r[3]), "=&v"(f.r[4]), "=&v"(f.r[5]), "=&v"(f.r[6]), "=&v"(f.r[7]) : "v"(addr) : "memory");
    return f;
}
DI void attn_task_params(int task, int wid, int& d, int& r, int& lqb, int& p) {
    p = task >> 1; const int tk = wid + 8 * (task & 1);
    if (p == 0) { d = 1; r = 0; lqb = 32 * tk; } else if (p == 1) { d = 4; r = tk >> 2; lqb = 32 * (tk & 3); } else { d = 16; r = tk; lqb = 0; }
}
DI void attn_unit(const Params& P, char* lds, int unit) {
    int tid = threadIdx.x; asm volatile("" : "+v"(tid));
    const int lane = tid & 63, wid = __builtin_amdgcn_readfirstlane(tid >> 6), c = lane & 31, hh = lane >> 5;
    const int b = unit >> 7, qb = (unit >> 3) & 15, h = unit & 7, t0 = qb * 512;
    char* st = lds;
    float* bt = (float*)(lds + 512 * 136);
    bf16_t* ksw = (bf16_t*)(bt + 3 * 192) + wid * (64 * LDP);
    bf16_t* vsw = ksw + 32 * LDP;
    const unsigned vtr = (unsigned)(size_t)vsw + (unsigned)(((4 * hh + ((lane & 15) >> 2)) * LDP + 16 * ((lane >> 4) & 1) + 4 * (lane & 3)) * 2);
    const bf16_t* qkv = (const bf16_t*)(P.ws + WS_QKVU) + (size_t)(b * SEQ) * NPROJ;
    constexpr float LOG2E = 1.4426950408889634f;
    for (int i = tid; i < 3 * 192; i += NTHR) {
        const int p = i / 192, j = i % 192 - 32; const int dist = (j < 0 ? 0 : j) << (2 * p); float v = NEG;
        if (j >= (p ? 33 : 0) && j <= 128) {
            const int mult = (p == 0) ? 1 + ((j & 3) == 0) + ((j & 15) == 0) : (p == 1 ? 1 + ((j & 3) == 0) : 1);
            v = P.rel_bias[t5_bucket(dist) * 8 + h] * LOG2E + (mult == 1 ? 0.f : (mult == 2 ? 1.f : 1.5849625007211562f));
        }
        bt[i] = v;
    }
    __syncthreads();
    bf16x8 kfN[4], vvN[4], qfN[4];
    auto issue = [&](int it) {
        int d, r, lqb, p; attn_task_params(it / 5, wid, d, r, lqb, p); const int ch = it % 5;
        if (p > 0 && ch == 4) return;
#pragma unroll
        for (int i = 0; i < 4; ++i) {
            int tk = t0 + d * (lqb - 128 + 32 * ch + 8 * i + (lane >> 3)) + r; tk = tk < 0 ? 0 : (tk > SEQ - 1 ? SEQ - 1 : tk);
            const bf16_t* rp = qkv + (size_t)tk * NPROJ + 512 + h * 64 + 8 * (lane & 7);
            kfN[i] = *(const bf16x8*)rp; vvN[i] = *(const bf16x8*)(rp + 512);
        }
        if (ch == 0) { const bf16_t* qrow = qkv + (size_t)(t0 + d * (lqb + c) + r) * NPROJ + h * 64 + 8 * hh;
#pragma unroll
            for (int s = 0; s < 4; ++s) qfN[s] = *(const bf16x8*)(qrow + 16 * s); }
    };
    issue(0);
    bf16x8 qf[4]; float m = NEG, l = 0.f; f32x16 o0, o1; int d = 1, r = 0, lqb = 0, p = 0, qidx = 0;
#pragma unroll 1
    for (int it = 0; it < 30; ++it) {
        const int ch = it % 5;
        if (ch == 0) {
            attn_task_params(it / 5, wid, d, r, lqb, p);
            qidx = d * (lqb + c) + r;
#pragma unroll
            for (int s = 0; s < 4; ++s) qf[s] = qfN[s];
            m = NEG; l = 0.f;
#pragma unroll
            for (int i = 0; i < 16; ++i) { o0[i] = 0.f; o1[i] = 0.f; }
            if (p > 0) {
                const char* sp = st + qidx * 136; const f32x2 ml = *(const f32x2*)(sp + 128); m = ml[0]; l = hh ? 0.f : ml[1];
#pragma unroll
                for (int g = 0; g < 4; ++g) { const u32x2 a = *(const u32x2*)(sp + (8 * g + 4 * hh) * 2), bb = *(const u32x2*)(sp + (32 + 8 * g + 4 * hh) * 2);
                    o0[4 * g] = bflo(a[0]); o0[4 * g + 1] = bfhi(a[0]); o0[4 * g + 2] = bflo(a[1]); o0[4 * g + 3] = bfhi(a[1]); o1[4 * g] = bflo(bb[0]); o1[4 * g + 1] = bfhi(bb[0]); o1[4 * g + 2] = bflo(bb[1]); o1[4 * g + 3] = bfhi(bb[1]); }
            }
        }
        const float* btp = bt + p * 192 + 32 + c + 128 - 32 * ch - 4 * hh;
        const bool dead = (t0 + d * (lqb - 128 + 32 * ch + 31) + r < 0) || (p > 0 && ch == 4);
        if (dead) { if (it + 1 < 30) issue(it + 1); }
        else {
        LDS_FENCE();
#pragma unroll
        for (int i = 0; i < 4; ++i) { *(bf16x8*)(ksw + (8 * i + (lane >> 3)) * LDP + 8 * (lane & 7)) = kfN[i]; *(bf16x8*)(vsw + (8 * i + (lane >> 3)) * LDP + 8 * (lane & 7)) = vvN[i]; }
        if (it + 1 < 30) issue(it + 1);
        LDS_FENCE();
        const int lk0 = lqb - 128 + 32 * ch;
        bf16x8 kf[4];
#pragma unroll
        for (int s = 0; s < 4; ++s) kf[s] = *(const bf16x8*)(ksw + c * LDP + 16 * s + 8 * hh);
        f32x16 sa;
#pragma unroll
        for (int i = 0; i < 16; ++i) sa[i] = 0.f;
#pragma unroll
        for (int s = 0; s < 4; ++s) sa = MFMA32(kf[s], qf[s], sa);
        float sc[16]; float mx = NEG;
#pragma unroll
        for (int i = 0; i < 16; ++i) sc[i] = btp[-((i & 3) + 8 * (i >> 2))];
        asm volatile("" : "+v"(sc[0]), "+v"(sc[1]), "+v"(sc[2]), "+v"(sc[3]), "+v"(sc[4]), "+v"(sc[5]), "+v"(sc[6]), "+v"(sc[7]), "+v"(sc[8]), "+v"(sc[9]), "+v"(sc[10]), "+v"(sc[11]), "+v"(sc[12]), "+v"(sc[13]), "+v"(sc[14]), "+v"(sc[15]));
        if (t0 + d * lk0 + r >= 0) {
#pragma unroll
            for (int i = 0; i < 16; ++i) { const float v = fmaf(sa[i], LOG2E, sc[i]); sc[i] = v; mx = fmaxf(mx, v); }
        } else {
#pragma unroll
            for (int i = 0; i < 16; ++i) {
                const int kr = (i & 3) + 8 * (i >> 2) + 4 * hh;
                const float v = (t0 + d * (lk0 + kr) + r >= 0) ? fmaf(sa[i], LOG2E, sc[i]) : NEG; sc[i] = v; mx = fmaxf(mx, v);
            }
        }
        mx = xmax32(mx);
        if (!__all(mx - m <= 8.f)) {
            const float mn = fmaxf(m, mx), alpha = __builtin_amdgcn_exp2f(m - mn); m = mn; l *= alpha;
#pragma unroll
            for (int i = 0; i < 16; ++i) { o0[i] *= alpha; o1[i] *= alpha; }
        }
        float ps = 0.f;
#pragma unroll
        for (int i = 0; i < 16; ++i) { sc[i] = __builtin_amdgcn_exp2f(sc[i] - m); ps += sc[i]; }
        l += ps;
        const VFrag vf = v_tr_read(vtr);
#pragma unroll
        for (int s = 0; s < 2; ++s) {
            const u32x4 pw = (u32x4){pk2(sc[8 * s], sc[8 * s + 1]), pk2(sc[8 * s + 2], sc[8 * s + 3]), pk2(sc[8 * s + 4], sc[8 * s + 5]), pk2(sc[8 * s + 6], sc[8 * s + 7])};
            const bf16x8 pf = __builtin_bit_cast(bf16x8, pw);
            const u32x4 v0 = (u32x4){vf.r[4 * s][0], vf.r[4 * s][1], vf.r[4 * s + 1][0], vf.r[4 * s + 1][1]}, v1 = (u32x4){vf.r[4 * s + 2][0], vf.r[4 * s + 2][1], vf.r[4 * s + 3][0], vf.r[4 * s + 3][1]};
            o0 = MFMA32(__builtin_bit_cast(bf16x8, v0), pf, o0); o1 = MFMA32(__builtin_bit_cast(bf16x8, v1), pf, o1);
        }
        }
        if (ch == 4) {
            l = xsum32(l);
            char* sp = st + qidx * 136;
            if (hh == 0) *(f32x2*)(sp + 128) = (f32x2){m, l};
#pragma unroll
            for (int g = 0; g < 4; ++g) { *(u32x2*)(sp + (8 * g + 4 * hh) * 2) = (u32x2){pk2(o0[4 * g], o0[4 * g + 1]), pk2(o0[4 * g + 2], o0[4 * g + 3])}; *(u32x2*)(sp + (32 + 8 * g + 4 * hh) * 2) = (u32x2){pk2(o1[4 * g], o1[4 * g + 1]), pk2(o1[4 * g + 2], o1[4 * g + 3])}; }
            if ((it / 5) & 1) __syncthreads();
        }
    }
    {
        const char* sp = st + tid * 136; const float inv = 1.f / *(const float*)(sp + 132);
        bf16_t* op = (bf16_t*)(P.ws + WS_MERGED) + (size_t)(b * SEQ + t0 + tid) * 1024 + h * 64; float ss = 0.f;
#pragma unroll
        for (int i = 0; i < 8; ++i) { const u32x2 wa = *(const u32x2*)(sp + 16 * i), wb = *(const u32x2*)(sp + 16 * i + 8); const unsigned w[4] = {wa[0], wa[1], wb[0], wb[1]}; float v[8];
#pragma unroll
            for (int j = 0; j < 4; ++j) { v[2 * j] = bflo(w[j]) * inv; v[2 * j + 1] = bfhi(w[j]) * inv; ss += v[2 * j] * v[2 * j] + v[2 * j + 1] * v[2 * j + 1]; }
            *(u32x4*)(op + 8 * i) = (u32x4){pk2(v[0], v[1]), pk2(v[2], v[3]), pk2(v[4], v[5]), pk2(v[6], v[7])}; }
        ((float*)(P.ws + WS_ATTSQ))[(size_t)(b * SEQ + t0 + tid) * 8 + h] = ss;
    }
    __syncthreads();
}

DI u32x2 tr_read1(unsigned addr) { u32x2 r; asm volatile("ds_read_b64_tr_b16 %0, %1\n\ts_waitcnt lgkmcnt(0)" : "=&v"(r) : "v"(addr) : "memory"); return r; }
struct STr16 { u32x2 r[16]; };
DI STr16 s_tr_read(unsigned addr) {
    STr16 f;
    asm volatile("ds_read_b64_tr_b16 %0, %16\n\tds_read_b64_tr_b16 %1, %16 offset:576\n\tds_read_b64_tr_b16 %2, %16 offset:4608\n\tds_read_b64_tr_b16 %3, %16 offset:5184\n\t"
                 "ds_read_b64_tr_b16 %4, %16 offset:9216\n\tds_read_b64_tr_b16 %5, %16 offset:9792\n\tds_read_b64_tr_b16 %6, %16 offset:13824\n\tds_read_b64_tr_b16 %7, %16 offset:14400\n\t"
                 "ds_read_b64_tr_b16 %8, %16 offset:32\n\tds_read_b64_tr_b16 %9, %16 offset:608\n\tds_read_b64_tr_b16 %10, %16 offset:4640\n\tds_read_b64_tr_b16 %11, %16 offset:5216\n\t"
                 "ds_read_b64_tr_b16 %12, %16 offset:9248\n\tds_read_b64_tr_b16 %13, %16 offset:9824\n\tds_read_b64_tr_b16 %14, %16 offset:13856\n\tds_read_b64_tr_b16 %15, %16 offset:14432\n\ts_waitcnt lgkmcnt(0)"
                 : "=&v"(f.r[0]), "=&v"(f.r[1]), "=&v"(f.r[2]), "=&v"(f.r[3]), "=&v"(f.r[4]), "=&v"(f.r[5]), "=&v"(f.r[6]), "=&v"(f.r[7]),
                   "=&v"(f.r[8]), "=&v"(f.r[9]), "=&v"(f.r[10]), "=&v"(f.r[11]), "=&v"(f.r[12]), "=&v"(f.r[13]), "=&v"(f.r[14]), "=&v"(f.r[15]) : "v"(addr) : "memory");
    return f;
}
template <bool FINAL>
DI void ssm_task(const Params& P, float* buf, int b, int k, int g, int lane, float s_re, float s_im) {
    const int c32 = lane & 31, hh = lane >> 5, fr = lane & 15, fq = lane >> 4;
    const float* ABAR = (const float*)(P.ws + WS_ABAR);
    const float a_re = ABAR[g * 128 + lane], a_im = ABAR[g * 128 + 64 + lane];
    bf16x8 bq[4];
#pragma unroll
    for (int tau = 0; tau < 4; ++tau) bq[tau] = *(const bf16x8*)((const bf16_t*)(P.ws + WS_BCAT) + (size_t)(g * 128 + 32 * tau + c32) * 16 + 8 * hh);
    bf16x8 cq[4]; f32x4 dsk = (f32x4){0.f, 0.f, 0.f, 0.f};
    if (FINAL) {
#pragma unroll
        for (int s = 0; s < 4; ++s) cq[s] = *(const bf16x8*)((const bf16_t*)(P.ws + WS_CCAT) + (size_t)(g * 16 + fr) * 128 + 32 * s + 8 * fq);
        dsk = *(const f32x4*)(P.ssm_d + g * 16 + 4 * fq);
    }
    const bf16_t* ubase = (const bf16_t*)(P.ws + WS_QKVU) + (size_t)(b * SEQ + k * 128) * NPROJ + 1536 + 16 * g;
    bf16x8 ufa[4]; u32x2 uwa[4][2];
#pragma unroll
    for (int sub = 0; sub < 4; ++sub) {
        ufa[sub] = *(const bf16x8*)(ubase + (size_t)(32 * sub + c32) * NPROJ + 8 * hh);
        if (FINAL) { uwa[sub][0] = *(const u32x2*)(ubase + (size_t)(32 * sub + fr) * NPROJ + 4 * fq); uwa[sub][1] = *(const u32x2*)(ubase + (size_t)(32 * sub + 16 + fr) * NPROJ + 4 * fq); }
    }
    const unsigned str = (unsigned)(size_t)buf + (unsigned)((8 * fq + ((lane & 15) >> 2)) * (SSM_PITCH * 4) + (lane & 3) * 8);
#pragma unroll
    for (int sub = 0; sub < 4; ++sub) {
        const bf16x8 uf = ufa[sub];
        LDS_FENCE();
#pragma unroll
        for (int tau = 0; tau < 4; ++tau) {
            f32x16 z;
#pragma unroll
            for (int i = 0; i < 16; ++i) z[i] = 0.f;
            z = MFMA32(uf, bq[tau], z);
#pragma unroll
            for (int gq = 0; gq < 4; ++gq) *(f32x4*)(buf + (32 * tau + c32) * SSM_PITCH + 8 * gq + 4 * hh) = (f32x4){z[4 * gq], z[4 * gq + 1], z[4 * gq + 2], z[4 * gq + 3]};
        }
        LDS_FENCE();
        float* rre = buf + lane * SSM_PITCH; float* rim = buf + (64 + lane) * SSM_PITCH;
#pragma unroll
        for (int tq = 0; tq < 8; ++tq) {
            const f32x4 re4 = *(const f32x4*)(rre + 4 * tq), im4 = *(const f32x4*)(rim + 4 * tq); float sr[4], si[4];
#pragma unroll
            for (int j = 0; j < 4; ++j) { const float nr = a_re * s_re - a_im * s_im + re4[j], ni = a_re * s_im + a_im * s_re + im4[j]; s_re = nr; s_im = ni; sr[j] = nr; si[j] = ni; }
            if (FINAL) { *(u32x2*)((bf16_t*)rre + 4 * tq) = (u32x2){pk2(sr[0], sr[1]), pk2(sr[2], sr[3])}; *(u32x2*)((bf16_t*)rim + 4 * tq) = (u32x2){pk2(si[0], si[1]), pk2(si[2], si[3])}; }
        }
        if (FINAL) {
            LDS_FENCE();
            const STr16 sf = s_tr_read(str);
#pragma unroll
            for (int tt = 0; tt < 2; ++tt) {
                f32x4 y = (f32x4){0.f, 0.f, 0.f, 0.f};
#pragma unroll
                for (int s = 0; s < 4; ++s) { const u32x4 w = (u32x4){sf.r[8 * tt + 2 * s][0], sf.r[8 * tt + 2 * s][1], sf.r[8 * tt + 2 * s + 1][0], sf.r[8 * tt + 2 * s + 1][1]}; y = MFMA16(cq[s], __builtin_bit_cast(bf16x8, w), y); }
                const int tl = 32 * sub + 16 * tt + fr;
                const u32x2 uw = uwa[sub][tt];
                const float v0 = gelu_tanh(y[0] + dsk[0] * bflo(uw[0])), v1 = gelu_tanh(y[1] + dsk[1] * bfhi(uw[0])), v2 = gelu_tanh(y[2] + dsk[2] * bflo(uw[1])), v3 = gelu_tanh(y[3] + dsk[3] * bfhi(uw[1]));
                *(u32x2*)((bf16_t*)(P.ws + WS_YGL) + (size_t)(b * SEQ + k * 128 + tl) * 512 + 16 * g + 4 * fq) = (u32x2){pk2(v0, v1), pk2(v2, v3)};
            }
        }
    }
    if (!FINAL) { float* E = (float*)(P.ws + WS_E) + (size_t)((b * 64 + k) * 32 + g) * 128; E[lane] = s_re; E[64 + lane] = s_im; }
    LDS_FENCE();
}

DI void p2_mixer(const Params& P, char* lds) {
    const int tid = opaque_tid(), lane = tid & 63, wid = tid >> 6, G = gridDim.x;
    for (int item = blockIdx.x; item < 1536; item += G) {
        if (item < 512) attn_unit(P, lds, item < 256 ? item : (item ^ (15 << 3)));
        else { const int wt = (item - 512) * 8 + wid; ssm_task<false>(P, (float*)(lds + wid * SSM_WAVE_LDS), wt >> 11, (wt >> 5) & 63, wt & 31, lane, 0.f, 0.f); __syncthreads(); }
    }
}

DI void route_token(const float* srow, const float* rbias, int lane, int& e_out, float& g_out) {
    const f32x4 s4 = *(const f32x4*)(srow + 4 * lane); const f32x4 rb = *(const f32x4*)(rbias + 4 * lane);
    float w0 = s4[0] + rb[0], w1 = s4[1] + rb[1], w2 = s4[2] + rb[2], w3 = s4[3] + rb[3];
    float m1, m2;
    { const float a = fmaxf(w0, w1), bb = fminf(w0, w1), cc = fmaxf(w2, w3), dd = fminf(w2, w3); m1 = fmaxf(a, cc); m2 = fmaxf(fminf(a, cc), fmaxf(bb, dd)); }
#define ROUTE_MERGE2(CTRL) { const float o1 = dppf<CTRL>(m1), o2 = dppf<CTRL>(m2); const float n1 = fmaxf(m1, o1), n2 = fmaxf(fminf(m1, o1), fmaxf(m2, o2)); m1 = n1; m2 = n2; }
    ROUTE_MERGE2(DPP_X1) ROUTE_MERGE2(DPP_X2) ROUTE_MERGE2(DPP_HM)
#undef ROUTE_MERGE2
    const float gs = m1 + m2; const int mygrp = lane >> 3; int rank = 0;
#pragma unroll
    for (int j = 0; j < 8; ++j) { const float gj = rdlane(gs, 8 * j); rank += ((gj > gs) || (gj == gs && j < mygrp)) ? 1 : 0; }
    const float NINF = -__builtin_inff();
    if (rank >= 4) { w0 = NINF; w1 = NINF; w2 = NINF; w3 = NINF; }
    int my_e = 0; float my_s = 0.f;
#pragma unroll 1
    for (int k = 0; k < TOPK; ++k) {
        float bv = w0; int bi = 0;
        if (w1 > bv) { bv = w1; bi = 1; } if (w2 > bv) { bv = w2; bi = 2; } if (w3 > bv) { bv = w3; bi = 3; }
        float rm = bv; rm = fmaxf(rm, dppf<DPP_X1>(rm)); rm = fmaxf(rm, dppf<DPP_X2>(rm)); rm = fmaxf(rm, dppf<DPP_HM>(rm)); rm = fmaxf(rm, dppf<DPP_RM>(rm));
        const float wmax = fmaxf(fmaxf(rdlane(rm, 0), rdlane(rm, 16)), fmaxf(rdlane(rm, 32), rdlane(rm, 48)));
        const unsigned long long bal = __ballot(bv == wmax);
        const int owner = __builtin_amdgcn_readfirstlane((int)__ffsll((long long)bal) - 1);
        const int sub = __builtin_amdgcn_readlane(bi, owner), idx = 4 * owner + sub;
        const float mys = bi == 0 ? s4[0] : (bi == 1 ? s4[1] : (bi == 2 ? s4[2] : s4[3]));
        const float sval = rdlane(mys, owner);
        if (lane == owner) { if (sub == 0) w0 = NINF; else if (sub == 1) w1 = NINF; else if (sub == 2) w2 = NINF; else w3 = NINF; }
        if (lane == k) { my_e = idx; my_s = sval; }
    }
    float sum = (lane < 8) ? my_s : 0.f;
    sum += dppf<DPP_X1>(sum); sum += dppf<DPP_X2>(sum); sum += dppf<DPP_HM>(sum);
    e_out = my_e; g_out = my_s / sum * 2.5f;
}

DI void p3a_ssm(const Params& P, char* lds) {
    const int tid = opaque_tid(), lane = tid & 63, wid = tid >> 6;
    float* buf = (float*)(lds + wid * SSM_WAVE_LDS);
    const float* ABARL = (const float*)(P.ws + WS_ABARL); const float* E = (const float*)(P.ws + WS_E);
    for (int wt = blockIdx.x * 8 + wid; wt < 8192; wt += gridDim.x * 8) {
        const int g = wt & 31, kk = (wt >> 5) & 63, b = wt >> 11, k = (b & 1) ? 63 - kk : kk;
        const float lr = ABARL[g * 128 + lane], li = ABARL[g * 128 + 64 + lane];
        float cr = 0.f, ci = 0.f;
        for (int k0 = 0; k0 < k; k0 += 8) {
            float er[8], ei[8];
#pragma unroll
            for (int j = 0; j < 8; ++j) { const bool ok = (k0 + j) < k; const float* ep = E + (size_t)((b * 64 + (ok ? k0 + j : 0)) * 32 + g) * 128; er[j] = ep[lane]; ei[j] = ep[64 + lane]; }
#pragma unroll
            for (int j = 0; j < 8; ++j) if (k0 + j < k) { const float nr = lr * cr - li * ci + er[j], ni = lr * ci + li * cr + ei[j]; cr = nr; ci = ni; }
        }
        ssm_task<true>(P, buf, b, k, g, lane, cr, ci);
    }
}
struct EpiGluE {
    static constexpr bool MID = false, PREP = false;
    const bf16_t* ygl; bf16_t* merged; const float* bglu; float* ssq;
    DI void operator()(const f32x4 (&acc)[2][2][4][2], const pg8::Unit& u, int wr, int wc, int fr, int fq) const {
        f32x4 bv[2][2];
#pragma unroll
        for (int bj = 0; bj < 2; ++bj)
#pragma unroll
            for (int n = 0; n < 2; ++n) bv[bj][n] = *(const f32x4*)(bglu + 256 * u.pn + 128 * bj + 32 * wc + 8 * fq + 4 * n);
#pragma unroll
        for (int ai = 0; ai < 2; ++ai)
#pragma unroll
            for (int m = 0; m < 4; ++m) {
                const size_t row = (size_t)256 * u.pm + 128 * ai + 64 * wr + 16 * m + fr; float ss = 0.f;
#pragma unroll
                for (int bj = 0; bj < 2; ++bj) {
                    const int col = 256 * u.pn + 128 * bj + 32 * wc + 8 * fq; const u32x4 yw = *(const u32x4*)(ygl + row * 512 + col);
                    const f32x4 z0 = acc[ai][bj][m][0] + bv[bj][0], z1 = acc[ai][bj][m][1] + bv[bj][1];
                    const float o0 = bflo(yw[0]) * sigmoidf_(z0[0]), o1 = bfhi(yw[0]) * sigmoidf_(z0[1]), o2 = bflo(yw[1]) * sigmoidf_(z0[2]), o3 = bfhi(yw[1]) * sigmoidf_(z0[3]);
                    const float o4 = bflo(yw[2]) * sigmoidf_(z1[0]), o5 = bfhi(yw[2]) * sigmoidf_(z1[1]), o6 = bflo(yw[3]) * sigmoidf_(z1[2]), o7 = bfhi(yw[3]) * sigmoidf_(z1[3]);
                    ss += (o0 * o0 + o1 * o1) + (o2 * o2 + o3 * o3) + (o4 * o4 + o5 * o5) + (o6 * o6 + o7 * o7);
                    *(u32x4*)(merged + row * 1024 + 512 + col) = (u32x4){pk2(o0, o1), pk2(o2, o3), pk2(o4, o5), pk2(o6, o7)};
                }
                ss = xsum16(ss); ss = xsum32(ss);
                if (fq == 0) ssq[row * 8 + u.pn * 4 + wc] = ss;
                asm volatile("" ::: "memory");
            }
    }
};
DI void p3b_glu(const Params& P, char* lds) {
    pg8::DenseOrder S; S.init(P.ws + WS_YGL, P.ws + WS_WGLU, T, 512, 512, gridDim.x, blockIdx.x);
    EpiGluE E{(const bf16_t*)(P.ws + WS_YGL), (bf16_t*)(P.ws + WS_MERGED), P.b_glu, (float*)(P.ws + WS_SSQ)};
    pg8::gemm_phase<EpiGluE, pg8::DenseOrder, false>((LAS unsigned char*)lds, 512, S, E);
}
struct EpiResidE {
    static constexpr bool MID = false, PREP = false;
    bf16_t* io; const float* ada; int goff;
    DI void operator()(const f32x4 (&acc)[2][2][4][2], const pg8::Unit& u, int wr, int wc, int fr, int fq) const {
        const float* gate = ada + ((256 * u.pm) >> 13) * 6144 + goff + 256 * u.pn + 32 * wc + 8 * fq;
        f32x4 gv[2][2];
#pragma unroll
        for (int bj = 0; bj < 2; ++bj)
#pragma unroll
            for (int n = 0; n < 2; ++n) gv[bj][n] = *(const f32x4*)(gate + 128 * bj + 4 * n);
#pragma unroll
        for (int ai = 0; ai < 2; ++ai)
#pragma unroll
            for (int m = 0; m < 4; ++m) {
                bf16_t* p = io + ((size_t)256 * u.pm + 128 * ai + 64 * wr + 16 * m + fr) * 1024 + 256 * u.pn + 32 * wc + 8 * fq; u32x4 xw[2];
#pragma unroll
                for (int bj = 0; bj < 2; ++bj) xw[bj] = *(const u32x4*)(p + 128 * bj);
#pragma unroll
                for (int bj = 0; bj < 2; ++bj) {
                    const f32x4 a0 = acc[ai][bj][m][0] * gv[bj][0], a1 = acc[ai][bj][m][1] * gv[bj][1]; const u32x4 w = xw[bj];
                    *(u32x4*)(p + 128 * bj) = (u32x4){pk2(ALPHA * bflo(w[0]) + a0[0], ALPHA * bfhi(w[0]) + a0[1]), pk2(ALPHA * bflo(w[1]) + a0[2], ALPHA * bfhi(w[1]) + a0[3]),
                                                      pk2(ALPHA * bflo(w[2]) + a1[0], ALPHA * bfhi(w[2]) + a1[1]), pk2(ALPHA * bflo(w[3]) + a1[2], ALPHA * bfhi(w[3]) + a1[3])};
                }
                asm volatile("" ::: "memory");
            }
    }
};
struct EpiOutProjE {
    static constexpr bool MID = true, PREP = true;
    const float* x; bf16_t* out; const float* ada; const float* attsq; const float* ssq; LAS float* tab;
    DI void prep(const pg8::Unit& u, int tid) const {
        if (tid < 256) {
            const size_t row = (size_t)256 * u.pm + tid;
            const f32x4 p0 = *(const f32x4*)(attsq + row * 8), p1 = *(const f32x4*)(attsq + row * 8 + 4), q0 = *(const f32x4*)(ssq + row * 8), q1 = *(const f32x4*)(ssq + row * 8 + 4);
            const float ra = rsqrtf((((p0[0] + p0[1]) + (p0[2] + p0[3])) + ((p1[0] + p1[1]) + (p1[2] + p1[3]))) * (1.f / 512.f) + EPS);
            const float rs = rsqrtf((((q0[0] + q0[1]) + (q0[2] + q0[3])) + ((q1[0] + q1[1]) + (q1[2] + q1[3]))) * (1.f / 512.f) + EPS);
            *(LAS f32x2*)(tab + (u.aux * 256 + tid) * 2) = (f32x2){ra, rs};
        }
    }
    DI void mid(f32x4 (&acc)[2][2][4][2], const pg8::Unit& u, int wr, int wc, int fr, int fq) const {
#pragma unroll
        for (int ai = 0; ai < 2; ++ai)
#pragma unroll
            for (int m = 0; m < 4; ++m) {
                const f32x2 r2 = *(const LAS f32x2*)(tab + (u.aux * 256 + 128 * ai + 64 * wr + 16 * m + fr) * 2); const float f = r2[0] * __builtin_amdgcn_rcpf(r2[1]);
#pragma unroll
                for (int bj = 0; bj < 2; ++bj)
#pragma unroll
                    for (int n = 0; n < 2; ++n) acc[ai][bj][m][n] *= f;
            }
    }
    DI void operator()(const f32x4 (&acc)[2][2][4][2], const pg8::Unit& u, int wr, int wc, int fr, int fq) const {
        const float* gate = ada + ((256 * u.pm) >> 13) * 6144 + 2048 + 256 * u.pn + 32 * wc + 8 * fq;
        f32x4 gv[2][2];
#pragma unroll
        for (int bj = 0; bj < 2; ++bj)
#pragma unroll
            for (int n = 0; n < 2; ++n) gv[bj][n] = *(const f32x4*)(gate + 128 * bj + 4 * n);
#pragma unroll
        for (int ai = 0; ai < 2; ++ai)
#pragma unroll
            for (int m = 0; m < 4; ++m) {
                const int rl = 128 * ai + 64 * wr + 16 * m + fr; const size_t row = (size_t)256 * u.pm + rl; const size_t o = row * 1024 + 256 * u.pn + 32 * wc + 8 * fq; f32x4 xv[2][2];
                const float r_s = tab[(u.aux * 256 + rl) * 2 + 1];
#pragma unroll
                for (int bj = 0; bj < 2; ++bj)
#pragma unroll
                    for (int n = 0; n < 2; ++n) xv[bj][n] = *(const f32x4*)(x + o + 128 * bj + 4 * n);
#pragma unroll
                for (int bj = 0; bj < 2; ++bj) {
                    const f32x4 v0 = ALPHA * xv[bj][0] + (gv[bj][0] * r_s) * acc[ai][bj][m][0], v1 = ALPHA * xv[bj][1] + (gv[bj][1] * r_s) * acc[ai][bj][m][1];
                    *(u32x4*)(out + o + 128 * bj) = (u32x4){pk2(v0[0], v0[1]), pk2(v0[2], v0[3]), pk2(v1[0], v1[1]), pk2(v1[2], v1[3])};
                }
                asm volatile("" ::: "memory");
            }
    }
};
DI void p3d_outproj(const Params& P, char* lds) {
    pg8::DenseOrder S; S.init(P.ws + WS_MERGED, P.ws + WS_WOUT, T, 1024, 1024, gridDim.x, blockIdx.x);
    EpiOutProjE E{P.x, (bf16_t*)(P.ws + WS_XZ), (const float*)(P.ws + WS_ADA), (const float*)(P.ws + WS_ATTSQ), (const float*)(P.ws + WS_SSQ), (LAS float*)((LAS unsigned char*)lds + P5TAB_OFF)};
    pg8::gemm_phase<EpiOutProjE, pg8::DenseOrder, false>((LAS unsigned char*)lds, 1024, S, E);
}
DI void p3e_ln1(const Params& P) {
    const int tid = opaque_tid(), lane = tid & 63, wid = tid >> 6;
    bf16_t* H2 = (bf16_t*)(P.ws + WS_H2); bf16_t* XZ = (bf16_t*)(P.ws + WS_XZ);
    for (int row = blockIdx.x * 8 + wid; row < T; row += gridDim.x * 8) {
        const float* ADA = (const float*)(P.ws + WS_ADA) + (row >> 13) * 6144;
        bf16_t* vp = XZ + (size_t)row * 1024 + 8 * lane; float v[16]; float s = 0.f;
#pragma unroll
        for (int j = 0; j < 2; ++j) { const u32x4 w = *(const u32x4*)(vp + 512 * j);
#pragma unroll
            for (int i = 0; i < 4; ++i) { v[8 * j + 2 * i] = bflo(w[i]); v[8 * j + 2 * i + 1] = bfhi(w[i]); s += v[8 * j + 2 * i] + v[8 * j + 2 * i + 1]; } }
        const float mean = wave_sum(s) * (1.f / 1024.f); float q = 0.f;
#pragma unroll
        for (int i = 0; i < 16; ++i) { v[i] -= mean; q += v[i] * v[i]; }
        const float rstd = rsqrtf(wave_sum(q) * (1.f / 1024.f) + EPS);
#pragma unroll
        for (int j = 0; j < 2; ++j) {
            const int col = 8 * lane + 512 * j; float x1[8], hv[8];
#pragma unroll
            for (int i = 0; i < 2; ++i) {
                const f32x4 g = *(const f32x4*)(P.ln1_g + col + 4 * i), bb = *(const f32x4*)(P.ln1_b + col + 4 * i), sc2 = *(const f32x4*)(ADA + 4096 + col + 4 * i), sh2 = *(const f32x4*)(ADA + 3072 + col + 4 * i);
#pragma unroll
                for (int t = 0; t < 4; ++t) { x1[4 * i + t] = v[8 * j + 4 * i + t] * rstd * g[t] + bb[t]; hv[4 * i + t] = x1[4 * i + t] * (1.f + sc2[t]) + sh2[t]; }
            }
            *(u32x4*)(vp + 512 * j) = (u32x4){pk2(x1[0], x1[1]), pk2(x1[2], x1[3]), pk2(x1[4], x1[5]), pk2(x1[6], x1[7])};
            *(u32x4*)(H2 + (size_t)row * 1024 + col) = (u32x4){pk2(hv[0], hv[1]), pk2(hv[2], hv[3]), pk2(hv[4], hv[5]), pk2(hv[6], hv[7])};
        }
    }
}
struct EpiRouterSharedE {
    static constexpr bool MID = false, PREP = false;
    float* sc; bf16_t* hids;
    DI void operator()(const f32x4 (&acc)[2][2][4][2], const pg8::Unit& u, int wr, int wc, int fr, int fq) const {
#pragma unroll
        for (int ai = 0; ai < 2; ++ai)
#pragma unroll
            for (int m = 0; m < 4; ++m) {
                const size_t row = (size_t)256 * u.pm + 128 * ai + 64 * wr + 16 * m + fr;
                if (u.pn == 0) {
#pragma unroll
                    for (int bj = 0; bj < 2; ++bj)
#pragma unroll
                        for (int n = 0; n < 2; ++n) { const f32x4 v = acc[ai][bj][m][n]; *(f32x4*)(sc + row * 256 + 128 * bj + 32 * wc + 8 * fq + 4 * n) = (f32x4){sigmoidf_(v[0]), sigmoidf_(v[1]), sigmoidf_(v[2]), sigmoidf_(v[3])}; }
                } else {
                    const f32x4 g0 = acc[ai][0][m][0], g1 = acc[ai][0][m][1], u0 = acc[ai][1][m][0], u1 = acc[ai][1][m][1];
                    *(u32x4*)(hids + row * 256 + 128 * (u.pn - 1) + 32 * wc + 8 * fq) = (u32x4){pk2(siluf_(g0[0]) * u0[0], siluf_(g0[1]) * u0[1]), pk2(siluf_(g0[2]) * u0[2], siluf_(g0[3]) * u0[3]),
                                                                                                 pk2(siluf_(g1[0]) * u1[0], siluf_(g1[1]) * u1[1]), pk2(siluf_(g1[2]) * u1[2], siluf_(g1[3]) * u1[3])};
                }
                asm volatile("" ::: "memory");
            }
    }
};
DI void p3f_router_shared(const Params& P, char* lds) {
    pg8::DenseOrder S; S.init(P.ws + WS_H2, P.ws + WS_WR, T, 768, 1024, gridDim.x, blockIdx.x);
    EpiRouterSharedE E{(float*)(P.ws + WS_SCORES), (bf16_t*)(P.ws + WS_HIDS)};
    pg8::gemm_phase<EpiRouterSharedE, pg8::DenseOrder, false>((LAS unsigned char*)lds, 1024, S, E);
    const int nb = fill_blocks(), G = gridDim.x;
    if (nb > 0 && nb < G && (int)blockIdx.x >= G - nb) conv_experts_block(P, lds, CONV_NT - nb * FILL_TILES_PER_WG + ((int)blockIdx.x - (G - nb)), CONV_NT, nb);
}
DI void p3g_route_shared_down(const Params& P, char* lds) {
    const int tid = opaque_tid(), lane = tid & 63, wid = tid >> 6;
    int* hist = (int*)(lds + P5TAB_OFF); int* base = hist + 256; int* hist2 = base + 256; int* rt_e = hist2 + 256; float* rt_g = (float*)(rt_e + 1024);
    for (int pm = blockIdx.x; pm < 256; pm += gridDim.x) {
        const int row0 = pm * 128; const float* SC = (const float*)(P.ws + WS_SCORES) + (size_t)row0 * 256;
        __syncthreads();
        if (tid < 256) hist[tid] = 0;
        __syncthreads();
        for (int tl = wid * 16; tl < wid * 16 + 16; ++tl) {
            int e; float gte; route_token(SC + (size_t)tl * 256, P.router_bias, lane, e, gte);
            if (lane < 8) { rt_e[tl * 8 + lane] = e; rt_g[tl * 8 + lane] = gte; atomicAdd(&hist[e], 1); }
        }
        __syncthreads();
        if (tid < 256) { const int cnt = hist[tid]; base[tid] = cnt ? atomicAdd((int*)(P.ws + WS_CNT) + tid, cnt) : 0; hist2[tid] = 0; }
        __syncthreads();
        for (int a = tid; a < 1024; a += NTHR) {
            const int e = rt_e[a]; const int pos = base[e] + atomicAdd(&hist2[e], 1); const int slot = (row0 + (a >> 3)) * 8 + (a & 7);
            ((int*)(P.ws + WS_BINS))[(size_t)e * T + pos] = slot; ((float*)(P.ws + WS_BING))[(size_t)e * T + pos] = rt_g[a]; ((int*)(P.ws + WS_EIDX))[slot] = e; ((int*)(P.ws + WS_EPOS))[slot] = pos;
        }
    }
    __syncthreads();
    pg8::DenseOrder S; S.init(P.ws + WS_HIDS, P.ws + WS_WSD, T, 1024, 256, gridDim.x, blockIdx.x);
    EpiResidE E{(bf16_t*)(P.ws + WS_XZ), (const float*)(P.ws + WS_ADA), 5120};
    pg8::gemm_phase<EpiResidE, pg8::DenseOrder, false>((LAS unsigned char*)lds, 256, S, E);
}

DI void moe_tables(const Params& P, char* lds) {
    LAS int* tstart = (LAS int*)((LAS unsigned char*)lds + P5TAB_OFF); LAS int* estart = tstart + 260;
    const int tid = opaque_tid();
    if (tid < 64) {
        const int* gc = (const int*)(P.ws + WS_CNT) + 4 * tid; const int c0 = gc[0], c1 = gc[1], c2 = gc[2], c3 = gc[3];
        const int t0 = (c0 + 255) >> 8, t1 = (c1 + 255) >> 8, t2 = (c2 + 255) >> 8, t3 = (c3 + 255) >> 8;
        int cs = c0 + c1 + c2 + c3, ts = t0 + t1 + t2 + t3; const int cown = cs, town = ts;
#pragma unroll
        for (int o = 1; o < 64; o <<= 1) { const int a = __shfl_up(cs, o), b = __shfl_up(ts, o); if (tid >= o) { cs += a; ts += b; } }
        int ce = cs - cown, te = ts - town;
        estart[4 * tid] = ce; tstart[4 * tid] = te; ce += c0; te += t0; estart[4 * tid + 1] = ce; tstart[4 * tid + 1] = te; ce += c1; te += t1;
        estart[4 * tid + 2] = ce; tstart[4 * tid + 2] = te; ce += c2; te += t2; estart[4 * tid + 3] = ce; tstart[4 * tid + 3] = te;
        if (tid == 63) { estart[256] = cs; tstart[256] = ts; }
    }
    __syncthreads();
}
struct MoeOrder {
    static constexpr bool RAGGED = true;
    const LAS int* tstart; const LAS int* estart; const char* Abase; const char* Bbase; const int* bins; int nunits, per, G, vb, mode;
    DI bool next(int i, pg8::Unit& u) const {
        const long L = (long)i * G + vb; if (L >= (long)nunits) return false;
        const int tile = (int)(L / per), sub = (int)(L % per);
        int lo = 0, hi = NEXP;
        while (hi - lo > 1) { const int mid = (lo + hi) >> 1; if (tstart[mid] <= tile) lo = mid; else hi = mid; }
        const int e = lo, rb = tile - tstart[e], cnt = estart[e + 1] - estart[e];
        u.rows = (cnt - 256 * rb) < 256 ? (cnt - 256 * rb) : 256; u.pm = estart[e] + 256 * rb; u.pn = sub; u.aux = e * T + 256 * rb;
        if (mode == 0) { u.A = Abase; u.B = Bbase + ((size_t)e * 512 + 256 * sub) * 2048; }
        else { u.A = Abase + (size_t)u.pm * 512; u.B = Bbase + ((size_t)e * 1024 + 256 * sub) * 512; }
        return true;
    }
    DI unsigned row_off(const pg8::Unit& u, int r) const { const int v = bins[u.aux + (r < u.rows ? r : u.rows - 1)]; return (unsigned)(v >> 3) * 2048u; }
};
struct EpiGateUp {
    static constexpr bool MID = false, PREP = false;
    bf16_t* H; const float* bing;
    DI void operator()(const f32x4 (&acc)[2][2][4][2], const pg8::Unit& u, int wr, int wc, int fr, int fq) const {
        float gt[2][4];
#pragma unroll
        for (int ai = 0; ai < 2; ++ai)
#pragma unroll
            for (int m = 0; m < 4; ++m) { const int r = 128 * ai + 64 * wr + 16 * m + fr; gt[ai][m] = bing[u.aux + (r < u.rows ? r : u.rows - 1)]; }
#pragma unroll
        for (int ai = 0; ai < 2; ++ai)
#pragma unroll
            for (int m = 0; m < 4; ++m) {
                const int r = 128 * ai + 64 * wr + 16 * m + fr; const float g = gt[ai][m];
                const f32x4 g0 = acc[ai][0][m][0], g1 = acc[ai][0][m][1], u0 = acc[ai][1][m][0], u1 = acc[ai][1][m][1];
                const u32x4 w = (u32x4){pk2(siluf_(g0[0]) * u0[0] * g, siluf_(g0[1]) * u0[1] * g), pk2(siluf_(g0[2]) * u0[2] * g, siluf_(g0[3]) * u0[3] * g),
                                        pk2(siluf_(g1[0]) * u1[0] * g, siluf_(g1[1]) * u1[1] * g), pk2(siluf_(g1[2]) * u1[2] * g, siluf_(g1[3]) * u1[3] * g)};
                if (r < u.rows) *(u32x4*)(H + (size_t)(u.pm + r) * 256 + 128 * u.pn + 32 * wc + 8 * fq) = w;
                asm volatile("" ::: "memory");
            }
    }
};
struct EpiDown {
    static constexpr bool MID = false, PREP = false;
    unsigned char* OA; unsigned char* OB;
    DI void operator()(const f32x4 (&acc)[2][2][4][2], const pg8::Unit& u, int wr, int wc, int fr, int fq) const {
#pragma unroll
        for (int ai = 0; ai < 2; ++ai)
#pragma unroll
            for (int m = 0; m < 4; ++m) {
                const int r = 128 * ai + 64 * wr + 16 * m + fr;
                if (r < u.rows) {
                    const int pos = u.pm + r; unsigned char* rowp = (pos < T * 4 ? OA + (size_t)pos * 1024 : OB + (size_t)(pos - T * 4) * 1024) + 256 * u.pn + 64 * wc + 16 * fq;
                    int pk[4];
#pragma unroll
                    for (int bj = 0; bj < 2; ++bj) {
                        f32x4 v0 = acc[ai][bj][m][0] * OUT_SCALE, v1 = acc[ai][bj][m][1] * OUT_SCALE;
#pragma unroll
                        for (int i = 0; i < 4; ++i) { v0[i] = fminf(fmaxf(v0[i], -448.f), 448.f); v1[i] = fminf(fmaxf(v1[i], -448.f), 448.f); }
                        int lo = 0, hi = 0;
                        lo = __builtin_amdgcn_cvt_pk_fp8_f32(v0[0], v0[1], lo, false); lo = __builtin_amdgcn_cvt_pk_fp8_f32(v0[2], v0[3], lo, true);
                        hi = __builtin_amdgcn_cvt_pk_fp8_f32(v1[0], v1[1], hi, false); hi = __builtin_amdgcn_cvt_pk_fp8_f32(v1[2], v1[3], hi, true);
                        pk[2 * bj] = lo; pk[2 * bj + 1] = hi;
                    }
                    *(u32x4*)rowp = (u32x4){(unsigned)pk[0], (unsigned)pk[1], (unsigned)pk[2], (unsigned)pk[3]};
                }
                asm volatile("" ::: "memory");
            }
    }
};
DI int xcd_vb() { const int G = gridDim.x; return (G % 8 == 0) ? (int)(blockIdx.x % 8) * (G / 8) + (int)(blockIdx.x / 8) : (int)blockIdx.x; }
DI void p5a_gateup(const Params& P, char* lds) {
    moe_tables(P, lds);
    const LAS int* tstart = (const LAS int*)((LAS unsigned char*)lds + P5TAB_OFF);
    MoeOrder S{tstart, tstart + 260, (const char*)(P.ws + WS_H2), (const char*)(P.ws + WS_WEGU), (const int*)(P.ws + WS_BINS), tstart[256] * 2, 2, (int)gridDim.x, xcd_vb(), 0};
    EpiGateUp E{(bf16_t*)(P.ws + WS_HIDALL), (const float*)(P.ws + WS_BING)};
    pg8::gemm_phase<EpiGateUp, MoeOrder, true>((LAS unsigned char*)lds, 1024, S, E);
}
DI void p5b_down(const Params& P, char* lds) {
    const LAS int* tstart = (const LAS int*)((LAS unsigned char*)lds + P5TAB_OFF);
    MoeOrder S{tstart, tstart + 260, (const char*)(P.ws + WS_HIDALL), (const char*)(P.ws + WS_WED), (const int*)(P.ws + WS_BINS), tstart[256] * 4, 4, (int)gridDim.x, xcd_vb(), 1};
    EpiDown E{P.ws + WS_OUTA, P.ws + WS_OUTB};
    pg8::gemm_phase<EpiDown, MoeOrder, false>((LAS unsigned char*)lds, 256, S, E);
}

DI void p6_combine(const Params& P, char* lds) {
    const LAS int* estart = (const LAS int*)((LAS unsigned char*)lds + P5TAB_OFF) + 260;
    const int tid = opaque_tid(), lane = tid & 63, wid = tid >> 6;
    const unsigned char* OA = P.ws + WS_OUTA; const unsigned char* OB = P.ws + WS_OUTB;
    for (int row = blockIdx.x * 8 + wid; row < T; row += gridDim.x * 8) {
        const float* ADA = (const float*)(P.ws + WS_ADA) + (row >> 13) * 6144 + 5120;
        int mypos = 0;
        if (lane < 8) { const int e = ((const int*)(P.ws + WS_EIDX))[row * 8 + lane]; mypos = estart[e] + ((const int*)(P.ws + WS_EPOS))[row * 8 + lane]; }
        u32x4 w[8];
#pragma unroll
        for (int s = 0; s < 8; ++s) { const int pos = __builtin_amdgcn_readlane(mypos, s); w[s] = *(const u32x4*)((pos < T * 4 ? OA + (size_t)pos * 1024 : OB + (size_t)(pos - T * 4) * 1024) + lane * 16); }
        float f[16];
#pragma unroll
        for (int i = 0; i < 16; ++i) f[i] = 0.f;
#pragma unroll
        for (int s = 0; s < 8; ++s)
#pragma unroll
            for (int q = 0; q < 4; ++q) { const f32x2 a = __builtin_amdgcn_cvt_pk_f32_fp8((int)w[s][q], false), bb = __builtin_amdgcn_cvt_pk_f32_fp8((int)w[s][q], true);
                f[4 * q] += a[0]; f[4 * q + 1] += a[1]; f[4 * q + 2] += bb[0]; f[4 * q + 3] += bb[1]; }
        float* op = P.out + (size_t)row * 1024 + 16 * lane; float z[16]; float sm = 0.f;
        const bf16_t* zp = (const bf16_t*)(P.ws + WS_XZ) + (size_t)row * 1024 + 16 * lane; const u32x4 zw0 = *(const u32x4*)zp, zw1 = *(const u32x4*)(zp + 8);
#pragma unroll
        for (int i = 0; i < 4; ++i) { const f32x4 g = *(const f32x4*)(ADA + 16 * lane + 4 * i); const unsigned wa = (i < 2 ? zw0 : zw1)[2 * (i & 1)], wb = (i < 2 ? zw0 : zw1)[2 * (i & 1) + 1];
            const f32x4 zs = (f32x4){bflo(wa), bfhi(wa), bflo(wb), bfhi(wb)};
#pragma unroll
            for (int q = 0; q < 4; ++q) { const float v = zs[q] + g[q] * (f[4 * i + q] * (1.f / OUT_SCALE)); z[4 * i + q] = v; sm += v; } }
        const float mean = wave_sum(sm) * (1.f / 1024.f); float qv = 0.f;
#pragma unroll
        for (int i = 0; i < 16; ++i) { z[i] -= mean; qv += z[i] * z[i]; }
        const float rstd = rsqrtf(wave_sum(qv) * (1.f / 1024.f) + EPS);
#pragma unroll
        for (int i = 0; i < 4; ++i) { const f32x4 g = *(const f32x4*)(P.ln2_g + 16 * lane + 4 * i), bb = *(const f32x4*)(P.ln2_b + 16 * lane + 4 * i);
            *(f32x4*)(op + 4 * i) = (f32x4){z[4 * i] * rstd * g[0] + bb[0], z[4 * i + 1] * rstd * g[1] + bb[1], z[4 * i + 2] * rstd * g[2] + bb[2], z[4 * i + 3] * rstd * g[3] + bb[3]}; }
    }
}

__global__ void __launch_bounds__(NTHR) fwd_megakernel(Params P) {
    extern __shared__ __attribute__((aligned(16))) char lds[];
    volatile LAS unsigned* bst = (volatile LAS unsigned*)((LAS unsigned char*)lds + BARLDS_OFF);
    if (threadIdx.x < 2) bst[threadIdx.x] = 0u;
    __syncthreads();
    const XcdBarrier bar = xcd_barrier_post((unsigned*)(P.ws + WS_BAR), bst);
    p0_prologue(P, lds);
    xcd_barrier(bar);
    p1_inproj_and_experts(P, lds);
    xcd_barrier(bar);
    p2_mixer(P, lds);
    xcd_barrier(bar);
    p3a_ssm(P, lds);
    xcd_barrier(bar);
    p3b_glu(P, lds);
    xcd_barrier(bar);
    p3d_outproj(P, lds);
    xcd_barrier(bar);
    p3e_ln1(P);
    xcd_barrier(bar);
    p3f_router_shared(P, lds);
    xcd_barrier(bar);
    p3g_route_shared_down(P, lds);
    xcd_barrier(bar);
    p5a_gateup(P, lds);
    xcd_barrier(bar);
    p5b_down(P, lds);
    xcd_barrier(bar);
    p6_combine(P, lds);
}


#ifdef ANALYZE_PHASES
template <int PH> __global__ void __launch_bounds__(NTHR) phase_kernel(Params P) {
    extern __shared__ __attribute__((aligned(16))) char lds[];
    if (PH == 0) p0_prologue(P, lds);
    if (PH == 1) p1_inproj_and_experts(P, lds);
    if (PH == 2) p2_mixer(P, lds);
    if (PH == 3) p3a_ssm(P, lds);
    if (PH == 7) p3b_glu(P, lds);
    if (PH == 9) p3d_outproj(P, lds);
    if (PH == 10) p3e_ln1(P);
    if (PH == 11) p3f_router_shared(P, lds);
    if (PH == 12) p3g_route_shared_down(P, lds);
    if (PH == 4) p5a_gateup(P, lds);
    if (PH == 5) p5b_down(P, lds);
    if (PH == 6) p6_combine(P, lds);
}
template __global__ void phase_kernel<0>(Params); template __global__ void phase_kernel<1>(Params); template __global__ void phase_kernel<2>(Params); template __global__ void phase_kernel<3>(Params);
template __global__ void phase_kernel<4>(Params); template __global__ void phase_kernel<5>(Params); template __global__ void phase_kernel<6>(Params);
template __global__ void phase_kernel<7>(Params); template __global__ void phase_kernel<8>(Params); template __global__ void phase_kernel<9>(Params); template __global__ void phase_kernel<10>(Params); template __global__ void phase_kernel<11>(Params); template __global__ void phase_kernel<12>(Params);
#endif

extern "C" void kernel_launch(void* const* d_in, const int* in_sizes, int n_in, void* d_out, int out_size, void* d_ws, size_t ws_size, hipStream_t stream) {
    static int grid = 0;
    if (grid == 0) {
        if (n_in != 31 || out_size != T * D || ws_size < WS_END) { fprintf(stderr, "kernel_launch: unexpected problem (n_in %d, out %d, ws %zu < %zu)\n", n_in, out_size, ws_size, (size_t)WS_END); grid = -1; return; }
        int dev = 0, cus = 0, per_cu = 0;
        (void)hipGetDevice(&dev); (void)hipDeviceGetAttribute(&cus, hipDeviceAttributeMultiprocessorCount, dev);
        (void)hipFuncSetAttribute((const void*)fwd_megakernel, hipFuncAttributeMaxDynamicSharedMemorySize, LDS_BYTES);
        (void)hipOccupancyMaxActiveBlocksPerMultiprocessor(&per_cu, (const void*)fwd_megakernel, NTHR, LDS_BYTES);
        if (per_cu < 1) { fprintf(stderr, "kernel_launch: occupancy query says %d blocks per CU\n", per_cu); grid = -1; return; }
        grid = cus * 1;
        if (grid > 256) grid = 256;
    }
    if (grid < 0) return;
    (void)hipMemsetAsync(d_ws, 0, 65536, stream);
    Params p{};
    const float** pf = (const float**)&p;
    for (int i = 0; i < 31; ++i) pf[i] = (const float*)d_in[i];
    p.out = (float*)d_out; p.ws = (unsigned char*)d_ws;
    void* args[] = {&p};
    hipError_t e = hipLaunchCooperativeKernel((const void*)fwd_megakernel, dim3(grid), dim3(NTHR), args, LDS_BYTES, stream);
    if (e != hipSuccess) fprintf(stderr, "cooperative launch failed: %s (grid %d)\n", hipGetErrorString(e), grid);
}
```

```cpp
#include <hip/hip_runtime.h>
#include <cstdio>
#include <cstdint>

#define DI __device__ __forceinline__
typedef unsigned short bf16_t;
typedef short bf16x8 __attribute__((ext_vector_type(8)));
typedef float f32x2 __attribute__((ext_vector_type(2)));
typedef float f32x4 __attribute__((ext_vector_type(4)));
typedef float f32x16 __attribute__((ext_vector_type(16)));
typedef unsigned u32x2 __attribute__((ext_vector_type(2)));
typedef unsigned u32x4 __attribute__((ext_vector_type(4)));
typedef __bf16 bf16v2 __attribute__((ext_vector_type(2)));

#define MFMA16(a, b, c) __builtin_amdgcn_mfma_f32_16x16x32_bf16((a), (b), (c), 0, 0, 0)
#define MFMA32(a, b, c) __builtin_amdgcn_mfma_f32_32x32x16_bf16((a), (b), (c), 0, 0, 0)
#define LDS_FENCE() asm volatile("s_waitcnt lgkmcnt(0)" ::: "memory")

constexpr int D = 1024, BATCH = 4, SEQ = 8192, T = BATCH * SEQ, NPROJ = 2048;
constexpr int NTHR = 512;
constexpr int NEXP = 256, TOPK = 8;
constexpr float ALPHA = 1.189207115002721f;
constexpr float EPS = 1e-5f;
constexpr float NEG = -1e30f;
constexpr float OUT_SCALE = 64.f;

constexpr size_t MiB = 1u << 20;
constexpr size_t WS_CNT = 0;
constexpr size_t WS_ADACNT = 2048;
constexpr size_t WS_BAR = 16384;
constexpr size_t WS_ADA = 64 * 1024;
constexpr size_t WS_ABAR = 192 * 1024;
constexpr size_t WS_ABARL = 208 * 1024;
constexpr size_t WS_BCAT = 256 * 1024;
constexpr size_t WS_CCAT = 384 * 1024;
constexpr size_t WS_WIN = 2 * MiB;
constexpr size_t WS_WGLU = 6 * MiB;
constexpr size_t WS_WR = 6 * MiB + 512 * 1024;
constexpr size_t WS_WSGU = 7 * MiB;
constexpr size_t WS_WOUT = 8 * MiB;
constexpr size_t WS_WSD = 10 * MiB;
constexpr size_t WS_EIDX = 11 * MiB;
constexpr size_t WS_EPOS = 12 * MiB;
constexpr size_t WS_HIDS = 14 * MiB;
constexpr size_t WS_BINS = 30 * MiB;
constexpr size_t WS_BING = 62 * MiB;
constexpr size_t WS_H2 = 94 * MiB;
constexpr size_t WS_WEGU = 158 * MiB;
constexpr size_t WS_WED = 414 * MiB;
constexpr size_t WS_H1 = 542 * MiB;
constexpr size_t WS_QKVU = 606 * MiB;
constexpr size_t WS_MERGED = 734 * MiB;
constexpr size_t WS_YGL = 798 * MiB;
constexpr size_t WS_SCORES = 830 * MiB;
constexpr size_t WS_E = 862 * MiB;
constexpr size_t WS_ATTSQ = 866 * MiB;
constexpr size_t WS_SSQ = 867 * MiB;
constexpr size_t WS_RS = 868 * MiB;
constexpr size_t WS_HIDALL = 542 * MiB;
constexpr size_t WS_OUTA = 158 * MiB;
constexpr size_t WS_OUTB = 670 * MiB;
constexpr size_t WS_XZ = 926 * MiB;
constexpr size_t WS_END = 1022 * MiB;

constexpr int LDP = 72;
constexpr int GEMM_LDS = (128 + 256) * LDP * 2;
constexpr int MISC_OFF = 57344;
constexpr int SSM_PITCH = 36;
constexpr int SSM_WAVE_LDS = 128 * SSM_PITCH * 4;
constexpr int P5TAB_OFF = 131072;
constexpr int BARLDS_OFF = 148 * 1024;
constexpr int LDS_BYTES = 148 * 1024 + 64;

struct Params {
    const float *x, *c, *rel_bias, *w_ada, *b_ada, *w_in, *a_re, *a_im, *b_re, *b_im, *c_re, *c_im, *ssm_d, *log_dt, *w_glu, *b_glu, *g_att, *g_ssm, *w_out,
        *ln1_g, *ln1_b, *w_router, *router_bias, *w_e_gate, *w_e_up, *w_e_down, *w_s_gate, *w_s_up, *w_s_down, *ln2_g, *ln2_b;
    float* out;
    unsigned char* ws;
};

DI int opaque_tid() { int t = threadIdx.x; asm volatile("" : "+v"(t)); return t; }
DI unsigned pk2(float a, float b) { f32x2 f = {a, b}; bf16v2 r = __builtin_convertvector(f, bf16v2); return __builtin_bit_cast(unsigned, r); }
DI bf16_t f2bf(float a) { return (bf16_t)(pk2(a, 0.f) & 0xffffu); }
DI float bflo(unsigned w) { return __uint_as_float(w << 16); }
DI float bfhi(unsigned w) { return __uint_as_float(w & 0xffff0000u); }
DI float sigmoidf_(float x) { return __builtin_amdgcn_rcpf(1.f + __expf(-x)); }
DI float siluf_(float x) { return x * __builtin_amdgcn_rcpf(1.f + __expf(-x)); }
DI float gelu_tanh(float x) { const float u = 0.7978845608028654f * (x + 0.044715f * x * x * x); const float e = __expf(2.f * u); const float th = 1.f - 2.f * __builtin_amdgcn_rcpf(e + 1.f); return 0.5f * x * (1.f + th); }
template <int CTRL> DI float dppf(float v) { return __builtin_bit_cast(float, __builtin_amdgcn_update_dpp(0, __builtin_bit_cast(int, v), CTRL, 0xF, 0xF, true)); }
DI float rdlane(float v, int l) { return __builtin_bit_cast(float, __builtin_amdgcn_readlane(__builtin_bit_cast(int, v), l)); }
constexpr int DPP_X1 = 0xB1, DPP_X2 = 0x4E, DPP_HM = 0x141, DPP_RM = 0x140;
DI float xsum16(float x) { auto t = __builtin_amdgcn_permlane16_swap(__float_as_uint(x), __float_as_uint(x), false, false); return __uint_as_float(t[0]) + __uint_as_float(t[1]); }
DI float xsum32(float x) { auto t = __builtin_amdgcn_permlane32_swap(__float_as_uint(x), __float_as_uint(x), false, false); return __uint_as_float(t[0]) + __uint_as_float(t[1]); }
DI float xmax32(float x) { auto t = __builtin_amdgcn_permlane32_swap(__float_as_uint(x), __float_as_uint(x), false, false); return fmaxf(__uint_as_float(t[0]), __uint_as_float(t[1])); }
DI float wave_sum(float v) {
    v += dppf<DPP_X1>(v); v += dppf<DPP_X2>(v); v += dppf<DPP_HM>(v); v += dppf<DPP_RM>(v); v = xsum16(v); return xsum32(v);
}

#define LAS __attribute__((address_space(3)))
#define XB_TMO      128
#define XB_XCNT(j)  (256  + 64 * (j))
#define XB_XSUB(j)  (1280 + 64 * (j))
#define XB_XGEN(j)  (2304 + 64 * (j))
#define XB_TOP      3328
#define XB_TOPGEN   3392
#define XB_SPIN_CAP (1u << 18)
DI unsigned xb_ld(unsigned* p) { return __hip_atomic_load(p, __ATOMIC_RELAXED, __HIP_MEMORY_SCOPE_AGENT); }
DI unsigned xb_add(unsigned* p, unsigned v) { return __hip_atomic_fetch_add(p, v, __ATOMIC_RELAXED, __HIP_MEMORY_SCOPE_AGENT); }
DI unsigned xb_xcc_id() { return (unsigned)__builtin_amdgcn_s_getreg((3 << 11) | 20) & 0xFu; }
#define XB_SPIN(cond, bar) do { unsigned _sp = 0; while (cond) { __builtin_amdgcn_s_sleep(1); \
    if ((++_sp & 255u) == 0u) { if (xb_ld(&(bar)[XB_TMO])) break; if (_sp > XB_SPIN_CAP) { atomicAdd(&(bar)[XB_TMO], 1u); break; } } } } while (0)
struct XcdBarrier { unsigned* bar; unsigned x; volatile LAS unsigned* st; };
DI XcdBarrier xcd_barrier_post(unsigned* bar, volatile LAS unsigned* st) {
    XcdBarrier b; b.bar = bar; b.x = xb_xcc_id(); b.st = st;
    if (threadIdx.x == 0) (void)xb_add(&bar[XB_XCNT(b.x)], 1u);
    return b;
}
DI void xcd_barrier_complete(unsigned* bar, unsigned x, unsigned& nloc, unsigned& nx) {
    const unsigned G = gridDim.x * gridDim.y * gridDim.z;
    unsigned sum, cnt, mine, sp = 0u;
    for (;;) {
        sum = 0u; cnt = 0u; mine = 0u;
#pragma unroll
        for (unsigned j = 0; j < 16; ++j) { const unsigned c = xb_ld(&bar[XB_XCNT(j)]); sum += c; cnt += (c > 0u) ? 1u : 0u; mine = (j == x) ? c : mine; }
        if (sum == G) break;
        __builtin_amdgcn_s_sleep(1);
        if ((++sp & 255u) == 0u) { if (xb_ld(&bar[XB_TMO])) break; if (sp > XB_SPIN_CAP) { atomicAdd(&bar[XB_TMO], 1u); break; } }
    }
    nloc = mine > 0u ? mine : 1u; nx = cnt > 0u ? cnt : 1u;
}
DI void xcd_barrier(const XcdBarrier& b) {
    asm volatile("s_waitcnt vmcnt(0)" ::: "memory");
    __syncthreads();
    if (threadIdx.x == 0) {
        unsigned* bar = b.bar;
        __builtin_amdgcn_s_waitcnt(0);
        unsigned nloc = b.st[0], nx = b.st[1];
        if (nloc == 0u) { xcd_barrier_complete(bar, b.x, nloc, nx); b.st[0] = nloc; b.st[1] = nx; }
        const unsigned old = xb_add(&bar[XB_XSUB(b.x)], 1u);
        const unsigned gen = old / nloc;
        if (old + 1u == (gen + 1u) * nloc) {
            __builtin_amdgcn_fence(__ATOMIC_RELEASE, "agent");
            asm volatile("s_waitcnt vmcnt(0)" ::: "memory");
            const unsigned og = xb_add(&bar[XB_TOP], 1u);
            const unsigned tg = og / nx;
            if (og + 1u == (tg + 1u) * nx) xb_add(&bar[XB_TOPGEN], 1u);
            else XB_SPIN(xb_ld(&bar[XB_TOPGEN]) == tg, bar);
            __builtin_amdgcn_fence(__ATOMIC_ACQUIRE, "agent");
            xb_add(&bar[XB_XGEN(b.x)], 1u);
            asm volatile("s_waitcnt vmcnt(0)" ::: "memory");
        } else {
            XB_SPIN(xb_ld(&bar[XB_XGEN(b.x)]) == gen, bar);
            __builtin_amdgcn_fence(__ATOMIC_ACQUIRE, "agent");
            asm volatile("s_waitcnt vmcnt(0)" ::: "memory");
        }
    }
    __syncthreads();
}

namespace pg8 {
constexpr int BM = 256, BK = 64, HALF = 128, HTB = HALF * BK * 2, STAGE_BYTES = 8 * HTB;
DI int lds_byte(int r, int c) { const int st = (r >> 4) * 2 + (c >> 5), rr = r & 15, cc = c & 31, ob = rr * 64 + cc * 2; return st * 1024 + (ob ^ (((ob >> 9) & 1) << 5)); }
DI void stage_rc(int b, int& R, int& C) { const int st = b / 1024, sb = b % 1024, swz = sb ^ (((sb >> 9) & 1) << 5); R = (st >> 1) * 16 + swz / 64; C = (st & 1) * 32 + (swz % 64) / 2; }
DI int perm32(int rho) { const int n = rho >> 4, i = rho & 15; return 8 * (i >> 2) + 4 * n + (i & 3); }
struct Unit { const char* A; const char* B; int pm, pn, rows, aux; };

template <class Epi, class Sched, bool GATHER>
DI void gemm_phase(LAS unsigned char* lds, const int K, const Sched& S, const Epi& E) {
    int tid = threadIdx.x; asm volatile("" : "+v"(tid));
    const int wid = __builtin_amdgcn_readfirstlane(tid >> 6), lane = tid & 63, wr = wid >> 2, wc = wid & 3, fr = lane & 15, fq = lane >> 4;
    const int nt = K / BK;
    unsigned voffA[2], voffB[2]; int Rr[2], Cc[2];
#pragma unroll
    for (int i = 0; i < 2; ++i) { int R, C; stage_rc(tid * 16 + i * 8192, R, C); const int Rb = (R & ~31) + perm32(R & 31); Rr[i] = R; Cc[i] = C;
        voffA[i] = (unsigned)(R * K + C) * 2u; voffB[i] = (unsigned)(Rb * K + C) * 2u; }
    const size_t kstep = (size_t)(BK * 2);
    const size_t hstep = (size_t)HALF * K * 2;
    const unsigned ldsw = (unsigned)wid * 1024u;
    const int aoff = lds_byte(wr * 64 + fr, fq * 8), boff = lds_byte(wc * 32 + fr, fq * 8);
#define PG8_SA(b, h) (((b) * 2 + (h)) * HTB)
#define PG8_SB(b, h) ((4 + (b) * 2 + (h)) * HTB)
#define PG8_STAGE(bufoff, gbase, voff) do { _Pragma("unroll") for (int _i = 0; _i < 2; ++_i) \
        __builtin_amdgcn_global_load_lds((const unsigned*)((const char*)(gbase) + (voff)[_i]), (LAS unsigned*)(lds + (bufoff) + ldsw + _i * 8192), 16, 0, 0); } while (0)
#define PG8_STAGEA(bufoff, gbase, h, nx) do { if constexpr (GATHER) { unsigned _o[2]; _o[0] = (nx) ? na[h][0] : ga[h][0]; _o[1] = (nx) ? na[h][1] : ga[h][1]; PG8_STAGE(bufoff, gbase, _o); } \
        else { PG8_STAGE(bufoff, (gbase) + (h) * hstep, voffA); } } while (0)
#define PG8_LDA(dst, b, h) do { _Pragma("unroll") for (int m = 0; m < 4; ++m) _Pragma("unroll") for (int k = 0; k < 2; ++k) dst[m][k] = *(const LAS bf16x8*)(lds + PG8_SA(b, h) + aoff + m * 2048 + k * 1024); } while (0)
#define PG8_LDB(dst, b, h) do { _Pragma("unroll") for (int n = 0; n < 2; ++n) _Pragma("unroll") for (int k = 0; k < 2; ++k) dst[n][k] = *(const LAS bf16x8*)(lds + PG8_SB(b, h) + boff + n * 2048 + k * 1024); } while (0)
#define PG8_MMA(ai, bj, At, Bt) do { __builtin_amdgcn_s_setprio(1); _Pragma("unroll") for (int m = 0; m < 4; ++m) _Pragma("unroll") for (int n = 0; n < 2; ++n) _Pragma("unroll") for (int k = 0; k < 2; ++k) \
        acc[ai][bj][m][n] = __builtin_amdgcn_mfma_f32_16x16x32_bf16(Bt[n][k], At[m][k], acc[ai][bj][m][n], 0, 0, 0); __builtin_amdgcn_s_setprio(0); } while (0)
#define PG8_WAIT_V(n) asm volatile("s_waitcnt vmcnt(" #n ")" ::: "memory")
#define PG8_WAIT_L(n) asm volatile("s_waitcnt lgkmcnt(" #n ")" ::: "memory")
#define PG8_BAR __builtin_amdgcn_s_barrier()
#define PG8_SCHED __builtin_amdgcn_sched_barrier(0)
    Unit cur, nxt; int ui = 0;
    if (!S.next(0, cur)) return;
    f32x4 acc[2][2][4][2];
#pragma unroll
    for (int a = 0; a < 2; ++a)
#pragma unroll
        for (int b = 0; b < 2; ++b)
#pragma unroll
            for (int m = 0; m < 4; ++m)
#pragma unroll
                for (int n = 0; n < 2; ++n) acc[a][b][m][n] = (f32x4){0.f, 0.f, 0.f, 0.f};
    bf16x8 At[4][2], B0[2][2], B1[2][2];
    const char* cA = cur.A; const char* cB = cur.B;
    if constexpr (Epi::PREP) E.prep(cur, tid);
    unsigned ga[2][2], na[2][2];
    if constexpr (GATHER) {
#pragma unroll
        for (int h = 0; h < 2; ++h)
#pragma unroll
            for (int i = 0; i < 2; ++i) { ga[h][i] = S.row_off(cur, 128 * h + Rr[i]) + (unsigned)Cc[i] * 2u; na[h][i] = ga[h][i]; }
    }
    PG8_STAGE(PG8_SB(0, 0), cB, voffB); PG8_STAGE(PG8_SB(0, 1), cB + hstep, voffB); PG8_STAGEA(PG8_SA(0, 0), cA, 0, false); PG8_STAGEA(PG8_SA(0, 1), cA, 1, false);
    if (wr == 1) PG8_BAR;
    PG8_WAIT_V(2); PG8_BAR;
    PG8_STAGE(PG8_SB(1, 0), cB + kstep, voffB); PG8_STAGEA(PG8_SA(1, 0), cA + kstep, 0, false); PG8_STAGE(PG8_SB(1, 1), cB + hstep + kstep, voffB);
    PG8_WAIT_V(6); PG8_BAR;
    for (;;) {
        const bool has_next = S.next(ui + 1, nxt);
        if constexpr (Epi::PREP) { if (has_next) E.prep(nxt, tid); }
        const char* nA = has_next ? nxt.A : cA; const char* nB = has_next ? nxt.B : cB;
        if constexpr (GATHER) {
            if (has_next) {
#pragma unroll
                for (int h = 0; h < 2; ++h)
#pragma unroll
                    for (int i = 0; i < 2; ++i) na[h][i] = S.row_off(nxt, 128 * h + Rr[i]) + (unsigned)Cc[i] * 2u;
            }
        }
        const bool do0 = !Sched::RAGGED || cur.rows > 64 * wr, do1 = !Sched::RAGGED || cur.rows > 128 + 64 * wr;
#pragma unroll 1
        for (int t = 0; t < nt; t += 2) {
            const bool last = (t == nt - 2);
            const char* a1 = cA + (size_t)(t + 1) * kstep;
            const char* a2 = last ? nA : cA + (size_t)(t + 2) * kstep; const char* b2 = last ? nB : cB + (size_t)(t + 2) * kstep;
            const char* a3 = a2 + kstep; const char* b3 = b2 + kstep;
            PG8_LDB(B0, 0, 0); PG8_LDB(B1, 0, 1); PG8_SCHED; PG8_LDA(At, 0, 0); PG8_STAGEA(PG8_SA(1, 1), a1, 1, false);
            PG8_WAIT_V(8); PG8_WAIT_L(0); PG8_BAR; if (do0) { PG8_MMA(0, 0, At, B0); PG8_MMA(0, 1, At, B1); } PG8_BAR; PG8_SCHED;
            PG8_LDA(At, 0, 1); PG8_STAGE(PG8_SB(0, 0), b2, voffB); PG8_STAGE(PG8_SB(0, 1), b2 + hstep, voffB); PG8_STAGEA(PG8_SA(0, 0), a2, 0, last);
            PG8_WAIT_V(8); PG8_WAIT_L(0); PG8_BAR; if (do1) { PG8_MMA(1, 0, At, B0); PG8_MMA(1, 1, At, B1); } PG8_BAR; PG8_SCHED;
            PG8_LDB(B0, 1, 0); PG8_LDB(B1, 1, 1); PG8_SCHED; PG8_LDA(At, 1, 0); PG8_STAGEA(PG8_SA(0, 1), a2, 1, last);
            PG8_WAIT_V(8); PG8_WAIT_L(0); PG8_BAR; if (do0) { PG8_MMA(0, 0, At, B0); PG8_MMA(0, 1, At, B1); } PG8_BAR; PG8_SCHED;
            PG8_LDA(At, 1, 1); PG8_STAGE(PG8_SB(1, 0), b3, voffB); PG8_STAGE(PG8_SB(1, 1), b3 + hstep, voffB); PG8_STAGEA(PG8_SA(1, 0), a3, 0, last);
            PG8_WAIT_V(8); PG8_WAIT_L(0); PG8_BAR; if (do1) { PG8_MMA(1, 0, At, B0); PG8_MMA(1, 1, At, B1); } PG8_BAR; PG8_SCHED;
            if constexpr (Epi::MID) { if (t == nt / 2 - 2) E.mid(acc, cur, wr, wc, fr, fq); }
        }
        if (wr == 0) PG8_BAR;
        E(acc, cur, wr, wc, fr, fq);
        if (!has_next) break;
#pragma unroll
        for (int a = 0; a < 2; ++a)
#pragma unroll
            for (int b = 0; b < 2; ++b)
#pragma unroll
                for (int m = 0; m < 4; ++m)
#pragma unroll
                    for (int n = 0; n < 2; ++n) acc[a][b][m][n] = (f32x4){0.f, 0.f, 0.f, 0.f};
        cur = nxt; cA = nA; cB = nB; ++ui;
        if constexpr (GATHER) {
#pragma unroll
            for (int h = 0; h < 2; ++h)
#pragma unroll
                for (int i = 0; i < 2; ++i) ga[h][i] = na[h][i];
        }
        if (wr == 1) PG8_BAR;
    }
    PG8_WAIT_V(0);
    PG8_BAR;
#undef PG8_SA
#undef PG8_SB
#undef PG8_STAGE
#undef PG8_STAGEA
#undef PG8_LDA
#undef PG8_LDB
#undef PG8_MMA
#undef PG8_WAIT_V
#undef PG8_WAIT_L
#undef PG8_BAR
#undef PG8_SCHED
}

struct DenseOrder {
    static constexpr bool RAGGED = false;
    const char* A; const char* Bt; int K, nM, nN, nwg, G, c;
    DI void init(const void* A_, const void* Bt_, int M, int N, int K_, int G_, int c_) { A = (const char*)A_; Bt = (const char*)Bt_; K = K_; nM = M / BM; nN = N / BM; nwg = nM * nN; G = G_; c = c_; }
    DI bool next(int i, Unit& u) const {
        const long L = (long)i * G + c; if (L >= nwg) return false;
        int wgid = (int)L; { const int q = nwg / 8, r = nwg % 8, xcd = wgid % 8, off = wgid / 8; wgid = (xcd < r ? xcd * (q + 1) : r * (q + 1) + (xcd - r) * q) + off; }
        const int nig = 8 * nN, gid = wgid / nig, fm = gid * 8, gsz = (nM - fm) < 8 ? (nM - fm) : 8;
        u.pm = fm + ((wgid % nig) % gsz); u.pn = (wgid % nig) / gsz; u.rows = 256; u.aux = i % 3;
        u.A = A + (size_t)u.pm * 256 * K * 2; u.B = Bt + (size_t)u.pn * 256 * K * 2; return true;
    }
    DI unsigned row_off(const Unit&, int) const { return 0u; }
};
struct EpiStoreBf16 {
    static constexpr bool MID = false, PREP = false;
    bf16_t* O; int ld;
    DI void operator()(const f32x4 (&acc)[2][2][4][2], const Unit& u, int wr, int wc, int fr, int fq) const {
        bf16_t* base = O + (size_t)(u.pm * 256 + wr * 64 + fr) * ld + u.pn * 256 + wc * 32 + 8 * fq;
#pragma unroll
        for (int ai = 0; ai < 2; ++ai)
#pragma unroll
            for (int m = 0; m < 4; ++m) { bf16_t* rowp = base + (size_t)(ai * HALF + m * 16) * ld;
#pragma unroll
                for (int bj = 0; bj < 2; ++bj) { const f32x4 v0 = acc[ai][bj][m][0], v1 = acc[ai][bj][m][1];
                    *(u32x4*)(rowp + bj * HALF) = (u32x4){pk2(v0[0], v0[1]), pk2(v0[2], v0[3]), pk2(v1[0], v1[1]), pk2(v1[2], v1[3])}; } }
    }
};
}

DI void sincos_d(double ang, double& s, double& c) {
    const double r = ang * 0.63661977236758134308; const double q = __builtin_rint(r);
    const double y = (ang - q * 1.57079632679489655800) - q * 6.12323399573676603587e-17;
    const double y2 = y * y;
    double sp = -1.0 / 1307674368000.0; sp = sp * y2 + 1.0 / 6227020800.0; sp = sp * y2 - 1.0 / 39916800.0; sp = sp * y2 + 1.0 / 362880.0; sp = sp * y2 - 1.0 / 5040.0; sp = sp * y2 + 1.0 / 120.0; sp = sp * y2 - 1.0 / 6.0; sp = sp * y2 + 1.0;
    const double sy = y * sp;
    double cp = 1.0 / 87178291200.0; cp = cp * y2 - 1.0 / 479001600.0; cp = cp * y2 + 1.0 / 3628800.0; cp = cp * y2 - 1.0 / 40320.0; cp = cp * y2 + 1.0 / 720.0; cp = cp * y2 - 1.0 / 24.0; cp = cp * y2 + 0.5; const double cy = 1.0 - y2 * cp;
    const int qi = ((int)q) & 3;
    s = (qi == 0) ? sy : (qi == 1) ? cy : (qi == 2) ? -sy : -cy;
    c = (qi == 0) ? cy : (qi == 1) ? -sy : (qi == 2) ? -cy : sy;
}
DI void ssm_tables(const Params& P, int g, int p) {
    float* ABAR = (float*)(P.ws + WS_ABAR); float* ABARL = (float*)(P.ws + WS_ABARL); bf16_t* BCAT = (bf16_t*)(P.ws + WS_BCAT); bf16_t* CCAT = (bf16_t*)(P.ws + WS_CCAT);
    const double dt = (double)expf(P.log_dt[g]);
    const double ar = P.a_re[g * 64 + p], ai = P.a_im[g * 64 + p];
    double sn, cs; sincos_d(dt * ai, sn, cs);
    const double mag = (double)expf((float)(dt * ar));
    const double abr = mag * cs, abi = mag * sn;
    ABAR[g * 128 + p] = (float)abr; ABAR[g * 128 + 64 + p] = (float)abi;
    double snL, csL; sincos_d(128.0 * dt * ai, snL, csL);
    const double magL = (double)expf((float)(128.0 * dt * ar));
    ABARL[g * 128 + p] = (float)(magL * csL); ABARL[g * 128 + 64 + p] = (float)(magL * snL);
    const double xr = abr - 1.0, xi = abi, den = ar * ar + ai * ai;
    const double qr = (xr * ar + xi * ai) / den, qi = (xi * ar - xr * ai) / den;
    for (int c = 0; c < 16; ++c) {
        const double br = P.b_re[(g * 64 + p) * 16 + c], bi = P.b_im[(g * 64 + p) * 16 + c];
        BCAT[(g * 128 + p) * 16 + c] = f2bf((float)(qr * br - qi * bi));
        BCAT[(g * 128 + 64 + p) * 16 + c] = f2bf((float)(qr * bi + qi * br));
        CCAT[(g * 16 + c) * 128 + p] = f2bf(P.c_re[(g * 16 + c) * 64 + p]);
        CCAT[(g * 16 + c) * 128 + 64 + p] = f2bf(-P.c_im[(g * 16 + c) * 64 + p]);
    }
}
DI void ada_item(const Params& P, char* lds, int item) {
    float* red = (float*)lds; const int tid = opaque_tid(), lane = tid & 63, wid = tid >> 6;
    const int n = item * 64 + lane, k0 = wid * 128;
    float a0 = 0.f, a1 = 0.f, a2 = 0.f, a3 = 0.f;
#pragma unroll 1
    for (int kb = k0; kb < k0 + 128; kb += 32) {
        float w[32];
#pragma unroll
        for (int j = 0; j < 32; ++j) w[j] = P.w_ada[(size_t)(kb + j) * 6144 + n];
#pragma unroll
        for (int j = 0; j < 32; ++j) { const int k = kb + j; a0 += siluf_(P.c[k]) * w[j]; a1 += siluf_(P.c[1024 + k]) * w[j]; a2 += siluf_(P.c[2048 + k]) * w[j]; a3 += siluf_(P.c[3072 + k]) * w[j]; }
    }
    red[(wid * 4 + 0) * 64 + lane] = a0; red[(wid * 4 + 1) * 64 + lane] = a1; red[(wid * 4 + 2) * 64 + lane] = a2; red[(wid * 4 + 3) * 64 + lane] = a3;
    __syncthreads();
    if (tid < 256) {
        const int b = tid >> 6, l = tid & 63; float s = 0.f;
#pragma unroll
        for (int w = 0; w < 8; ++w) s += red[(w * 4 + b) * 64 + l];
        ((float*)(P.ws + WS_ADA))[b * 6144 + item * 64 + l] = s + P.b_ada[item * 64 + l];
    }
    asm volatile("s_waitcnt vmcnt(0)" ::: "memory");
    __syncthreads();
    if (tid == 0) {
        __builtin_amdgcn_fence(__ATOMIC_RELEASE, "agent"); asm volatile("s_waitcnt vmcnt(0)" ::: "memory");
        __hip_atomic_fetch_add((unsigned*)(P.ws + WS_ADACNT), 1u, __ATOMIC_RELAXED, __HIP_MEMORY_SCOPE_AGENT);
    }
}
DI void tr_item(const float* __restrict__ W, int K, int N, bf16_t* __restrict__ WT, int item, float* scr, int lane, int mode, int s, bool qscale, const float* ks0 = nullptr, const float* ks1 = nullptr) {
    const int nblk = N >> 6, kb = item / nblk, nb = item % nblk, k0 = 64 * kb, n0 = 64 * nb;
    const float* src = W + (size_t)(k0 + (lane >> 4)) * N + n0 + 4 * (lane & 15);
    f32x4 wv[16];
#pragma unroll
    for (int i = 0; i < 16; ++i) wv[i] = *(const f32x4*)(src + (size_t)(4 * i) * N);
    if (ks0) {
#pragma unroll
        for (int i = 0; i < 16; ++i) { const int k = k0 + 4 * i + (lane >> 4); wv[i] = wv[i] * ((k < 512) ? ks0[k] : ks1[k - 512]); }
    }
#pragma unroll
    for (int i = 0; i < 16; ++i) { float* d = scr + (4 * i + (lane >> 4)) * 65 + 4 * (lane & 15); d[0] = wv[i][0]; d[1] = wv[i][1]; d[2] = wv[i][2]; d[3] = wv[i][3]; }
    LDS_FENCE();
    const int c = lane & 7; const float sc = (qscale && n0 < 512) ? 0.125f : 1.f;
#pragma unroll
    for (int j = 0; j < 8; ++j) {
        const int n = (lane >> 3) + 8 * j; const float* sp = scr + (8 * c) * 65 + n;
        const u32x4 o = (u32x4){pk2(sp[0] * sc, sp[65] * sc), pk2(sp[130] * sc, sp[195] * sc), pk2(sp[260] * sc, sp[325] * sc), pk2(sp[390] * sc, sp[455] * sc)};
        const int nn = n0 + n; const int drow = mode == 0 ? nn : (mode == 1 ? (64 * (nn >> 5) + 32 * s + (nn & 31)) : (mode == 2 ? (256 * (nn >> 7) + 128 * s + (nn & 127)) :
            ((nn & ~255) + 128 * ((nn >> 3) & 1) + 32 * ((nn >> 6) & 3) + 8 * ((nn >> 4) & 3) + (nn & 7))));
        *(u32x4*)(WT + (size_t)drow * K + k0 + 8 * c) = o;
    }
    LDS_FENCE();
}
constexpr int CI_IN = 512, CI_GLU = 64, CI_OUT = 256, CI_R = 64, CI_SG = 64, CI_SU = 64, CI_SD = 64, CI_SMALL = CI_IN + CI_GLU + CI_OUT + CI_R + CI_SG + CI_SU + CI_SD;
DI void conv_item(const Params& P, int r, float* scr, int lane) {
    if (r < CI_IN) { tr_item(P.w_in, 1024, 2048, (bf16_t*)(P.ws + WS_WIN), r, scr, lane, 0, 0, true); return; } r -= CI_IN;
    if (r < CI_GLU) { tr_item(P.w_glu, 512, 512, (bf16_t*)(P.ws + WS_WGLU), r, scr, lane, 0, 0, false); return; } r -= CI_GLU;
    if (r < CI_OUT) { tr_item(P.w_out, 1024, 1024, (bf16_t*)(P.ws + WS_WOUT), r, scr, lane, 0, 0, false, P.g_att, P.g_ssm); return; } r -= CI_OUT;
    if (r < CI_R) { tr_item(P.w_router, 1024, 256, (bf16_t*)(P.ws + WS_WR), r, scr, lane, 0, 0, false); return; } r -= CI_R;
    if (r < CI_SG) { tr_item(P.w_s_gate, 1024, 256, (bf16_t*)(P.ws + WS_WSGU), r, scr, lane, 2, 0, false); return; } r -= CI_SG;
    if (r < CI_SU) { tr_item(P.w_s_up, 1024, 256, (bf16_t*)(P.ws + WS_WSGU), r, scr, lane, 2, 1, false); return; } r -= CI_SU;
    if (r < CI_SD) tr_item(P.w_s_down, 256, 1024, (bf16_t*)(P.ws + WS_WSD), r, scr, lane, 0, 0, false);
}
DI void p0_prologue(const Params& P, char* lds) {
    const int tid = opaque_tid(), lane = tid & 63, wid = tid >> 6, G = gridDim.x;
    { const int gt = blockIdx.x * NTHR + tid; if (gt < 2048) ssm_tables(P, gt >> 6, gt & 63); }
    for (int item = blockIdx.x; item < 96; item += G) ada_item(P, lds, item);
    float* scr = (float*)(lds + wid * 16640);
    const int gw = blockIdx.x * 8 + wid, NGW = G * 8;
    if (blockIdx.x >= 96 || G <= 96) { const int w0 = (G > 96) ? gw - 96 * 8 : gw, nw = (G > 96) ? (G - 96) * 8 : NGW; for (int it = w0; it < CI_SMALL; it += nw) conv_item(P, it, scr, lane); }
    if (tid == 0) {
        unsigned* ctr = (unsigned*)(P.ws + WS_ADACNT); unsigned sp = 0;
        while (__hip_atomic_load(ctr, __ATOMIC_RELAXED, __HIP_MEMORY_SCOPE_AGENT) < 96u) { __builtin_amdgcn_s_sleep(2); if (++sp > (1u << 22)) break; }
        __builtin_amdgcn_fence(__ATOMIC_ACQUIRE, "agent"); asm volatile("s_waitcnt vmcnt(0)" ::: "memory");
    }
    __syncthreads();
    {
        const float* ADA = (const float*)(P.ws + WS_ADA); bf16_t* H1 = (bf16_t*)(P.ws + WS_H1);
        for (int row = gw; row < T; row += NGW) {
            const float* xr = P.x + (size_t)row * 1024 + 4 * lane; const float* ad = ADA + (row >> 13) * 6144 + 4 * lane;
#pragma unroll
            for (int j = 0; j < 4; ++j) {
                const f32x4 xv = *(const f32x4*)(xr + 256 * j), sc = *(const f32x4*)(ad + 1024 + 256 * j), sh = *(const f32x4*)(ad + 256 * j);
                const f32x4 hv = xv * (1.f + sc) + sh;
                *(u32x2*)(H1 + (size_t)row * 1024 + 4 * lane + 256 * j) = (u32x2){pk2(hv[0], hv[1]), pk2(hv[2], hv[3])};
            }
        }
    }
}

DI void p1_inproj(const Params& P, char* lds) {
    pg8::DenseOrder S; S.init(P.ws + WS_H1, P.ws + WS_WIN, T, NPROJ, 1024, gridDim.x, blockIdx.x);
    pg8::EpiStoreBf16 E{(bf16_t*)(P.ws + WS_QKVU), NPROJ};
    pg8::gemm_phase<pg8::EpiStoreBf16, pg8::DenseOrder, false>((LAS unsigned char*)lds, 1024, S, E);
}

constexpr int CONV_NT = 3 * 256 * 16, CONV_TP = 257, FILL_TILES_PER_WG = 8;
struct ConvTile { const float* src; bf16_t* WT; int pitch, K, k0, n0, mode, s; };
DI ConvTile conv_tile(const Params& P, int t) {
    const int kind = t / 4096, e = (t % 4096) >> 4, sub = t & 15;
    if (kind < 2) return ConvTile{(kind ? P.w_e_up : P.w_e_gate) + (size_t)e * 262144 + (size_t)(64 * sub) * 256, (bf16_t*)(P.ws + WS_WEGU) + (size_t)e * 524288, 256, 1024, 64 * sub, 0, 2, kind};
    return ConvTile{P.w_e_down + (size_t)e * 262144 + (size_t)(64 * (sub >> 2)) * 1024 + 256 * (sub & 3), (bf16_t*)(P.ws + WS_WED) + (size_t)e * 262144, 1024, 256, 64 * (sub >> 2), 256 * (sub & 3), 3, 0};
}
DI void conv_tile_load(const ConvTile& d, int wid, int lane, f32x4 (&w)[8]) {
#pragma unroll
    for (int i = 0; i < 8; ++i) w[i] = __builtin_nontemporal_load((const f32x4*)(d.src + (size_t)(8 * wid + i) * d.pitch + 4 * lane));
}
DI void conv_experts_block(const Params& P, char* lds, int t, const int NT, const int stride) {
    const int tid = opaque_tid(), lane = tid & 63, wid = tid >> 6;
    if (t >= NT) return;
    float* buf0 = (float*)lds; float* buf1 = buf0 + 64 * CONV_TP;
    ConvTile d = conv_tile(P, t); f32x4 w[8]; conv_tile_load(d, wid, lane, w);
    int par = 0;
    for (;;) {
        float* buf = par ? buf1 : buf0;
#pragma unroll
        for (int i = 0; i < 8; ++i) { float* p = buf + (8 * wid + i) * CONV_TP + 4 * lane; p[0] = w[i][0]; p[1] = w[i][1]; p[2] = w[i][2]; p[3] = w[i][3]; }
        const int tn = t + stride; const ConvTile dn = conv_tile(P, tn < NT ? tn : t);
        conv_tile_load(dn, wid, lane, w);
        __syncthreads();
        const int c = lane & 7;
#pragma unroll
        for (int it = 0; it < 4; ++it) {
            const int n = 8 * wid + (lane >> 3) + 64 * it; const float* sp = buf + (8 * c) * CONV_TP + n;
            const u32x4 o = (u32x4){pk2(sp[0], sp[CONV_TP]), pk2(sp[2 * CONV_TP], sp[3 * CONV_TP]), pk2(sp[4 * CONV_TP], sp[5 * CONV_TP]), pk2(sp[6 * CONV_TP], sp[7 * CONV_TP])};
            const int nn = d.n0 + n; const int drow = d.mode == 2 ? (256 * (nn >> 7) + 128 * d.s + (nn & 127)) : ((nn & ~255) + 128 * ((nn >> 3) & 1) + 32 * ((nn >> 6) & 3) + 8 * ((nn >> 4) & 3) + (nn & 7));
            *(u32x4*)(d.WT + (size_t)drow * d.K + d.k0 + 8 * c) = o;
        }
        t = tn; if (t >= NT) break;
        d = dn; par ^= 1;
    }
    __syncthreads();
}
DI int fill_blocks() { const int G = gridDim.x, rounds = (384 + G - 1) / G; return rounds * G - 384; }
DI void p1_inproj_and_experts(const Params& P, char* lds) {
    const bool conv_first = ((blockIdx.x >> 3) & 1) == 0;
    const int nb = fill_blocks(), fill = (nb > 0 && nb < (int)gridDim.x) ? nb * FILL_TILES_PER_WG : 0;
    if (conv_first) conv_experts_block(P, lds, blockIdx.x, CONV_NT - fill, gridDim.x);
    p1_inproj(P, lds);
    if (!conv_first) conv_experts_block(P, lds, blockIdx.x, CONV_NT - fill, gridDim.x);
}

DI int t5_bucket(int dist) {
    if (dist < 16) return dist;
    const float v = logf((float)dist / 16.0f) / 4.852030263919617f * 16.0f;
    int l = 16 + (int)v; return l < 31 ? l : 31;
}
struct VFrag { u32x2 r[8]; };
DI VFrag v_tr_read(unsigned addr) {
    VFrag f;
    asm volatile("ds_read_b64_tr_b16 %0, %8\n\tds_read_b64_tr_b16 %1, %8 offset:1152\n\tds_read_b64_tr_b16 %2, %8 offset:64\n\tds_read_b64_tr_b16 %3, %8 offset:1216\n\t"
                 "ds_read_b64_tr_b16 %4, %8 offset:2304\n\tds_read_b64_tr_b16 %5, %8 offset:3456\n\tds_read_b64_tr_b16 %6, %8 offset:2368\n\tds_read_b64_tr_b16 %7, %8 offset:3520\n\ts_waitcnt lgkmcnt(0)"
                 : "=&v"(f.r[0]), "=&v"(f.r[1]), "=&v"(f.r[2]), "=&v"(f.r[3]), "=&v"(f.r[4]), "=&v"(f.r[5]), "=&v"(f.r[6]), "=&v"(f.r[7]) : "v"(addr) : "memory");
    return f;
}
DI void attn_task_params(int task, int wid, int& d, int& r, int& lqb, int& p) {
    p = task >> 1; const int tk = wid + 8 * (task & 1);
    if (p == 0) { d = 1; r = 0; lqb = 32 * tk; } else if (p == 1) { d = 4; r = tk >> 2; lqb = 32 * (tk & 3); } else { d = 16; r = tk; lqb = 0; }
}
DI void attn_unit(const Params& P, char* lds, int unit) {
    int tid = threadIdx.x; asm volatile("" : "+v"(tid));
    const int lane = tid & 63, wid = __builtin_amdgcn_readfirstlane(tid >> 6), c = lane & 31, hh = lane >> 5;
    const int b = unit >> 7, qb = (unit >> 3) & 15, h = unit & 7, t0 = qb * 512;
    char* st = lds;
    float* bt = (float*)(lds + 512 * 136);
    bf16_t* ksw = (bf16_t*)(bt + 3 * 192) + wid * (64 * LDP);
    bf16_t* vsw = ksw + 32 * LDP;
    const unsigned vtr = (unsigned)(size_t)vsw + (unsigned)(((4 * hh + ((lane & 15) >> 2)) * LDP + 16 * ((lane >> 4) & 1) + 4 * (lane & 3)) * 2);
    const bf16_t* qkv = (const bf16_t*)(P.ws + WS_QKVU) + (size_t)(b * SEQ) * NPROJ;
    constexpr float LOG2E = 1.4426950408889634f;
    for (int i = tid; i < 3 * 192; i += NTHR) {
        const int p = i / 192, j = i % 192 - 32; const int dist = (j < 0 ? 0 : j) << (2 * p); float v = NEG;
        if (j >= (p ? 33 : 0) && j <= 128) {
            const int mult = (p == 0) ? 1 + ((j & 3) == 0) + ((j & 15) == 0) : (p == 1 ? 1 + ((j & 3) == 0) : 1);
            v = P.rel_bias[t5_bucket(dist) * 8 + h] * LOG2E + (mult == 1 ? 0.f : (mult == 2 ? 1.f : 1.5849625007211562f));
        }
        bt[i] = v;
    }
    __syncthreads();
    bf16x8 kfN[4], vvN[4], qfN[4];
    auto issue = [&](int it) {
        int d, r, lqb, p; attn_task_params(it / 5, wid, d, r, lqb, p); const int ch = it % 5;
#pragma unroll
        for (int i = 0; i < 4; ++i) {
            int tk = t0 + d * (lqb - 128 + 32 * ch + 8 * i + (lane >> 3)) + r; tk = tk < 0 ? 0 : (tk > SEQ - 1 ? SEQ - 1 : tk);
            const bf16_t* rp = qkv + (size_t)tk * NPROJ + 512 + h * 64 + 8 * (lane & 7);
            kfN[i] = *(const bf16x8*)rp; vvN[i] = *(const bf16x8*)(rp + 512);
        }
        if (ch == 0) { const bf16_t* qrow = qkv + (size_t)(t0 + d * (lqb + c) + r) * NPROJ + h * 64 + 8 * hh;
#pragma unroll
            for (int s = 0; s < 4; ++s) qfN[s] = *(const bf16x8*)(qrow + 16 * s); }
    };
    issue(0);
    bf16x8 qf[4]; float m = NEG, l = 0.f; f32x16 o0, o1; int d = 1, r = 0, lqb = 0, p = 0, qidx = 0;
#pragma unroll 1
    for (int it = 0; it < 30; ++it) {
        const int ch = it % 5;
        if (ch == 0) {
            attn_task_params(it / 5, wid, d, r, lqb, p);
            qidx = d * (lqb + c) + r; qidx ^= (qidx >> 5) & 15;
#pragma unroll
            for (int s = 0; s < 4; ++s) qf[s] = qfN[s];
            m = NEG; l = 0.f;
#pragma unroll
            for (int i = 0; i < 16; ++i) { o0[i] = 0.f; o1[i] = 0.f; }
            if (p > 0) {
                const char* sp = st + qidx * 136; const f32x2 ml = *(const f32x2*)(sp + 128); m = ml[0]; l = hh ? 0.f : ml[1];
#pragma unroll
                for (int g = 0; g < 4; ++g) { const u32x2 a = *(const u32x2*)(sp + (8 * g + 4 * hh) * 2), bb = *(const u32x2*)(sp + (32 + 8 * g + 4 * hh) * 2);
                    o0[4 * g] = bflo(a[0]); o0[4 * g + 1] = bfhi(a[0]); o0[4 * g + 2] = bflo(a[1]); o0[4 * g + 3] = bfhi(a[1]); o1[4 * g] = bflo(bb[0]); o1[4 * g + 1] = bfhi(bb[0]); o1[4 * g + 2] = bflo(bb[1]); o1[4 * g + 3] = bfhi(bb[1]); }
            }
        }
        const float* btp = bt + p * 192 + 32 + c + 128 - 32 * ch - 4 * hh;
        const bool mdead = p > 0 && ch == 4;
        const bool sdead = t0 + d * (lqb - 128 + 32 * ch + 31) + r < 0;
        const int nx = (it >= 13 && ch == 3) ? it + 2 : it + 1;
        if (mdead) {}
        else if (sdead) { if (nx < 30) issue(nx); }
        else {
        LDS_FENCE();
#pragma unroll
        for (int i = 0; i < 4; ++i) { *(bf16x8*)(ksw + (8 * i + (lane >> 3)) * LDP + 8 * (lane & 7)) = kfN[i]; *(bf16x8*)(vsw + (8 * i + (lane >> 3)) * LDP + 8 * (lane & 7)) = vvN[i]; }
        if (nx < 30) issue(nx);
        LDS_FENCE();
        const int lk0 = lqb - 128 + 32 * ch;
        bf16x8 kf[4];
#pragma unroll
        for (int s = 0; s < 4; ++s) kf[s] = *(const bf16x8*)(ksw + c * LDP + 16 * s + 8 * hh);
        f32x16 sa;
#pragma unroll
        for (int i = 0; i < 16; ++i) sa[i] = 0.f;
#pragma unroll
        for (int s = 0; s < 4; ++s) sa = MFMA32(kf[s], qf[s], sa);
        float sc[16]; float mx = NEG;
#pragma unroll
        for (int i = 0; i < 16; ++i) sc[i] = btp[-((i & 3) + 8 * (i >> 2))];
        asm volatile("" : "+v"(sc[0]), "+v"(sc[1]), "+v"(sc[2]), "+v"(sc[3]), "+v"(sc[4]), "+v"(sc[5]), "+v"(sc[6]), "+v"(sc[7]), "+v"(sc[8]), "+v"(sc[9]), "+v"(sc[10]), "+v"(sc[11]), "+v"(sc[12]), "+v"(sc[13]), "+v"(sc[14]), "+v"(sc[15]));
        if (t0 + d * lk0 + r >= 0) {
#pragma unroll
            for (int i = 0; i < 16; ++i) { const float v = fmaf(sa[i], LOG2E, sc[i]); sc[i] = v; mx = fmaxf(mx, v); }
        } else {
#pragma unroll
            for (int i = 0; i < 16; ++i) {
                const int kr = (i & 3) + 8 * (i >> 2) + 4 * hh;
                const float v = (t0 + d * (lk0 + kr) + r >= 0) ? fmaf(sa[i], LOG2E, sc[i]) : NEG; sc[i] = v; mx = fmaxf(mx, v);
            }
        }
        mx = xmax32(mx);
        if (!__all(mx - m <= 8.f)) {
            const float mn = fmaxf(m, mx), alpha = __builtin_amdgcn_exp2f(m - mn); m = mn; l *= alpha;
#pragma unroll
            for (int i = 0; i < 16; ++i) { o0[i] *= alpha; o1[i] *= alpha; }
        }
        float ps = 0.f;
#pragma unroll
        for (int i = 0; i < 16; ++i) { sc[i] = __builtin_amdgcn_exp2f(sc[i] - m); ps += sc[i]; }
        l += ps;
        const VFrag vf = v_tr_read(vtr);
#pragma unroll
        for (int s = 0; s < 2; ++s) {
            const u32x4 pw = (u32x4){pk2(sc[8 * s], sc[8 * s + 1]), pk2(sc[8 * s + 2], sc[8 * s + 3]), pk2(sc[8 * s + 4], sc[8 * s + 5]), pk2(sc[8 * s + 6], sc[8 * s + 7])};
            const bf16x8 pf = __builtin_bit_cast(bf16x8, pw);
            const u32x4 v0 = (u32x4){vf.r[4 * s][0], vf.r[4 * s][1], vf.r[4 * s + 1][0], vf.r[4 * s + 1][1]}, v1 = (u32x4){vf.r[4 * s + 2][0], vf.r[4 * s + 2][1], vf.r[4 * s + 3][0], vf.r[4 * s + 3][1]};
            o0 = MFMA32(__builtin_bit_cast(bf16x8, v0), pf, o0); o1 = MFMA32(__builtin_bit_cast(bf16x8, v1), pf, o1);
        }
        }
        if (ch == 4) {
            l = xsum32(l);
            char* sp = st + qidx * 136;
            if (hh == 0) *(f32x2*)(sp + 128) = (f32x2){m, l};
#pragma unroll
            for (int g = 0; g < 4; ++g) { *(u32x2*)(sp + (8 * g + 4 * hh) * 2) = (u32x2){pk2(o0[4 * g], o0[4 * g + 1]), pk2(o0[4 * g + 2], o0[4 * g + 3])}; *(u32x2*)(sp + (32 + 8 * g + 4 * hh) * 2) = (u32x2){pk2(o1[4 * g], o1[4 * g + 1]), pk2(o1[4 * g + 2], o1[4 * g + 3])}; }
            if ((it / 5) & 1) __syncthreads();
        }
    }
    {
        const char* sp = st + (tid ^ ((tid >> 5) & 15)) * 136; const float inv = 1.f / *(const float*)(sp + 132);
        bf16_t* op = (bf16_t*)(P.ws + WS_MERGED) + (size_t)(b * SEQ + t0 + tid) * 1024 + h * 64; float ss = 0.f;
#pragma unroll
        for (int i = 0; i < 8; ++i) { const u32x2 wa = *(const u32x2*)(sp + 16 * i), wb = *(const u32x2*)(sp + 16 * i + 8); const unsigned w[4] = {wa[0], wa[1], wb[0], wb[1]}; float v[8];
#pragma unroll
            for (int j = 0; j < 4; ++j) { v[2 * j] = bflo(w[j]) * inv; v[2 * j + 1] = bfhi(w[j]) * inv; ss += v[2 * j] * v[2 * j] + v[2 * j + 1] * v[2 * j + 1]; }
            *(u32x4*)(op + 8 * i) = (u32x4){pk2(v[0], v[1]), pk2(v[2], v[3]), pk2(v[4], v[5]), pk2(v[6], v[7])}; }
        ((float*)(P.ws + WS_ATTSQ))[(size_t)(b * SEQ + t0 + tid) * 8 + h] = ss;
    }
    __syncthreads();
}

DI u32x2 tr_read1(unsigned addr) { u32x2 r; asm volatile("ds_read_b64_tr_b16 %0, %1\n\ts_waitcnt lgkmcnt(0)" : "=&v"(r) : "v"(addr) : "memory"); return r; }
struct STr16 { u32x2 r[16]; };
DI STr16 s_tr_read(unsigned addr) {
    STr16 f;
    asm volatile("ds_read_b64_tr_b16 %0, %16\n\tds_read_b64_tr_b16 %1, %16 offset:576\n\tds_read_b64_tr_b16 %2, %16 offset:4608\n\tds_read_b64_tr_b16 %3, %16 offset:5184\n\t"
                 "ds_read_b64_tr_b16 %4, %16 offset:9216\n\tds_read_b64_tr_b16 %5, %16 offset:9792\n\tds_read_b64_tr_b16 %6, %16 offset:13824\n\tds_read_b64_tr_b16 %7, %16 offset:14400\n\t"
                 "ds_read_b64_tr_b16 %8, %16 offset:32\n\tds_read_b64_tr_b16 %9, %16 offset:608\n\tds_read_b64_tr_b16 %10, %16 offset:4640\n\tds_read_b64_tr_b16 %11, %16 offset:5216\n\t"
                 "ds_read_b64_tr_b16 %12, %16 offset:9248\n\tds_read_b64_tr_b16 %13, %16 offset:9824\n\tds_read_b64_tr_b16 %14, %16 offset:13856\n\tds_read_b64_tr_b16 %15, %16 offset:14432\n\ts_waitcnt lgkmcnt(0)"
                 : "=&v"(f.r[0]), "=&v"(f.r[1]), "=&v"(f.r[2]), "=&v"(f.r[3]), "=&v"(f.r[4]), "=&v"(f.r[5]), "=&v"(f.r[6]), "=&v"(f.r[7]),
                   "=&v"(f.r[8]), "=&v"(f.r[9]), "=&v"(f.r[10]), "=&v"(f.r[11]), "=&v"(f.r[12]), "=&v"(f.r[13]), "=&v"(f.r[14]), "=&v"(f.r[15]) : "v"(addr) : "memory");
    return f;
}
template <bool FINAL>
DI void ssm_task(const Params& P, float* buf, int b, int k, int g, int lane, float s_re, float s_im) {
    const int c32 = lane & 31, hh = lane >> 5, fr = lane & 15, fq = lane >> 4;
    const float* ABAR = (const float*)(P.ws + WS_ABAR);
    const float a_re = ABAR[g * 128 + lane], a_im = ABAR[g * 128 + 64 + lane];
    bf16x8 bq[4];
#pragma unroll
    for (int tau = 0; tau < 4; ++tau) bq[tau] = *(const bf16x8*)((const bf16_t*)(P.ws + WS_BCAT) + (size_t)(g * 128 + 32 * tau + c32) * 16 + 8 * hh);
    bf16x8 cq[4]; f32x4 dsk = (f32x4){0.f, 0.f, 0.f, 0.f};
    if (FINAL) {
#pragma unroll
        for (int s = 0; s < 4; ++s) cq[s] = *(const bf16x8*)((const bf16_t*)(P.ws + WS_CCAT) + (size_t)(g * 16 + fr) * 128 + 32 * s + 8 * fq);
        dsk = *(const f32x4*)(P.ssm_d + g * 16 + 4 * fq);
    }
    const bf16_t* ubase = (const bf16_t*)(P.ws + WS_QKVU) + (size_t)(b * SEQ + k * 128) * NPROJ + 1536 + 16 * g;
    bf16x8 ufa[4]; u32x2 uwa[4][2];
#pragma unroll
    for (int sub = 0; sub < 4; ++sub) {
        ufa[sub] = *(const bf16x8*)(ubase + (size_t)(32 * sub + c32) * NPROJ + 8 * hh);
        if (FINAL) { uwa[sub][0] = *(const u32x2*)(ubase + (size_t)(32 * sub + fr) * NPROJ + 4 * fq); uwa[sub][1] = *(const u32x2*)(ubase + (size_t)(32 * sub + 16 + fr) * NPROJ + 4 * fq); }
    }
    const unsigned str = (unsigned)(size_t)buf + (unsigned)((8 * fq + ((lane & 15) >> 2)) * (SSM_PITCH * 4) + (lane & 3) * 8);
#pragma unroll
    for (int sub = 0; sub < 4; ++sub) {
        const bf16x8 uf = ufa[sub];
        LDS_FENCE();
#pragma unroll
        for (int tau = 0; tau < 4; ++tau) {
            f32x16 z;
#pragma unroll
            for (int i = 0; i < 16; ++i) z[i] = 0.f;
            z = MFMA32(uf, bq[tau], z);
#pragma unroll
            for (int gq = 0; gq < 4; ++gq) *(f32x4*)(buf + (32 * tau + c32) * SSM_PITCH + 8 * gq + 4 * hh) = (f32x4){z[4 * gq], z[4 * gq + 1], z[4 * gq + 2], z[4 * gq + 3]};
        }
        LDS_FENCE();
        float* rre = buf + lane * SSM_PITCH; float* rim = buf + (64 + lane) * SSM_PITCH;
#pragma unroll
        for (int tq = 0; tq < 8; ++tq) {
            const f32x4 re4 = *(const f32x4*)(rre + 4 * tq), im4 = *(const f32x4*)(rim + 4 * tq); float sr[4], si[4];
#pragma unroll
            for (int j = 0; j < 4; ++j) { const float nr = a_re * s_re - a_im * s_im + re4[j], ni = a_re * s_im + a_im * s_re + im4[j]; s_re = nr; s_im = ni; sr[j] = nr; si[j] = ni; }
            if (FINAL) { *(u32x2*)((bf16_t*)rre + 4 * tq) = (u32x2){pk2(sr[0], sr[1]), pk2(sr[2], sr[3])}; *(u32x2*)((bf16_t*)rim + 4 * tq) = (u32x2){pk2(si[0], si[1]), pk2(si[2], si[3])}; }
        }
        if (FINAL) {
            LDS_FENCE();
            const STr16 sf = s_tr_read(str);
#pragma unroll
            for (int tt = 0; tt < 2; ++tt) {
                f32x4 y = (f32x4){0.f, 0.f, 0.f, 0.f};
#pragma unroll
                for (int s = 0; s < 4; ++s) { const u32x4 w = (u32x4){sf.r[8 * tt + 2 * s][0], sf.r[8 * tt + 2 * s][1], sf.r[8 * tt + 2 * s + 1][0], sf.r[8 * tt + 2 * s + 1][1]}; y = MFMA16(cq[s], __builtin_bit_cast(bf16x8, w), y); }
                const int tl = 32 * sub + 16 * tt + fr;
                const u32x2 uw = uwa[sub][tt];
                const float v0 = gelu_tanh(y[0] + dsk[0] * bflo(uw[0])), v1 = gelu_tanh(y[1] + dsk[1] * bfhi(uw[0])), v2 = gelu_tanh(y[2] + dsk[2] * bflo(uw[1])), v3 = gelu_tanh(y[3] + dsk[3] * bfhi(uw[1]));
                *(u32x2*)((bf16_t*)(P.ws + WS_YGL) + (size_t)(b * SEQ + k * 128 + tl) * 512 + 16 * g + 4 * fq) = (u32x2){pk2(v0, v1), pk2(v2, v3)};
            }
        }
    }
    if (!FINAL) { float* E = (float*)(P.ws + WS_E) + (size_t)((b * 64 + k) * 32 + g) * 128; E[lane] = s_re; E[64 + lane] = s_im; }
    LDS_FENCE();
}

DI void p2_mixer(const Params& P, char* lds) {
    const int tid = opaque_tid(), lane = tid & 63, wid = tid >> 6, G = gridDim.x;
    for (int item = blockIdx.x; item < 1536; item += G) {
        if (item < 512) attn_unit(P, lds, item < 256 ? item : (item ^ (15 << 3)));
        else { const int wt = (item - 512) * 8 + wid; ssm_task<false>(P, (float*)(lds + wid * SSM_WAVE_LDS), wt >> 11, (wt >> 5) & 63, wt & 31, lane, 0.f, 0.f); __syncthreads(); }
    }
}

DI void route_token(const float* srow, const float* rbias, int lane, int& e_out, float& g_out) {
    const f32x4 s4 = *(const f32x4*)(srow + 4 * lane); const f32x4 rb = *(const f32x4*)(rbias + 4 * lane);
    float w0 = s4[0] + rb[0], w1 = s4[1] + rb[1], w2 = s4[2] + rb[2], w3 = s4[3] + rb[3];
    float m1, m2;
    { const float a = fmaxf(w0, w1), bb = fminf(w0, w1), cc = fmaxf(w2, w3), dd = fminf(w2, w3); m1 = fmaxf(a, cc); m2 = fmaxf(fminf(a, cc), fmaxf(bb, dd)); }
#define ROUTE_MERGE2(CTRL) { const float o1 = dppf<CTRL>(m1), o2 = dppf<CTRL>(m2); const float n1 = fmaxf(m1, o1), n2 = fmaxf(fminf(m1, o1), fmaxf(m2, o2)); m1 = n1; m2 = n2; }
    ROUTE_MERGE2(DPP_X1) ROUTE_MERGE2(DPP_X2) ROUTE_MERGE2(DPP_HM)
#undef ROUTE_MERGE2
    const float gs = m1 + m2; const int mygrp = lane >> 3; int rank = 0;
#pragma unroll
    for (int j = 0; j < 8; ++j) { const float gj = rdlane(gs, 8 * j); rank += ((gj > gs) || (gj == gs && j < mygrp)) ? 1 : 0; }
    const float NINF = -__builtin_inff();
    if (rank >= 4) { w0 = NINF; w1 = NINF; w2 = NINF; w3 = NINF; }
    int my_e = 0; float my_s = 0.f;
#pragma unroll 1
    for (int k = 0; k < TOPK; ++k) {
        float bv = w0; int bi = 0;
        if (w1 > bv) { bv = w1; bi = 1; } if (w2 > bv) { bv = w2; bi = 2; } if (w3 > bv) { bv = w3; bi = 3; }
        float rm = bv; rm = fmaxf(rm, dppf<DPP_X1>(rm)); rm = fmaxf(rm, dppf<DPP_X2>(rm)); rm = fmaxf(rm, dppf<DPP_HM>(rm)); rm = fmaxf(rm, dppf<DPP_RM>(rm));
        const float wmax = fmaxf(fmaxf(rdlane(rm, 0), rdlane(rm, 16)), fmaxf(rdlane(rm, 32), rdlane(rm, 48)));
        const unsigned long long bal = __ballot(bv == wmax);
        const int owner = __builtin_amdgcn_readfirstlane((int)__ffsll((long long)bal) - 1);
        const int sub = __builtin_amdgcn_readlane(bi, owner), idx = 4 * owner + sub;
        const float mys = bi == 0 ? s4[0] : (bi == 1 ? s4[1] : (bi == 2 ? s4[2] : s4[3]));
        const float sval = rdlane(mys, owner);
        if (lane == owner) { if (sub == 0) w0 = NINF; else if (sub == 1) w1 = NINF; else if (sub == 2) w2 = NINF; else w3 = NINF; }
        if (lane == k) { my_e = idx; my_s = sval; }
    }
    float sum = (lane < 8) ? my_s : 0.f;
    sum += dppf<DPP_X1>(sum); sum += dppf<DPP_X2>(sum); sum += dppf<DPP_HM>(sum);
    e_out = my_e; g_out = my_s / sum * 2.5f;
}

DI void p3a_ssm(const Params& P, char* lds) {
    const int tid = opaque_tid(), lane = tid & 63, wid = tid >> 6;
    float* buf = (float*)(lds + wid * SSM_WAVE_LDS);
    const float* ABARL = (const float*)(P.ws + WS_ABARL); const float* E = (const float*)(P.ws + WS_E);
    for (int wt = blockIdx.x * 8 + wid; wt < 8192; wt += gridDim.x * 8) {
        const int g = wt & 31, kk = (wt >> 5) & 63, b = wt >> 11, k = (b & 1) ? 63 - kk : kk;
        const float lr = ABARL[g * 128 + lane], li = ABARL[g * 128 + 64 + lane];
        float cr = 0.f, ci = 0.f;
        for (int k0 = 0; k0 < k; k0 += 8) {
            float er[8], ei[8];
#pragma unroll
            for (int j = 0; j < 8; ++j) { const bool ok = (k0 + j) < k; const float* ep = E + (size_t)((b * 64 + (ok ? k0 + j : 0)) * 32 + g) * 128; er[j] = ep[lane]; ei[j] = ep[64 + lane]; }
#pragma unroll
            for (int j = 0; j < 8; ++j) if (k0 + j < k) { const float nr = lr * cr - li * ci + er[j], ni = lr * ci + li * cr + ei[j]; cr = nr; ci = ni; }
        }
        ssm_task<true>(P, buf, b, k, g, lane, cr, ci);
    }
}
struct EpiGluE {
    static constexpr bool MID = false, PREP = false;
    const bf16_t* ygl; bf16_t* merged; const float* bglu; float* ssq;
    DI void operator()(const f32x4 (&acc)[2][2][4][2], const pg8::Unit& u, int wr, int wc, int fr, int fq) const {
        f32x4 bv[2][2];
#pragma unroll
        for (int bj = 0; bj < 2; ++bj)
#pragma unroll
            for (int n = 0; n < 2; ++n) bv[bj][n] = *(const f32x4*)(bglu + 256 * u.pn + 128 * bj + 32 * wc + 8 * fq + 4 * n);
#pragma unroll
        for (int ai = 0; ai < 2; ++ai)
#pragma unroll
            for (int m = 0; m < 4; ++m) {
                const size_t row = (size_t)256 * u.pm + 128 * ai + 64 * wr + 16 * m + fr; float ss = 0.f;
#pragma unroll
                for (int bj = 0; bj < 2; ++bj) {
                    const int col = 256 * u.pn + 128 * bj + 32 * wc + 8 * fq; const u32x4 yw = *(const u32x4*)(ygl + row * 512 + col);
                    const f32x4 z0 = acc[ai][bj][m][0] + bv[bj][0], z1 = acc[ai][bj][m][1] + bv[bj][1];
                    const float o0 = bflo(yw[0]) * sigmoidf_(z0[0]), o1 = bfhi(yw[0]) * sigmoidf_(z0[1]), o2 = bflo(yw[1]) * sigmoidf_(z0[2]), o3 = bfhi(yw[1]) * sigmoidf_(z0[3]);
                    const float o4 = bflo(yw[2]) * sigmoidf_(z1[0]), o5 = bfhi(yw[2]) * sigmoidf_(z1[1]), o6 = bflo(yw[3]) * sigmoidf_(z1[2]), o7 = bfhi(yw[3]) * sigmoidf_(z1[3]);
                    ss += (o0 * o0 + o1 * o1) + (o2 * o2 + o3 * o3) + (o4 * o4 + o5 * o5) + (o6 * o6 + o7 * o7);
                    *(u32x4*)(merged + row * 1024 + 512 + col) = (u32x4){pk2(o0, o1), pk2(o2, o3), pk2(o4, o5), pk2(o6, o7)};
                }
                ss = xsum16(ss); ss = xsum32(ss);
                if (fq == 0) ssq[row * 8 + u.pn * 4 + wc] = ss;
                asm volatile("" ::: "memory");
            }
    }
};
DI void p3b_glu(const Params& P, char* lds) {
    pg8::DenseOrder S; S.init(P.ws + WS_YGL, P.ws + WS_WGLU, T, 512, 512, gridDim.x, blockIdx.x);
    EpiGluE E{(const bf16_t*)(P.ws + WS_YGL), (bf16_t*)(P.ws + WS_MERGED), P.b_glu, (float*)(P.ws + WS_SSQ)};
    pg8::gemm_phase<EpiGluE, pg8::DenseOrder, false>((LAS unsigned char*)lds, 512, S, E);
}
struct EpiResidE {
    static constexpr bool MID = false, PREP = false;
    bf16_t* io; const float* ada; int goff;
    DI void operator()(const f32x4 (&acc)[2][2][4][2], const pg8::Unit& u, int wr, int wc, int fr, int fq) const {
        const float* gate = ada + ((256 * u.pm) >> 13) * 6144 + goff + 256 * u.pn + 32 * wc + 8 * fq;
        f32x4 gv[2][2];
#pragma unroll
        for (int bj = 0; bj < 2; ++bj)
#pragma unroll
            for (int n = 0; n < 2; ++n) gv[bj][n] = *(const f32x4*)(gate + 128 * bj + 4 * n);
#pragma unroll
        for (int ai = 0; ai < 2; ++ai)
#pragma unroll
            for (int m = 0; m < 4; ++m) {
                bf16_t* p = io + ((size_t)256 * u.pm + 128 * ai + 64 * wr + 16 * m + fr) * 1024 + 256 * u.pn + 32 * wc + 8 * fq; u32x4 xw[2];
#pragma unroll
                for (int bj = 0; bj < 2; ++bj) xw[bj] = *(const u32x4*)(p + 128 * bj);
#pragma unroll
                for (int bj = 0; bj < 2; ++bj) {
                    const f32x4 a0 = acc[ai][bj][m][0] * gv[bj][0], a1 = acc[ai][bj][m][1] * gv[bj][1]; const u32x4 w = xw[bj];
                    *(u32x4*)(p + 128 * bj) = (u32x4){pk2(ALPHA * bflo(w[0]) + a0[0], ALPHA * bfhi(w[0]) + a0[1]), pk2(ALPHA * bflo(w[1]) + a0[2], ALPHA * bfhi(w[1]) + a0[3]),
                                                      pk2(ALPHA * bflo(w[2]) + a1[0], ALPHA * bfhi(w[2]) + a1[1]), pk2(ALPHA * bflo(w[3]) + a1[2], ALPHA * bfhi(w[3]) + a1[3])};
                }
                asm volatile("" ::: "memory");
            }
    }
};
struct EpiOutProjE {
    static constexpr bool MID = true, PREP = true;
    const float* x; bf16_t* out; const float* ada; const float* attsq; const float* ssq; LAS float* tab;
    DI void prep(const pg8::Unit& u, int tid) const {
        if (tid < 256) {
            const size_t row = (size_t)256 * u.pm + tid;
            const f32x4 p0 = *(const f32x4*)(attsq + row * 8), p1 = *(const f32x4*)(attsq + row * 8 + 4), q0 = *(const f32x4*)(ssq + row * 8), q1 = *(const f32x4*)(ssq + row * 8 + 4);
            const float ra = rsqrtf((((p0[0] + p0[1]) + (p0[2] + p0[3])) + ((p1[0] + p1[1]) + (p1[2] + p1[3]))) * (1.f / 512.f) + EPS);
            const float rs = rsqrtf((((q0[0] + q0[1]) + (q0[2] + q0[3])) + ((q1[0] + q1[1]) + (q1[2] + q1[3]))) * (1.f / 512.f) + EPS);
            *(LAS f32x2*)(tab + (u.aux * 256 + tid) * 2) = (f32x2){ra, rs};
        }
    }
    DI void mid(f32x4 (&acc)[2][2][4][2], const pg8::Unit& u, int wr, int wc, int fr, int fq) const {
#pragma unroll
        for (int ai = 0; ai < 2; ++ai)
#pragma unroll
            for (int m = 0; m < 4; ++m) {
                const f32x2 r2 = *(const LAS f32x2*)(tab + (u.aux * 256 + 128 * ai + 64 * wr + 16 * m + fr) * 2); const float f = r2[0] * __builtin_amdgcn_rcpf(r2[1]);
#pragma unroll
                for (int bj = 0; bj < 2; ++bj)
#pragma unroll
                    for (int n = 0; n < 2; ++n) acc[ai][bj][m][n] *= f;
            }
    }
    DI void operator()(const f32x4 (&acc)[2][2][4][2], const pg8::Unit& u, int wr, int wc, int fr, int fq) const {
        const float* gate = ada + ((256 * u.pm) >> 13) * 6144 + 2048 + 256 * u.pn + 32 * wc + 8 * fq;
        f32x4 gv[2][2];
#pragma unroll
        for (int bj = 0; bj < 2; ++bj)
#pragma unroll
            for (int n = 0; n < 2; ++n) gv[bj][n] = *(const f32x4*)(gate + 128 * bj + 4 * n);
#pragma unroll
        for (int ai = 0; ai < 2; ++ai)
#pragma unroll
            for (int m = 0; m < 4; ++m) {
                const int rl = 128 * ai + 64 * wr + 16 * m + fr; const size_t row = (size_t)256 * u.pm + rl; const size_t o = row * 1024 + 256 * u.pn + 32 * wc + 8 * fq; f32x4 xv[2][2];
                const float r_s = tab[(u.aux * 256 + rl) * 2 + 1];
#pragma unroll
                for (int bj = 0; bj < 2; ++bj)
#pragma unroll
                    for (int n = 0; n < 2; ++n) xv[bj][n] = *(const f32x4*)(x + o + 128 * bj + 4 * n);
#pragma unroll
                for (int bj = 0; bj < 2; ++bj) {
                    const f32x4 v0 = ALPHA * xv[bj][0] + (gv[bj][0] * r_s) * acc[ai][bj][m][0], v1 = ALPHA * xv[bj][1] + (gv[bj][1] * r_s) * acc[ai][bj][m][1];
                    *(u32x4*)(out + o + 128 * bj) = (u32x4){pk2(v0[0], v0[1]), pk2(v0[2], v0[3]), pk2(v1[0], v1[1]), pk2(v1[2], v1[3])};
                }
                asm volatile("" ::: "memory");
            }
    }
};
DI void p3d_outproj(const Params& P, char* lds) {
    pg8::DenseOrder S; S.init(P.ws + WS_MERGED, P.ws + WS_WOUT, T, 1024, 1024, gridDim.x, blockIdx.x);
    EpiOutProjE E{P.x, (bf16_t*)(P.ws + WS_XZ), (const float*)(P.ws + WS_ADA), (const float*)(P.ws + WS_ATTSQ), (const float*)(P.ws + WS_SSQ), (LAS float*)((LAS unsigned char*)lds + P5TAB_OFF)};
    pg8::gemm_phase<EpiOutProjE, pg8::DenseOrder, false>((LAS unsigned char*)lds, 1024, S, E);
}
DI void p3e_ln1(const Params& P) {
    const int tid = opaque_tid(), lane = tid & 63, wid = tid >> 6;
    bf16_t* H2 = (bf16_t*)(P.ws + WS_H2); bf16_t* XZ = (bf16_t*)(P.ws + WS_XZ);
    for (int row = blockIdx.x * 8 + wid; row < T; row += gridDim.x * 8) {
        const float* ADA = (const float*)(P.ws + WS_ADA) + (row >> 13) * 6144;
        bf16_t* vp = XZ + (size_t)row * 1024 + 8 * lane; float v[16]; float s = 0.f;
#pragma unroll
        for (int j = 0; j < 2; ++j) { const u32x4 w = *(const u32x4*)(vp + 512 * j);
#pragma unroll
            for (int i = 0; i < 4; ++i) { v[8 * j + 2 * i] = bflo(w[i]); v[8 * j + 2 * i + 1] = bfhi(w[i]); s += v[8 * j + 2 * i] + v[8 * j + 2 * i + 1]; } }
        const float mean = wave_sum(s) * (1.f / 1024.f); float q = 0.f;
#pragma unroll
        for (int i = 0; i < 16; ++i) { v[i] -= mean; q += v[i] * v[i]; }
        const float rstd = rsqrtf(wave_sum(q) * (1.f / 1024.f) + EPS);
#pragma unroll
        for (int j = 0; j < 2; ++j) {
            const int col = 8 * lane + 512 * j; float x1[8], hv[8];
#pragma unroll
            for (int i = 0; i < 2; ++i) {
                const f32x4 g = *(const f32x4*)(P.ln1_g + col + 4 * i), bb = *(const f32x4*)(P.ln1_b + col + 4 * i), sc2 = *(const f32x4*)(ADA + 4096 + col + 4 * i), sh2 = *(const f32x4*)(ADA + 3072 + col + 4 * i);
#pragma unroll
                for (int t = 0; t < 4; ++t) { x1[4 * i + t] = v[8 * j + 4 * i + t] * rstd * g[t] + bb[t]; hv[4 * i + t] = x1[4 * i + t] * (1.f + sc2[t]) + sh2[t]; }
            }
            *(u32x4*)(vp + 512 * j) = (u32x4){pk2(x1[0], x1[1]), pk2(x1[2], x1[3]), pk2(x1[4], x1[5]), pk2(x1[6], x1[7])};
            *(u32x4*)(H2 + (size_t)row * 1024 + col) = (u32x4){pk2(hv[0], hv[1]), pk2(hv[2], hv[3]), pk2(hv[4], hv[5]), pk2(hv[6], hv[7])};
        }
    }
}
struct EpiRouterSharedE {
    static constexpr bool MID = false, PREP = false;
    float* sc; bf16_t* hids;
    DI void operator()(const f32x4 (&acc)[2][2][4][2], const pg8::Unit& u, int wr, int wc, int fr, int fq) const {
#pragma unroll
        for (int ai = 0; ai < 2; ++ai)
#pragma unroll
            for (int m = 0; m < 4; ++m) {
                const size_t row = (size_t)256 * u.pm + 128 * ai + 64 * wr + 16 * m + fr;
                if (u.pn == 0) {
#pragma unroll
                    for (int bj = 0; bj < 2; ++bj)
#pragma unroll
                        for (int n = 0; n < 2; ++n) { const f32x4 v = acc[ai][bj][m][n]; *(f32x4*)(sc + row * 256 + 128 * bj + 32 * wc + 8 * fq + 4 * n) = (f32x4){sigmoidf_(v[0]), sigmoidf_(v[1]), sigmoidf_(v[2]), sigmoidf_(v[3])}; }
                } else {
                    const f32x4 g0 = acc[ai][0][m][0], g1 = acc[ai][0][m][1], u0 = acc[ai][1][m][0], u1 = acc[ai][1][m][1];
                    *(u32x4*)(hids + row * 256 + 128 * (u.pn - 1) + 32 * wc + 8 * fq) = (u32x4){pk2(siluf_(g0[0]) * u0[0], siluf_(g0[1]) * u0[1]), pk2(siluf_(g0[2]) * u0[2], siluf_(g0[3]) * u0[3]),
                                                                                                 pk2(siluf_(g1[0]) * u1[0], siluf_(g1[1]) * u1[1]), pk2(siluf_(g1[2]) * u1[2], siluf_(g1[3]) * u1[3])};
                }
                asm volatile("" ::: "memory");
            }
    }
};
DI void p3f_router_shared(const Params& P, char* lds) {
    pg8::DenseOrder S; S.init(P.ws + WS_H2, P.ws + WS_WR, T, 768, 1024, gridDim.x, blockIdx.x);
    EpiRouterSharedE E{(float*)(P.ws + WS_SCORES), (bf16_t*)(P.ws + WS_HIDS)};
    pg8::gemm_phase<EpiRouterSharedE, pg8::DenseOrder, false>((LAS unsigned char*)lds, 1024, S, E);
    const int nb = fill_blocks(), G = gridDim.x;
    if (nb > 0 && nb < G && (int)blockIdx.x >= G - nb) conv_experts_block(P, lds, CONV_NT - nb * FILL_TILES_PER_WG + ((int)blockIdx.x - (G - nb)), CONV_NT, nb);
}
DI void p3g_route_shared_down(const Params& P, char* lds) {
    const int tid = opaque_tid(), lane = tid & 63, wid = tid >> 6;
    int* hist = (int*)(lds + P5TAB_OFF); int* base = hist + 256; int* hist2 = base + 256; int* rt_e = hist2 + 256; float* rt_g = (float*)(rt_e + 1024);
    for (int pm = blockIdx.x; pm < 256; pm += gridDim.x) {
        const int row0 = pm * 128; const float* SC = (const float*)(P.ws + WS_SCORES) + (size_t)row0 * 256;
        __syncthreads();
        if (tid < 256) hist[tid] = 0;
        __syncthreads();
        for (int tl = wid * 16; tl < wid * 16 + 16; ++tl) {
            int e; float gte; route_token(SC + (size_t)tl * 256, P.router_bias, lane, e, gte);
            if (lane < 8) { rt_e[tl * 8 + lane] = e; rt_g[tl * 8 + lane] = gte; atomicAdd(&hist[e], 1); }
        }
        __syncthreads();
        if (tid < 256) { const int cnt = hist[tid]; base[tid] = cnt ? atomicAdd((int*)(P.ws + WS_CNT) + tid, cnt) : 0; hist2[tid] = 0; }
        __syncthreads();
        for (int a = tid; a < 1024; a += NTHR) {
            const int e = rt_e[a]; const int pos = base[e] + atomicAdd(&hist2[e], 1); const int slot = (row0 + (a >> 3)) * 8 + (a & 7);
            ((int*)(P.ws + WS_BINS))[(size_t)e * T + pos] = slot; ((float*)(P.ws + WS_BING))[(size_t)e * T + pos] = rt_g[a]; ((int*)(P.ws + WS_EIDX))[slot] = e; ((int*)(P.ws + WS_EPOS))[slot] = pos;
        }
    }
    __syncthreads();
    pg8::DenseOrder S; S.init(P.ws + WS_HIDS, P.ws + WS_WSD, T, 1024, 256, gridDim.x, blockIdx.x);
    EpiResidE E{(bf16_t*)(P.ws + WS_XZ), (const float*)(P.ws + WS_ADA), 5120};
    pg8::gemm_phase<EpiResidE, pg8::DenseOrder, false>((LAS unsigned char*)lds, 256, S, E);
}

DI void moe_tables(const Params& P, char* lds) {
    LAS int* tstart = (LAS int*)((LAS unsigned char*)lds + P5TAB_OFF); LAS int* estart = tstart + 260;
    const int tid = opaque_tid();
    if (tid < 64) {
        const int* gc = (const int*)(P.ws + WS_CNT) + 4 * tid; const int c0 = gc[0], c1 = gc[1], c2 = gc[2], c3 = gc[3];
        const int t0 = (c0 + 255) >> 8, t1 = (c1 + 255) >> 8, t2 = (c2 + 255) >> 8, t3 = (c3 + 255) >> 8;
        int cs = c0 + c1 + c2 + c3, ts = t0 + t1 + t2 + t3; const int cown = cs, town = ts;
#pragma unroll
        for (int o = 1; o < 64; o <<= 1) { const int a = __shfl_up(cs, o), b = __shfl_up(ts, o); if (tid >= o) { cs += a; ts += b; } }
        int ce = cs - cown, te = ts - town;
        estart[4 * tid] = ce; tstart[4 * tid] = te; ce += c0; te += t0; estart[4 * tid + 1] = ce; tstart[4 * tid + 1] = te; ce += c1; te += t1;
        estart[4 * tid + 2] = ce; tstart[4 * tid + 2] = te; ce += c2; te += t2; estart[4 * tid + 3] = ce; tstart[4 * tid + 3] = te;
        if (tid == 63) { estart[256] = cs; tstart[256] = ts; }
    }
    __syncthreads();
}
struct MoeOrder {
    static constexpr bool RAGGED = true;
    const LAS int* tstart; const LAS int* estart; const char* Abase; const char* Bbase; const int* bins; int nunits, per, G, vb, mode;
    DI bool next(int i, pg8::Unit& u) const {
        const long L = (long)i * G + vb; if (L >= (long)nunits) return false;
        const int tile = (int)(L / per), sub = (int)(L % per);
        int lo = 0, hi = NEXP;
        while (hi - lo > 1) { const int mid = (lo + hi) >> 1; if (tstart[mid] <= tile) lo = mid; else hi = mid; }
        const int e = lo, rb = tile - tstart[e], cnt = estart[e + 1] - estart[e];
        u.rows = (cnt - 256 * rb) < 256 ? (cnt - 256 * rb) : 256; u.pm = estart[e] + 256 * rb; u.pn = sub; u.aux = e * T + 256 * rb;
        if (mode == 0) { u.A = Abase; u.B = Bbase + ((size_t)e * 512 + 256 * sub) * 2048; }
        else { u.A = Abase + (size_t)u.pm * 512; u.B = Bbase + ((size_t)e * 1024 + 256 * sub) * 512; }
        return true;
    }
    DI unsigned row_off(const pg8::Unit& u, int r) const { const int v = bins[u.aux + (r < u.rows ? r : u.rows - 1)]; return (unsigned)(v >> 3) * 2048u; }
};
struct EpiGateUp {
    static constexpr bool MID = false, PREP = false;
    bf16_t* H; const float* bing;
    DI void operator()(const f32x4 (&acc)[2][2][4][2], const pg8::Unit& u, int wr, int wc, int fr, int fq) const {
        float gt[2][4];
#pragma unroll
        for (int ai = 0; ai < 2; ++ai)
#pragma unroll
            for (int m = 0; m < 4; ++m) { const int r = 128 * ai + 64 * wr + 16 * m + fr; gt[ai][m] = bing[u.aux + (r < u.rows ? r : u.rows - 1)]; }
#pragma unroll
        for (int ai = 0; ai < 2; ++ai)
#pragma unroll
            for (int m = 0; m < 4; ++m) {
                const int r = 128 * ai + 64 * wr + 16 * m + fr; const float g = gt[ai][m];
                const f32x4 g0 = acc[ai][0][m][0], g1 = acc[ai][0][m][1], u0 = acc[ai][1][m][0], u1 = acc[ai][1][m][1];
                const u32x4 w = (u32x4){pk2(siluf_(g0[0]) * u0[0] * g, siluf_(g0[1]) * u0[1] * g), pk2(siluf_(g0[2]) * u0[2] * g, siluf_(g0[3]) * u0[3] * g),
                                        pk2(siluf_(g1[0]) * u1[0] * g, siluf_(g1[1]) * u1[1] * g), pk2(siluf_(g1[2]) * u1[2] * g, siluf_(g1[3]) * u1[3] * g)};
                if (r < u.rows) *(u32x4*)(H + (size_t)(u.pm + r) * 256 + 128 * u.pn + 32 * wc + 8 * fq) = w;
                asm volatile("" ::: "memory");
            }
    }
};
struct EpiDown {
    static constexpr bool MID = false, PREP = false;
    unsigned char* OA; unsigned char* OB;
    DI void operator()(const f32x4 (&acc)[2][2][4][2], const pg8::Unit& u, int wr, int wc, int fr, int fq) const {
#pragma unroll
        for (int ai = 0; ai < 2; ++ai)
#pragma unroll
            for (int m = 0; m < 4; ++m) {
                const int r = 128 * ai + 64 * wr + 16 * m + fr;
                if (r < u.rows) {
                    const int pos = u.pm + r; unsigned char* rowp = (pos < T * 4 ? OA + (size_t)pos * 1024 : OB + (size_t)(pos - T * 4) * 1024) + 256 * u.pn + 64 * wc + 16 * fq;
                    int pk[4];
#pragma unroll
                    for (int bj = 0; bj < 2; ++bj) {
                        f32x4 v0 = acc[ai][bj][m][0] * OUT_SCALE, v1 = acc[ai][bj][m][1] * OUT_SCALE;
#pragma unroll
                        for (int i = 0; i < 4; ++i) { v0[i] = fminf(fmaxf(v0[i], -448.f), 448.f); v1[i] = fminf(fmaxf(v1[i], -448.f), 448.f); }
                        int lo = 0, hi = 0;
                        lo = __builtin_amdgcn_cvt_pk_fp8_f32(v0[0], v0[1], lo, false); lo = __builtin_amdgcn_cvt_pk_fp8_f32(v0[2], v0[3], lo, true);
                        hi = __builtin_amdgcn_cvt_pk_fp8_f32(v1[0], v1[1], hi, false); hi = __builtin_amdgcn_cvt_pk_fp8_f32(v1[2], v1[3], hi, true);
                        pk[2 * bj] = lo; pk[2 * bj + 1] = hi;
                    }
                    *(u32x4*)rowp = (u32x4){(unsigned)pk[0], (unsigned)pk[1], (unsigned)pk[2], (unsigned)pk[3]};
                }
                asm volatile("" ::: "memory");
            }
    }
};
DI int xcd_vb() { const int G = gridDim.x; return (G % 8 == 0) ? (int)(blockIdx.x % 8) * (G / 8) + (int)(blockIdx.x / 8) : (int)blockIdx.x; }
DI void p5a_gateup(const Params& P, char* lds) {
    moe_tables(P, lds);
    const LAS int* tstart = (const LAS int*)((LAS unsigned char*)lds + P5TAB_OFF);
    MoeOrder S{tstart, tstart + 260, (const char*)(P.ws + WS_H2), (const char*)(P.ws + WS_WEGU), (const int*)(P.ws + WS_BINS), tstart[256] * 2, 2, (int)gridDim.x, xcd_vb(), 0};
    EpiGateUp E{(bf16_t*)(P.ws + WS_HIDALL), (const float*)(P.ws + WS_BING)};
    pg8::gemm_phase<EpiGateUp, MoeOrder, true>((LAS unsigned char*)lds, 1024, S, E);
}
DI void p5b_down(const Params& P, char* lds) {
    const LAS int* tstart = (const LAS int*)((LAS unsigned char*)lds + P5TAB_OFF);
    MoeOrder S{tstart, tstart + 260, (const char*)(P.ws + WS_HIDALL), (const char*)(P.ws + WS_WED), (const int*)(P.ws + WS_BINS), tstart[256] * 4, 4, (int)gridDim.x, xcd_vb(), 1};
    EpiDown E{P.ws + WS_OUTA, P.ws + WS_OUTB};
    pg8::gemm_phase<EpiDown, MoeOrder, false>((LAS unsigned char*)lds, 256, S, E);
}

DI void p6_combine(const Params& P, char* lds) {
    const LAS int* estart = (const LAS int*)((LAS unsigned char*)lds + P5TAB_OFF) + 260;
    const int tid = opaque_tid(), lane = tid & 63, wid = tid >> 6;
    const unsigned char* OA = P.ws + WS_OUTA; const unsigned char* OB = P.ws + WS_OUTB;
    for (int row = blockIdx.x * 8 + wid; row < T; row += gridDim.x * 8) {
        const float* ADA = (const float*)(P.ws + WS_ADA) + (row >> 13) * 6144 + 5120;
        int mypos = 0;
        if (lane < 8) { const int e = ((const int*)(P.ws + WS_EIDX))[row * 8 + lane]; mypos = estart[e] + ((const int*)(P.ws + WS_EPOS))[row * 8 + lane]; }
        u32x4 w[8];
#pragma unroll
        for (int s = 0; s < 8; ++s) { const int pos = __builtin_amdgcn_readlane(mypos, s); w[s] = *(const u32x4*)((pos < T * 4 ? OA + (size_t)pos * 1024 : OB + (size_t)(pos - T * 4) * 1024) + lane * 16); }
        float f[16];
#pragma unroll
        for (int i = 0; i < 16; ++i) f[i] = 0.f;
#pragma unroll
        for (int s = 0; s < 8; ++s)
#pragma unroll
            for (int q = 0; q < 4; ++q) { const f32x2 a = __builtin_amdgcn_cvt_pk_f32_fp8((int)w[s][q], false), bb = __builtin_amdgcn_cvt_pk_f32_fp8((int)w[s][q], true);
                f[4 * q] += a[0]; f[4 * q + 1] += a[1]; f[4 * q + 2] += bb[0]; f[4 * q + 3] += bb[1]; }
        float* op = P.out + (size_t)row * 1024 + 16 * lane; float z[16]; float sm = 0.f;
        const bf16_t* zp = (const bf16_t*)(P.ws + WS_XZ) + (size_t)row * 1024 + 16 * lane; const u32x4 zw0 = *(const u32x4*)zp, zw1 = *(const u32x4*)(zp + 8);
#pragma unroll
        for (int i = 0; i < 4; ++i) { const f32x4 g = *(const f32x4*)(ADA + 16 * lane + 4 * i); const unsigned wa = (i < 2 ? zw0 : zw1)[2 * (i & 1)], wb = (i < 2 ? zw0 : zw1)[2 * (i & 1) + 1];
            const f32x4 zs = (f32x4){bflo(wa), bfhi(wa), bflo(wb), bfhi(wb)};
#pragma unroll
            for (int q = 0; q < 4; ++q) { const float v = zs[q] + g[q] * (f[4 * i + q] * (1.f / OUT_SCALE)); z[4 * i + q] = v; sm += v; } }
        const float mean = wave_sum(sm) * (1.f / 1024.f); float qv = 0.f;
#pragma unroll
        for (int i = 0; i < 16; ++i) { z[i] -= mean; qv += z[i] * z[i]; }
        const float rstd = rsqrtf(wave_sum(qv) * (1.f / 1024.f) + EPS);
#pragma unroll
        for (int i = 0; i < 4; ++i) { const f32x4 g = *(const f32x4*)(P.ln2_g + 16 * lane + 4 * i), bb = *(const f32x4*)(P.ln2_b + 16 * lane + 4 * i);
            *(f32x4*)(op + 4 * i) = (f32x4){z[4 * i] * rstd * g[0] + bb[0], z[4 * i + 1] * rstd * g[1] + bb[1], z[4 * i + 2] * rstd * g[2] + bb[2], z[4 * i + 3] * rstd * g[3] + bb[3]}; }
    }
}

__global__ void __launch_bounds__(NTHR) fwd_megakernel(Params P) {
    extern __shared__ __attribute__((aligned(16))) char lds[];
    volatile LAS unsigned* bst = (volatile LAS unsigned*)((LAS unsigned char*)lds + BARLDS_OFF);
    if (threadIdx.x < 2) bst[threadIdx.x] = 0u;
    __syncthreads();
    const XcdBarrier bar = xcd_barrier_post((unsigned*)(P.ws + WS_BAR), bst);
    p0_prologue(P, lds);
    xcd_barrier(bar);
    p1_inproj_and_experts(P, lds);
    xcd_barrier(bar);
    p2_mixer(P, lds);
    xcd_barrier(bar);
    p3a_ssm(P, lds);
    xcd_barrier(bar);
    p3b_glu(P, lds);
    xcd_barrier(bar);
    p3d_outproj(P, lds);
    xcd_barrier(bar);
    p3e_ln1(P);
    xcd_barrier(bar);
    p3f_router_shared(P, lds);
    xcd_barrier(bar);
    p3g_route_shared_down(P, lds);
    xcd_barrier(bar);
    p5a_gateup(P, lds);
    xcd_barrier(bar);
    p5b_down(P, lds);
    xcd_barrier(bar);
    p6_combine(P, lds);
}


#ifdef ANALYZE_PHASES
template <int PH> __global__ void __launch_bounds__(NTHR) phase_kernel(Params P) {
    extern __shared__ __attribute__((aligned(16))) char lds[];
    if (PH == 0) p0_prologue(P, lds);
    if (PH == 1) p1_inproj_and_experts(P, lds);
    if (PH == 2) p2_mixer(P, lds);
    if (PH == 3) p3a_ssm(P, lds);
    if (PH == 7) p3b_glu(P, lds);
    if (PH == 9) p3d_outproj(P, lds);
    if (PH == 10) p3e_ln1(P);
    if (PH == 11) p3f_router_shared(P, lds);
    if (PH == 12) p3g_route_shared_down(P, lds);
    if (PH == 4) p5a_gateup(P, lds);
    if (PH == 5) p5b_down(P, lds);
    if (PH == 6) p6_combine(P, lds);
}
template __global__ void phase_kernel<0>(Params); template __global__ void phase_kernel<1>(Params); template __global__ void phase_kernel<2>(Params); template __global__ void phase_kernel<3>(Params);
template __global__ void phase_kernel<4>(Params); template __global__ void phase_kernel<5>(Params); template __global__ void phase_kernel<6>(Params);
template __global__ void phase_kernel<7>(Params); template __global__ void phase_kernel<8>(Params); template __global__ void phase_kernel<9>(Params); template __global__ void phase_kernel<10>(Params); template __global__ void phase_kernel<11>(Params); template __global__ void phase_kernel<12>(Params);
#endif

extern "C" void kernel_launch(void* const* d_in, const int* in_sizes, int n_in, void* d_out, int out_size, void* d_ws, size_t ws_size, hipStream_t stream) {
    static int grid = 0;
    if (grid == 0) {
        if (n_in != 31 || out_size != T * D || ws_size < WS_END) { fprintf(stderr, "kernel_launch: unexpected problem (n_in %d, out %d, ws %zu < %zu)\n", n_in, out_size, ws_size, (size_t)WS_END); grid = -1; return; }
        int dev = 0, cus = 0, per_cu = 0;
        (void)hipGetDevice(&dev); (void)hipDeviceGetAttribute(&cus, hipDeviceAttributeMultiprocessorCount, dev);
        (void)hipFuncSetAttribute((const void*)fwd_megakernel, hipFuncAttributeMaxDynamicSharedMemorySize, LDS_BYTES);
        (void)hipOccupancyMaxActiveBlocksPerMultiprocessor(&per_cu, (const void*)fwd_megakernel, NTHR, LDS_BYTES);
        if (per_cu < 1) { fprintf(stderr, "kernel_launch: occupancy query says %d blocks per CU\n", per_cu); grid = -1; return; }
        grid = cus * 1;
        if (grid > 256) grid = 256;
    }
    if (grid < 0) return;
    (void)hipMemsetAsync(d_ws, 0, 65536, stream);
    Params p{};
    const float** pf = (const float**)&p;
    for (int i = 0; i < 31; ++i) pf[i] = (const float*)d_in[i];
    p.out = (float*)d_out; p.ws = (unsigned char*)d_ws;
    void* args[] = {&p};
    hipError_t e = hipLaunchCooperativeKernel((const void*)fwd_megakernel, dim3(grid), dim3(NTHR), args, LDS_BYTES, stream);
    if (e != hipSuccess) fprintf(stderr, "cooperative launch failed: %s (grid %d)\n", hipGetErrorString(e), grid);
}
```

```cpp
#include <hip/hip_runtime.h>
#include <cstdio>
#include <cstdint>

#define DI __device__ __forceinline__
typedef unsigned short bf16_t;
typedef short bf16x8 __attribute__((ext_vector_type(8)));
typedef float f32x2 __attribute__((ext_vector_type(2)));
typedef float f32x4 __attribute__((ext_vector_type(4)));
typedef float f32x16 __attribute__((ext_vector_type(16)));
typedef unsigned u32x2 __attribute__((ext_vector_type(2)));
typedef unsigned u32x4 __attribute__((ext_vector_type(4)));
typedef __bf16 bf16v2 __attribute__((ext_vector_type(2)));

#define MFMA16(a, b, c) __builtin_amdgcn_mfma_f32_16x16x32_bf16((a), (b), (c), 0, 0, 0)
#define MFMA32(a, b, c) __builtin_amdgcn_mfma_f32_32x32x16_bf16((a), (b), (c), 0, 0, 0)
#define LDS_FENCE() asm volatile("s_waitcnt lgkmcnt(0)" ::: "memory")

constexpr int D = 1024, BATCH = 4, SEQ = 8192, T = BATCH * SEQ, NPROJ = 2048;
constexpr int NTHR = 512;
constexpr int NEXP = 256, TOPK = 8;
constexpr float ALPHA = 1.189207115002721f;
constexpr float EPS = 1e-5f;
constexpr float NEG = -1e30f;
constexpr float OUT_SCALE = 64.f;

constexpr size_t MiB = 1u << 20;
constexpr size_t WS_CNT = 0;
constexpr size_t WS_ADACNT = 2048;
constexpr size_t WS_BAR = 16384;
constexpr size_t WS_ADA = 64 * 1024;
constexpr size_t WS_ABAR = 192 * 1024;
constexpr size_t WS_ABARL = 208 * 1024;
constexpr size_t WS_BCAT = 256 * 1024;
constexpr size_t WS_CCAT = 384 * 1024;
constexpr size_t WS_WIN = 2 * MiB;
constexpr size_t WS_WGLU = 6 * MiB;
constexpr size_t WS_WR = 6 * MiB + 512 * 1024;
constexpr size_t WS_WSGU = 7 * MiB;
constexpr size_t WS_WOUT = 8 * MiB;
constexpr size_t WS_WSD = 10 * MiB;
constexpr size_t WS_EIDX = 11 * MiB;
constexpr size_t WS_EPOS = 12 * MiB;
constexpr size_t WS_HIDS = 14 * MiB;
constexpr size_t WS_BINS = 30 * MiB;
constexpr size_t WS_BING = 62 * MiB;
constexpr size_t WS_H2 = 94 * MiB;
constexpr size_t WS_WEGU = 158 * MiB;
constexpr size_t WS_WED = 414 * MiB;
constexpr size_t WS_H1 = 542 * MiB;
constexpr size_t WS_QKVU = 606 * MiB;
constexpr size_t WS_MERGED = 734 * MiB;
constexpr size_t WS_YGL = 798 * MiB;
constexpr size_t WS_SCORES = 830 * MiB;
constexpr size_t WS_E = 862 * MiB;
constexpr size_t WS_ATTSQ = 866 * MiB;
constexpr size_t WS_SSQ = 867 * MiB;
constexpr size_t WS_RS = 868 * MiB;
constexpr size_t WS_HIDALL = 542 * MiB;
constexpr size_t WS_OUTA = 158 * MiB;
constexpr size_t WS_OUTB = 670 * MiB;
constexpr size_t WS_XZ = 926 * MiB;
constexpr size_t WS_END = 1022 * MiB;

constexpr int LDP = 72;
constexpr int GEMM_LDS = (128 + 256) * LDP * 2;
constexpr int MISC_OFF = 57344;
constexpr int SSM_PITCH = 36;
constexpr int SSM_WAVE_LDS = 128 * SSM_PITCH * 4;
constexpr int P5TAB_OFF = 131072;
constexpr int BARLDS_OFF = 148 * 1024;
constexpr int LDS_BYTES = 148 * 1024 + 64;

struct Params {
    const float *x, *c, *rel_bias, *w_ada, *b_ada, *w_in, *a_re, *a_im, *b_re, *b_im, *c_re, *c_im, *ssm_d, *log_dt, *w_glu, *b_glu, *g_att, *g_ssm, *w_out,
        *ln1_g, *ln1_b, *w_router, *router_bias, *w_e_gate, *w_e_up, *w_e_down, *w_s_gate, *w_s_up, *w_s_down, *ln2_g, *ln2_b;
    float* out;
    unsigned char* ws;
};

DI int opaque_tid() { int t = threadIdx.x; asm volatile("" : "+v"(t)); return t; }
DI unsigned pk2(float a, float b) { f32x2 f = {a, b}; bf16v2 r = __builtin_convertvector(f, bf16v2); return __builtin_bit_cast(unsigned, r); }
DI bf16_t f2bf(float a) { return (bf16_t)(pk2(a, 0.f) & 0xffffu); }
DI float bflo(unsigned w) { return __uint_as_float(w << 16); }
DI float bfhi(unsigned w) { return __uint_as_float(w & 0xffff0000u); }
DI float sigmoidf_(float x) { return __builtin_amdgcn_rcpf(1.f + __expf(-x)); }
DI float siluf_(float x) { return x * __builtin_amdgcn_rcpf(1.f + __expf(-x)); }
DI float gelu_tanh(float x) { const float u = 0.7978845608028654f * (x + 0.044715f * x * x * x); const float e = __expf(2.f * u); const float th = 1.f - 2.f * __builtin_amdgcn_rcpf(e + 1.f); return 0.5f * x * (1.f + th); }
template <int CTRL> DI float dppf(float v) { return __builtin_bit_cast(float, __builtin_amdgcn_update_dpp(0, __builtin_bit_cast(int, v), CTRL, 0xF, 0xF, true)); }
DI float rdlane(float v, int l) { return __builtin_bit_cast(float, __builtin_amdgcn_readlane(__builtin_bit_cast(int, v), l)); }
constexpr int DPP_X1 = 0xB1, DPP_X2 = 0x4E, DPP_HM = 0x141, DPP_RM = 0x140;
DI float xsum16(float x) { auto t = __builtin_amdgcn_permlane16_swap(__float_as_uint(x), __float_as_uint(x), false, false); return __uint_as_float(t[0]) + __uint_as_float(t[1]); }
DI float xsum32(float x) { auto t = __builtin_amdgcn_permlane32_swap(__float_as_uint(x), __float_as_uint(x), false, false); return __uint_as_float(t[0]) + __uint_as_float(t[1]); }
DI float xmax32(float x) { auto t = __builtin_amdgcn_permlane32_swap(__float_as_uint(x), __float_as_uint(x), false, false); return fmaxf(__uint_as_float(t[0]), __uint_as_float(t[1])); }
DI float wave_sum(float v) {
    v += dppf<DPP_X1>(v); v += dppf<DPP_X2>(v); v += dppf<DPP_HM>(v); v += dppf<DPP_RM>(v); v = xsum16(v); return xsum32(v);
}

#define LAS __attribute__((address_space(3)))
#define XB_TMO      128
#define XB_XCNT(j)  (256  + 64 * (j))
#define XB_XSUB(j)  (1280 + 64 * (j))
#define XB_XGEN(j)  (2304 + 64 * (j))
#define XB_TOP      3328
#define XB_TOPGEN   3392
#define XB_SPIN_CAP (1u << 18)
DI unsigned xb_ld(unsigned* p) { return __hip_atomic_load(p, __ATOMIC_RELAXED, __HIP_MEMORY_SCOPE_AGENT); }
DI unsigned xb_add(unsigned* p, unsigned v) { return __hip_atomic_fetch_add(p, v, __ATOMIC_RELAXED, __HIP_MEMORY_SCOPE_AGENT); }
DI unsigned xb_xcc_id() { return (unsigned)__builtin_amdgcn_s_getreg((3 << 11) | 20) & 0xFu; }
#define XB_SPIN(cond, bar) do { unsigned _sp = 0; while (cond) { __builtin_amdgcn_s_sleep(1); \
    if ((++_sp & 255u) == 0u) { if (xb_ld(&(bar)[XB_TMO])) break; if (_sp > XB_SPIN_CAP) { atomicAdd(&(bar)[XB_TMO], 1u); break; } } } } while (0)
struct XcdBarrier { unsigned* bar; unsigned x; volatile LAS unsigned* st; };
DI XcdBarrier xcd_barrier_post(unsigned* bar, volatile LAS unsigned* st) {
    XcdBarrier b; b.bar = bar; b.x = xb_xcc_id(); b.st = st;
    if (threadIdx.x == 0) (void)xb_add(&bar[XB_XCNT(b.x)], 1u);
    return b;
}
DI void xcd_barrier_complete(unsigned* bar, unsigned x, unsigned& nloc, unsigned& nx) {
    const unsigned G = gridDim.x * gridDim.y * gridDim.z;
    unsigned sum, cnt, mine, sp = 0u;
    for (;;) {
        sum = 0u; cnt = 0u; mine = 0u;
#pragma unroll
        for (unsigned j = 0; j < 16; ++j) { const unsigned c = xb_ld(&bar[XB_XCNT(j)]); sum += c; cnt += (c > 0u) ? 1u : 0u; mine = (j == x) ? c : mine; }
        if (sum == G) break;
        __builtin_amdgcn_s_sleep(1);
        if ((++sp & 255u) == 0u) { if (xb_ld(&bar[XB_TMO])) break; if (sp > XB_SPIN_CAP) { atomicAdd(&bar[XB_TMO], 1u); break; } }
    }
    nloc = mine > 0u ? mine : 1u; nx = cnt > 0u ? cnt : 1u;
}
DI void xcd_barrier(const XcdBarrier& b) {
    asm volatile("s_waitcnt vmcnt(0)" ::: "memory");
    __syncthreads();
    if (threadIdx.x == 0) {
        unsigned* bar = b.bar;
        __builtin_amdgcn_s_waitcnt(0);
        unsigned nloc = b.st[0], nx = b.st[1];
        if (nloc == 0u) { xcd_barrier_complete(bar, b.x, nloc, nx); b.st[0] = nloc; b.st[1] = nx; }
        const unsigned old = xb_add(&bar[XB_XSUB(b.x)], 1u);
        const unsigned gen = old / nloc;
        if (old + 1u == (gen + 1u) * nloc) {
            __builtin_amdgcn_fence(__ATOMIC_RELEASE, "agent");
            asm volatile("s_waitcnt vmcnt(0)" ::: "memory");
            const unsigned og = xb_add(&bar[XB_TOP], 1u);
            const unsigned tg = og / nx;
            if (og + 1u == (tg + 1u) * nx) xb_add(&bar[XB_TOPGEN], 1u);
            else XB_SPIN(xb_ld(&bar[XB_TOPGEN]) == tg, bar);
            __builtin_amdgcn_fence(__ATOMIC_ACQUIRE, "agent");
            xb_add(&bar[XB_XGEN(b.x)], 1u);
            asm volatile("s_waitcnt vmcnt(0)" ::: "memory");
        } else {
            XB_SPIN(xb_ld(&bar[XB_XGEN(b.x)]) == gen, bar);
            __builtin_amdgcn_fence(__ATOMIC_ACQUIRE, "agent");
            asm volatile("s_waitcnt vmcnt(0)" ::: "memory");
        }
    }
    __syncthreads();
}

namespace pg8 {
constexpr int BM = 256, BK = 64, HALF = 128, HTB = HALF * BK * 2, STAGE_BYTES = 8 * HTB;
DI int lds_byte(int r, int c) { const int st = (r >> 4) * 2 + (c >> 5), rr = r & 15, cc = c & 31, ob = rr * 64 + cc * 2; return st * 1024 + (ob ^ (((ob >> 9) & 1) << 5)); }
DI void stage_rc(int b, int& R, int& C) { const int st = b / 1024, sb = b % 1024, swz = sb ^ (((sb >> 9) & 1) << 5); R = (st >> 1) * 16 + swz / 64; C = (st & 1) * 32 + (swz % 64) / 2; }
DI int perm32(int rho) { const int n = rho >> 4, i = rho & 15; return 8 * (i >> 2) + 4 * n + (i & 3); }
struct Unit { const char* A; const char* B; int pm, pn, rows, aux; };

template <class Epi, class Sched, bool GATHER>
DI void gemm_phase(LAS unsigned char* lds, const int K, const Sched& S, const Epi& E) {
    int tid = threadIdx.x; asm volatile("" : "+v"(tid));
    const int wid = __builtin_amdgcn_readfirstlane(tid >> 6), lane = tid & 63, wr = wid >> 2, wc = wid & 3, fr = lane & 15, fq = lane >> 4;
    const int nt = K / BK;
    unsigned voffA[2], voffB[2]; int Rr[2], Cc[2];
#pragma unroll
    for (int i = 0; i < 2; ++i) { int R, C; stage_rc(tid * 16 + i * 8192, R, C); const int Rb = (R & ~31) + perm32(R & 31); Rr[i] = R; Cc[i] = C;
        voffA[i] = (unsigned)(R * K + C) * 2u; voffB[i] = (unsigned)(Rb * K + C) * 2u; }
    const size_t kstep = (size_t)(BK * 2);
    const size_t hstep = (size_t)HALF * K * 2;
    const unsigned ldsw = (unsigned)wid * 1024u;
    const int aoff = lds_byte(wr * 64 + fr, fq * 8), boff = lds_byte(wc * 32 + fr, fq * 8);
#define PG8_SA(b, h) (((b) * 2 + (h)) * HTB)
#define PG8_SB(b, h) ((4 + (b) * 2 + (h)) * HTB)
#define PG8_STAGE(bufoff, gbase, voff) do { _Pragma("unroll") for (int _i = 0; _i < 2; ++_i) \
        __builtin_amdgcn_global_load_lds((const unsigned*)((const char*)(gbase) + (voff)[_i]), (LAS unsigned*)(lds + (bufoff) + ldsw + _i * 8192), 16, 0, 0); } while (0)
#define PG8_STAGEA(bufoff, gbase, h, nx) do { if constexpr (GATHER) { unsigned _o[2]; _o[0] = (nx) ? na[h][0] : ga[h][0]; _o[1] = (nx) ? na[h][1] : ga[h][1]; PG8_STAGE(bufoff, gbase, _o); } \
        else { PG8_STAGE(bufoff, (gbase) + (h) * hstep, voffA); } } while (0)
#define PG8_LDA(dst, b, h) do { _Pragma("unroll") for (int m = 0; m < 4; ++m) _Pragma("unroll") for (int k = 0; k < 2; ++k) dst[m][k] = *(const LAS bf16x8*)(lds + PG8_SA(b, h) + aoff + m * 2048 + k * 1024); } while (0)
#define PG8_LDB(dst, b, h) do { _Pragma("unroll") for (int n = 0; n < 2; ++n) _Pragma("unroll") for (int k = 0; k < 2; ++k) dst[n][k] = *(const LAS bf16x8*)(lds + PG8_SB(b, h) + boff + n * 2048 + k * 1024); } while (0)
#define PG8_MMA(ai, bj, At, Bt) do { __builtin_amdgcn_s_setprio(1); _Pragma("unroll") for (int m = 0; m < 4; ++m) _Pragma("unroll") for (int n = 0; n < 2; ++n) _Pragma("unroll") for (int k = 0; k < 2; ++k) \
        acc[ai][bj][m][n] = __builtin_amdgcn_mfma_f32_16x16x32_bf16(Bt[n][k], At[m][k], acc[ai][bj][m][n], 0, 0, 0); __builtin_amdgcn_s_setprio(0); } while (0)
#define PG8_WAIT_V(n) asm volatile("s_waitcnt vmcnt(" #n ")" ::: "memory")
#define PG8_WAIT_L(n) asm volatile("s_waitcnt lgkmcnt(" #n ")" ::: "memory")
#define PG8_BAR __builtin_amdgcn_s_barrier()
#define PG8_SCHED __builtin_amdgcn_sched_barrier(0)
    Unit cur, nxt; int ui = 0;
    if (!S.next(0, cur)) return;
    f32x4 acc[2][2][4][2];
#pragma unroll
    for (int a = 0; a < 2; ++a)
#pragma unroll
        for (int b = 0; b < 2; ++b)
#pragma unroll
            for (int m = 0; m < 4; ++m)
#pragma unroll
                for (int n = 0; n < 2; ++n) acc[a][b][m][n] = (f32x4){0.f, 0.f, 0.f, 0.f};
    bf16x8 At[4][2], B0[2][2], B1[2][2];
    const char* cA = cur.A; const char* cB = cur.B;
    if constexpr (Epi::PREP) E.prep(cur, tid);
    unsigned ga[2][2], na[2][2];
    if constexpr (GATHER) {
#pragma unroll
        for (int h = 0; h < 2; ++h)
#pragma unroll
            for (int i = 0; i < 2; ++i) { ga[h][i] = S.row_off(cur, 128 * h + Rr[i]) + (unsigned)Cc[i] * 2u; na[h][i] = ga[h][i]; }
    }
    PG8_STAGE(PG8_SB(0, 0), cB, voffB); PG8_STAGE(PG8_SB(0, 1), cB + hstep, voffB); PG8_STAGEA(PG8_SA(0, 0), cA, 0, false); PG8_STAGEA(PG8_SA(0, 1), cA, 1, false);
    if (wr == 1) PG8_BAR;
    PG8_WAIT_V(2); PG8_BAR;
    PG8_STAGE(PG8_SB(1, 0), cB + kstep, voffB); PG8_STAGEA(PG8_SA(1, 0), cA + kstep, 0, false); PG8_STAGE(PG8_SB(1, 1), cB + hstep + kstep, voffB);
    PG8_WAIT_V(6); PG8_BAR;
    for (;;) {
        const bool has_next = S.next(ui + 1, nxt);
        if constexpr (Epi::PREP) { if (has_next) E.prep(nxt, tid); }
        const char* nA = has_next ? nxt.A : cA; const char* nB = has_next ? nxt.B : cB;
        if constexpr (GATHER) {
            if (has_next) {
#pragma unroll
                for (int h = 0; h < 2; ++h)
#pragma unroll
                    for (int i = 0; i < 2; ++i) na[h][i] = S.row_off(nxt, 128 * h + Rr[i]) + (unsigned)Cc[i] * 2u;
            }
        }
        const bool do0 = !Sched::RAGGED || cur.rows > 64 * wr, do1 = !Sched::RAGGED || cur.rows > 128 + 64 * wr;
#pragma unroll 1
        for (int t = 0; t < nt; t += 2) {
            const bool last = (t == nt - 2);
            const char* a1 = cA + (size_t)(t + 1) * kstep;
            const char* a2 = last ? nA : cA + (size_t)(t + 2) * kstep; const char* b2 = last ? nB : cB + (size_t)(t + 2) * kstep;
            const char* a3 = a2 + kstep; const char* b3 = b2 + kstep;
            PG8_LDB(B0, 0, 0); PG8_LDB(B1, 0, 1); PG8_SCHED; PG8_LDA(At, 0, 0); PG8_STAGEA(PG8_SA(1, 1), a1, 1, false);
            PG8_WAIT_V(8); PG8_WAIT_L(0); PG8_BAR; if (do0) { PG8_MMA(0, 0, At, B0); PG8_MMA(0, 1, At, B1); } PG8_BAR; PG8_SCHED;
            PG8_LDA(At, 0, 1); PG8_STAGE(PG8_SB(0, 0), b2, voffB); PG8_STAGE(PG8_SB(0, 1), b2 + hstep, voffB); PG8_STAGEA(PG8_SA(0, 0), a2, 0, last);
            PG8_WAIT_V(8); PG8_WAIT_L(0); PG8_BAR; if (do1) { PG8_MMA(1, 0, At, B0); PG8_MMA(1, 1, At, B1); } PG8_BAR; PG8_SCHED;
            PG8_LDB(B0, 1, 0); PG8_LDB(B1, 1, 1); PG8_SCHED; PG8_LDA(At, 1, 0); PG8_STAGEA(PG8_SA(0, 1), a2, 1, last);
            PG8_WAIT_V(8); PG8_WAIT_L(0); PG8_BAR; if (do0) { PG8_MMA(0, 0, At, B0); PG8_MMA(0, 1, At, B1); } PG8_BAR; PG8_SCHED;
            PG8_LDA(At, 1, 1); PG8_STAGE(PG8_SB(1, 0), b3, voffB); PG8_STAGE(PG8_SB(1, 1), b3 + hstep, voffB); PG8_STAGEA(PG8_SA(1, 0), a3, 0, last);
            PG8_WAIT_V(8); PG8_WAIT_L(0); PG8_BAR; if (do1) { PG8_MMA(1, 0, At, B0); PG8_MMA(1, 1, At, B1); } PG8_BAR; PG8_SCHED;
            if constexpr (Epi::MID) { if (t == nt / 2 - 2) E.mid(acc, cur, wr, wc, fr, fq); }
        }
        if (wr == 0) PG8_BAR;
        E(acc, cur, wr, wc, fr, fq);
        if (!has_next) break;
#pragma unroll
        for (int a = 0; a < 2; ++a)
#pragma unroll
            for (int b = 0; b < 2; ++b)
#pragma unroll
                for (int m = 0; m < 4; ++m)
#pragma unroll
                    for (int n = 0; n < 2; ++n) acc[a][b][m][n] = (f32x4){0.f, 0.f, 0.f, 0.f};
        cur = nxt; cA = nA; cB = nB; ++ui;
        if constexpr (GATHER) {
#pragma unroll
            for (int h = 0; h < 2; ++h)
#pragma unroll
                for (int i = 0; i < 2; ++i) ga[h][i] = na[h][i];
        }
        if (wr == 1) PG8_BAR;
    }
    PG8_WAIT_V(0);
    PG8_BAR;
#undef PG8_SA
#undef PG8_SB
#undef PG8_STAGE
#undef PG8_STAGEA
#undef PG8_LDA
#undef PG8_LDB
#undef PG8_MMA
#undef PG8_WAIT_V
#undef PG8_WAIT_L
#undef PG8_BAR
#undef PG8_SCHED
}

struct DenseOrder {
    static constexpr bool RAGGED = false;
    const char* A; const char* Bt; int K, nM, nN, nwg, G, c;
    DI void init(const void* A_, const void* Bt_, int M, int N, int K_, int G_, int c_) { A = (const char*)A_; Bt = (const char*)Bt_; K = K_; nM = M / BM; nN = N / BM; nwg = nM * nN; G = G_; c = c_; }
    DI bool next(int i, Unit& u) const {
        const long L = (long)i * G + c; if (L >= nwg) return false;
        int wgid = (int)L; { const int q = nwg / 8, r = nwg % 8, xcd = wgid % 8, off = wgid / 8; wgid = (xcd < r ? xcd * (q + 1) : r * (q + 1) + (xcd - r) * q) + off; }
        const int nig = 8 * nN, gid = wgid / nig, fm = gid * 8, gsz = (nM - fm) < 8 ? (nM - fm) : 8;
        u.pm = fm + ((wgid % nig) % gsz); u.pn = (wgid % nig) / gsz; u.rows = 256; u.aux = i % 3;
        u.A = A + (size_t)u.pm * 256 * K * 2; u.B = Bt + (size_t)u.pn * 256 * K * 2; return true;
    }
    DI unsigned row_off(const Unit&, int) const { return 0u; }
};
struct EpiStoreBf16 {
    static constexpr bool MID = false, PREP = false;
    bf16_t* O; int ld;
    DI void operator()(const f32x4 (&acc)[2][2][4][2], const Unit& u, int wr, int wc, int fr, int fq) const {
        bf16_t* base = O + (size_t)(u.pm * 256 + wr * 64 + fr) * ld + u.pn * 256 + wc * 32 + 8 * fq;
#pragma unroll
        for (int ai = 0; ai < 2; ++ai)
#pragma unroll
            for (int m = 0; m < 4; ++m) { bf16_t* rowp = base + (size_t)(ai * HALF + m * 16) * ld;
#pragma unroll
                for (int bj = 0; bj < 2; ++bj) { const f32x4 v0 = acc[ai][bj][m][0], v1 = acc[ai][bj][m][1];
                    *(u32x4*)(rowp + bj * HALF) = (u32x4){pk2(v0[0], v0[1]), pk2(v0[2], v0[3]), pk2(v1[0], v1[1]), pk2(v1[2], v1[3])}; } }
    }
};
}

DI void sincos_d(double ang, double& s, double& c) {
    const double r = ang * 0.63661977236758134308; const double q = __builtin_rint(r);
    const double y = (ang - q * 1.57079632679489655800) - q * 6.12323399573676603587e-17;
    const double y2 = y * y;
    double sp = -1.0 / 1307674368000.0; sp = sp * y2 + 1.0 / 6227020800.0; sp = sp * y2 - 1.0 / 39916800.0; sp = sp * y2 + 1.0 / 362880.0; sp = sp * y2 - 1.0 / 5040.0; sp = sp * y2 + 1.0 / 120.0; sp = sp * y2 - 1.0 / 6.0; sp = sp * y2 + 1.0;
    const double sy = y * sp;
    double cp = 1.0 / 87178291200.0; cp = cp * y2 - 1.0 / 479001600.0; cp = cp * y2 + 1.0 / 3628800.0; cp = cp * y2 - 1.0 / 40320.0; cp = cp * y2 + 1.0 / 720.0; cp = cp * y2 - 1.0 / 24.0; cp = cp * y2 + 0.5; const double cy = 1.0 - y2 * cp;
    const int qi = ((int)q) & 3;
    s = (qi == 0) ? sy : (qi == 1) ? cy : (qi == 2) ? -sy : -cy;
    c = (qi == 0) ? cy : (qi == 1) ? -sy : (qi == 2) ? -cy : sy;
}
DI void ssm_tables(const Params& P, int g, int p) {
    float* ABAR = (float*)(P.ws + WS_ABAR); float* ABARL = (float*)(P.ws + WS_ABARL); bf16_t* BCAT = (bf16_t*)(P.ws + WS_BCAT); bf16_t* CCAT = (bf16_t*)(P.ws + WS_CCAT);
    const double dt = (double)expf(P.log_dt[g]);
    const double ar = P.a_re[g * 64 + p], ai = P.a_im[g * 64 + p];
    double sn, cs; sincos_d(dt * ai, sn, cs);
    const double mag = (double)expf((float)(dt * ar));
    const double abr = mag * cs, abi = mag * sn;
    ABAR[g * 128 + p] = (float)abr; ABAR[g * 128 + 64 + p] = (float)abi;
    double snL, csL; sincos_d(128.0 * dt * ai, snL, csL);
    const double magL = (double)expf((float)(128.0 * dt * ar));
    ABARL[g * 128 + p] = (float)(magL * csL); ABARL[g * 128 + 64 + p] = (float)(magL * snL);
    const double xr = abr - 1.0, xi = abi, den = ar * ar + ai * ai;
    const double qr = (xr * ar + xi * ai) / den, qi = (xi * ar - xr * ai) / den;
    for (int c = 0; c < 16; ++c) {
        const double br = P.b_re[(g * 64 + p) * 16 + c], bi = P.b_im[(g * 64 + p) * 16 + c];
        BCAT[(g * 128 + p) * 16 + c] = f2bf((float)(qr * br - qi * bi));
        BCAT[(g * 128 + 64 + p) * 16 + c] = f2bf((float)(qr * bi + qi * br));
        CCAT[(g * 16 + c) * 128 + p] = f2bf(P.c_re[(g * 16 + c) * 64 + p]);
        CCAT[(g * 16 + c) * 128 + 64 + p] = f2bf(-P.c_im[(g * 16 + c) * 64 + p]);
    }
}
DI void ada_item(const Params& P, char* lds, int item) {
    float* red = (float*)lds; const int tid = opaque_tid(), lane = tid & 63, wid = tid >> 6;
    const int n = item * 64 + lane, k0 = wid * 128;
    float a0 = 0.f, a1 = 0.f, a2 = 0.f, a3 = 0.f;
#pragma unroll 1
    for (int kb = k0; kb < k0 + 128; kb += 32) {
        float w[32];
#pragma unroll
        for (int j = 0; j < 32; ++j) w[j] = P.w_ada[(size_t)(kb + j) * 6144 + n];
#pragma unroll
        for (int j = 0; j < 32; ++j) { const int k = kb + j; a0 += siluf_(P.c[k]) * w[j]; a1 += siluf_(P.c[1024 + k]) * w[j]; a2 += siluf_(P.c[2048 + k]) * w[j]; a3 += siluf_(P.c[3072 + k]) * w[j]; }
    }
    red[(wid * 4 + 0) * 64 + lane] = a0; red[(wid * 4 + 1) * 64 + lane] = a1; red[(wid * 4 + 2) * 64 + lane] = a2; red[(wid * 4 + 3) * 64 + lane] = a3;
    __syncthreads();
    if (tid < 256) {
        const int b = tid >> 6, l = tid & 63; float s = 0.f;
#pragma unroll
        for (int w = 0; w < 8; ++w) s += red[(w * 4 + b) * 64 + l];
        ((float*)(P.ws + WS_ADA))[b * 6144 + item * 64 + l] = s + P.b_ada[item * 64 + l];
    }
    asm volatile("s_waitcnt vmcnt(0)" ::: "memory");
    __syncthreads();
    if (tid == 0) {
        __builtin_amdgcn_fence(__ATOMIC_RELEASE, "agent"); asm volatile("s_waitcnt vmcnt(0)" ::: "memory");
        __hip_atomic_fetch_add((unsigned*)(P.ws + WS_ADACNT), 1u, __ATOMIC_RELAXED, __HIP_MEMORY_SCOPE_AGENT);
    }
}
DI void tr_item(const float* __restrict__ W, int K, int N, bf16_t* __restrict__ WT, int item, float* scr, int lane, int mode, int s, bool qscale, const float* ks0 = nullptr, const float* ks1 = nullptr) {
    const int nblk = N >> 6, kb = item / nblk, nb = item % nblk, k0 = 64 * kb, n0 = 64 * nb;
    const float* src = W + (size_t)(k0 + (lane >> 4)) * N + n0 + 4 * (lane & 15);
    f32x4 wv[16];
#pragma unroll
    for (int i = 0; i < 16; ++i) wv[i] = *(const f32x4*)(src + (size_t)(4 * i) * N);
    if (ks0) {
#pragma unroll
        for (int i = 0; i < 16; ++i) { const int k = k0 + 4 * i + (lane >> 4); wv[i] = wv[i] * ((k < 512) ? ks0[k] : ks1[k - 512]); }
    }
#pragma unroll
    for (int i = 0; i < 16; ++i) { float* d = scr + (4 * i + (lane >> 4)) * 65 + 4 * (lane & 15); d[0] = wv[i][0]; d[1] = wv[i][1]; d[2] = wv[i][2]; d[3] = wv[i][3]; }
    LDS_FENCE();
    const int c = lane & 7; const float sc = (qscale && n0 < 512) ? 0.125f : 1.f;
#pragma unroll
    for (int j = 0; j < 8; ++j) {
        const int n = (lane >> 3) + 8 * j; const float* sp = scr + (8 * c) * 65 + n;
        const u32x4 o = (u32x4){pk2(sp[0] * sc, sp[65] * sc), pk2(sp[130] * sc, sp[195] * sc), pk2(sp[260] * sc, sp[325] * sc), pk2(sp[390] * sc, sp[455] * sc)};
        const int nn = n0 + n; const int drow = mode == 0 ? nn : (mode == 1 ? (64 * (nn >> 5) + 32 * s + (nn & 31)) : (mode == 2 ? (256 * (nn >> 7) + 128 * s + (nn & 127)) :
            ((nn & ~255) + 128 * ((nn >> 3) & 1) + 32 * ((nn >> 6) & 3) + 8 * ((nn >> 4) & 3) + (nn & 7))));
        *(u32x4*)(WT + (size_t)drow * K + k0 + 8 * c) = o;
    }
    LDS_FENCE();
}
constexpr int CI_IN = 512, CI_GLU = 64, CI_OUT = 256, CI_R = 64, CI_SG = 64, CI_SU = 64, CI_SD = 64, CI_SMALL = CI_IN + CI_GLU + CI_OUT + CI_R + CI_SG + CI_SU + CI_SD;
DI void conv_item(const Params& P, int r, float* scr, int lane) {
    if (r < CI_IN) { tr_item(P.w_in, 1024, 2048, (bf16_t*)(P.ws + WS_WIN), r, scr, lane, 0, 0, true); return; } r -= CI_IN;
    if (r < CI_GLU) { tr_item(P.w_glu, 512, 512, (bf16_t*)(P.ws + WS_WGLU), r, scr, lane, 0, 0, false); return; } r -= CI_GLU;
    if (r < CI_OUT) { tr_item(P.w_out, 1024, 1024, (bf16_t*)(P.ws + WS_WOUT), r, scr, lane, 0, 0, false, P.g_att, P.g_ssm); return; } r -= CI_OUT;
    if (r < CI_R) { tr_item(P.w_router, 1024, 256, (bf16_t*)(P.ws + WS_WR), r, scr, lane, 0, 0, false); return; } r -= CI_R;
    if (r < CI_SG) { tr_item(P.w_s_gate, 1024, 256, (bf16_t*)(P.ws + WS_WSGU), r, scr, lane, 2, 0, false); return; } r -= CI_SG;
    if (r < CI_SU) { tr_item(P.w_s_up, 1024, 256, (bf16_t*)(P.ws + WS_WSGU), r, scr, lane, 2, 1, false); return; } r -= CI_SU;
    if (r < CI_SD) tr_item(P.w_s_down, 256, 1024, (bf16_t*)(P.ws + WS_WSD), r, scr, lane, 0, 0, false);
}
DI void p0_prologue(const Params& P, char* lds) {
    const int tid = opaque_tid(), lane = tid & 63, wid = tid >> 6, G = gridDim.x;
    { const int gt = blockIdx.x * NTHR + tid; if (gt < 2048) ssm_tables(P, gt >> 6, gt & 63); }
    for (int item = blockIdx.x; item < 96; item += G) ada_item(P, lds, item);
    float* scr = (float*)(lds + wid * 16640);
    const int gw = blockIdx.x * 8 + wid, NGW = G * 8;
    if (blockIdx.x >= 96 || G <= 96) { const int w0 = (G > 96) ? gw - 96 * 8 : gw, nw = (G > 96) ? (G - 96) * 8 : NGW; for (int it = w0; it < CI_SMALL; it += nw) conv_item(P, it, scr, lane); }
    if (tid == 0) {
        unsigned* ctr = (unsigned*)(P.ws + WS_ADACNT); unsigned sp = 0;
        while (__hip_atomic_load(ctr, __ATOMIC_RELAXED, __HIP_MEMORY_SCOPE_AGENT) < 96u) { __builtin_amdgcn_s_sleep(2); if (++sp > (1u << 22)) break; }
        __builtin_amdgcn_fence(__ATOMIC_ACQUIRE, "agent"); asm volatile("s_waitcnt vmcnt(0)" ::: "memory");
    }
    __syncthreads();
    {
        const float* ADA = (const float*)(P.ws + WS_ADA); bf16_t* H1 = (bf16_t*)(P.ws + WS_H1);
        for (int row = gw; row < T; row += NGW) {
            const float* xr = P.x + (size_t)row * 1024 + 4 * lane; const float* ad = ADA + (row >> 13) * 6144 + 4 * lane;
#pragma unroll
            for (int j = 0; j < 4; ++j) {
                const f32x4 xv = *(const f32x4*)(xr + 256 * j), sc = *(const f32x4*)(ad + 1024 + 256 * j), sh = *(const f32x4*)(ad + 256 * j);
                const f32x4 hv = xv * (1.f + sc) + sh;
                *(u32x2*)(H1 + (size_t)row * 1024 + 4 * lane + 256 * j) = (u32x2){pk2(hv[0], hv[1]), pk2(hv[2], hv[3])};
            }
        }
    }
}

DI void p1_inproj(const Params& P, char* lds) {
    pg8::DenseOrder S; S.init(P.ws + WS_H1, P.ws + WS_WIN, T, NPROJ, 1024, gridDim.x, blockIdx.x);
    pg8::EpiStoreBf16 E{(bf16_t*)(P.ws + WS_QKVU), NPROJ};
    pg8::gemm_phase<pg8::EpiStoreBf16, pg8::DenseOrder, false>((LAS unsigned char*)lds, 1024, S, E);
}

constexpr int CONV_NT = 3 * 256 * 16, CONV_TP = 257, FILL_TILES_PER_WG = 8;
struct ConvTile { const float* src; bf16_t* WT; int pitch, K, k0, n0, mode, s; };
DI ConvTile conv_tile(const Params& P, int t) {
    const int kind = t / 4096, e = (t % 4096) >> 4, sub = t & 15;
    if (kind < 2) return ConvTile{(kind ? P.w_e_up : P.w_e_gate) + (size_t)e * 262144 + (size_t)(64 * sub) * 256, (bf16_t*)(P.ws + WS_WEGU) + (size_t)e * 524288, 256, 1024, 64 * sub, 0, 2, kind};
    return ConvTile{P.w_e_down + (size_t)e * 262144 + (size_t)(64 * (sub >> 2)) * 1024 + 256 * (sub & 3), (bf16_t*)(P.ws + WS_WED) + (size_t)e * 262144, 1024, 256, 64 * (sub >> 2), 256 * (sub & 3), 3, 0};
}
DI void conv_tile_load(const ConvTile& d, int wid, int lane, f32x4 (&w)[8]) {
#pragma unroll
    for (int i = 0; i < 8; ++i) w[i] = __builtin_nontemporal_load((const f32x4*)(d.src + (size_t)(8 * wid + i) * d.pitch + 4 * lane));
}
DI void conv_experts_block(const Params& P, char* lds, int t, const int NT, const int stride) {
    const int tid = opaque_tid(), lane = tid & 63, wid = tid >> 6;
    if (t >= NT) return;
    float* buf0 = (float*)lds; float* buf1 = buf0 + 64 * CONV_TP;
    ConvTile d = conv_tile(P, t); f32x4 w[8]; conv_tile_load(d, wid, lane, w);
    int par = 0;
    for (;;) {
        float* buf = par ? buf1 : buf0;
#pragma unroll
        for (int i = 0; i < 8; ++i) { float* p = buf + (8 * wid + i) * CONV_TP + 4 * lane; p[0] = w[i][0]; p[1] = w[i][1]; p[2] = w[i][2]; p[3] = w[i][3]; }
        const int tn = t + stride; const ConvTile dn = conv_tile(P, tn < NT ? tn : t);
        conv_tile_load(dn, wid, lane, w);
        __syncthreads();
        const int c = lane & 7;
#pragma unroll
        for (int it = 0; it < 4; ++it) {
            const int n = 8 * wid + (lane >> 3) + 64 * it; const float* sp = buf + (8 * c) * CONV_TP + n;
            const u32x4 o = (u32x4){pk2(sp[0], sp[CONV_TP]), pk2(sp[2 * CONV_TP], sp[3 * CONV_TP]), pk2(sp[4 * CONV_TP], sp[5 * CONV_TP]), pk2(sp[6 * CONV_TP], sp[7 * CONV_TP])};
            const int nn = d.n0 + n; const int drow = d.mode == 2 ? (256 * (nn >> 7) + 128 * d.s + (nn & 127)) : ((nn & ~255) + 128 * ((nn >> 3) & 1) + 32 * ((nn >> 6) & 3) + 8 * ((nn >> 4) & 3) + (nn & 7));
            *(u32x4*)(d.WT + (size_t)drow * d.K + d.k0 + 8 * c) = o;
        }
        t = tn; if (t >= NT) break;
        d = dn; par ^= 1;
    }
    __syncthreads();
}
DI int fill_blocks() { const int G = gridDim.x, rounds = (384 + G - 1) / G; return rounds * G - 384; }
DI void p1_inproj_and_experts(const Params& P, char* lds) {
    const bool conv_first = ((blockIdx.x >> 3) & 1) == 0;
    const int nb = fill_blocks(), fill = (nb > 0 && nb < (int)gridDim.x) ? nb * FILL_TILES_PER_WG : 0;
    if (conv_first) conv_experts_block(P, lds, blockIdx.x, CONV_NT - fill, gridDim.x);
    p1_inproj(P, lds);
    if (!conv_first) conv_experts_block(P, lds, blockIdx.x, CONV_NT - fill, gridDim.x);
}

DI int t5_bucket(int dist) {
    if (dist < 16) return dist;
    const float v = logf((float)dist / 16.0f) / 4.852030263919617f * 16.0f;
    int l = 16 + (int)v; return l < 31 ? l : 31;
}
struct VFrag { u32x2 r[8]; };
DI VFrag v_tr_read(unsigned addr) {
    VFrag f;
    asm volatile("ds_read_b64_tr_b16 %0, %8\n\tds_read_b64_tr_b16 %1, %8 offset:1152\n\tds_read_b64_tr_b16 %2, %8 offset:64\n\tds_read_b64_tr_b16 %3, %8 offset:1216\n\t"
                 "ds_read_b64_tr_b16 %4, %8 offset:2304\n\tds_read_b64_tr_b16 %5, %8 offset:3456\n\tds_read_b64_tr_b16 %6, %8 offset:2368\n\tds_read_b64_tr_b16 %7, %8 offset:3520\n\ts_waitcnt lgkmcnt(0)"
                 : "=&v"(f.r[0]), "=&v"(f.r[1]), "=&v"(f.r[2]), "=&v"(f.r[3]), "=&v"(f.r[4]), "=&v"(f.r[5]), "=&v"(f.r[6]), "=&v"(f.r[7]) : "v"(addr) : "memory");
    return f;
}
DI void attn_task_params(int task, int wid, int& d, int& r, int& lqb, int& p) {
    p = task >> 1; const int tk = wid + 8 * (task & 1);
    if (p == 0) { d = 1; r = 0; lqb = 32 * tk; } else if (p == 1) { d = 4; r = tk >> 2; lqb = 32 * (tk & 3); } else { d = 16; r = tk; lqb = 0; }
}
struct ATask { int d, r, lqb, p, cb, ce; };
DI ATask attn_task(int task, int wid, int t0) {
    ATask a; attn_task_params(task, wid, a.d, a.r, a.lqb, a.p);
    a.ce = a.p > 0 ? 4 : 5;
    const int base = t0 + a.r + a.d * (a.lqb - 97);
    const int cb = base >= 0 ? 0 : ((-base + 32 * a.d - 1) >> (5 + 2 * a.p));
    a.cb = cb < a.ce ? cb : a.ce;
    return a;
}
DI void attn_unit(const Params& P, char* lds, int unit) {
    int tid = threadIdx.x; asm volatile("" : "+v"(tid));
    const int lane = tid & 63, wid = __builtin_amdgcn_readfirstlane(tid >> 6), c = lane & 31, hh = lane >> 5;
    const int b = unit >> 7, qb = (unit >> 3) & 15, h = unit & 7, t0 = qb * 512;
    char* st = lds;
    float* bt = (float*)(lds + 512 * 136);
    bf16_t* ksw = (bf16_t*)(bt + 3 * 192) + wid * (64 * LDP);
    bf16_t* vsw = ksw + 32 * LDP;
    const unsigned vtr = (unsigned)(size_t)vsw + (unsigned)(((4 * hh + ((lane & 15) >> 2)) * LDP + 16 * ((lane >> 4) & 1) + 4 * (lane & 3)) * 2);
    const bf16_t* qkv = (const bf16_t*)(P.ws + WS_QKVU) + (size_t)(b * SEQ) * NPROJ;
    constexpr float LOG2E = 1.4426950408889634f;
    for (int i = tid; i < 3 * 192; i += NTHR) {
        const int p = i / 192, j = i % 192 - 32; const int dist = (j < 0 ? 0 : j) << (2 * p); float v = NEG;
        if (j >= (p ? 33 : 0) && j <= 128) {
            const int mult = (p == 0) ? 1 + ((j & 3) == 0) + ((j & 15) == 0) : (p == 1 ? 1 + ((j & 3) == 0) : 1);
            v = P.rel_bias[t5_bucket(dist) * 8 + h] * LOG2E + (mult == 1 ? 0.f : (mult == 2 ? 1.f : 1.5849625007211562f));
        }
        bt[i] = v;
    }
    __syncthreads();
    bf16x8 kfN[4], vvN[4], qfN[4];
    auto issue_kv = [&](const ATask& a, int ch) __attribute__((always_inline)) {
        const int tkv = t0 + a.r + a.d * (a.lqb - 128 + 32 * ch) + ((lane >> 3) << (2 * a.p));
#pragma unroll
        for (int i = 0; i < 4; ++i) {
            int tk = tkv + 8 * i * a.d; tk = tk < 0 ? 0 : tk;
            const bf16_t* rp = qkv + (size_t)(unsigned)tk * NPROJ + 512 + h * 64 + 8 * (lane & 7);
            kfN[i] = *(const bf16x8*)rp; vvN[i] = *(const bf16x8*)(rp + 512);
        }
    };
    auto issue_q = [&](const ATask& a) __attribute__((always_inline)) {
        const bf16_t* qrow = qkv + (size_t)(unsigned)(t0 + a.d * (a.lqb + c) + a.r) * NPROJ + h * 64 + 8 * hh;
#pragma unroll
        for (int s = 0; s < 4; ++s) qfN[s] = *(const bf16x8*)(qrow + 16 * s);
    };
    { const ATask a0 = attn_task(0, wid, t0); issue_q(a0); issue_kv(a0, a0.cb); }
#pragma unroll 1
    for (int task = 0; task < 6; ++task) {
        const ATask cur = attn_task(task, wid, t0);
        if (cur.cb < cur.ce) {
            ATask nxt = cur;
#pragma unroll 1
            for (int t2 = task + 1; t2 < 6; ++t2) { const ATask c2 = attn_task(t2, wid, t0); if (c2.cb < c2.ce) { nxt = c2; break; } }
            const int d = cur.d, r = cur.r, lqb = cur.lqb, p = cur.p;
            int qidx = d * (lqb + c) + r; qidx ^= (qidx >> 5) & 15;
            bf16x8 qf[4];
#pragma unroll
            for (int s = 0; s < 4; ++s) qf[s] = qfN[s];
            issue_q(nxt);
            float m = NEG, l = 0.f; f32x16 o0, o1;
#pragma unroll
            for (int i = 0; i < 16; ++i) { o0[i] = 0.f; o1[i] = 0.f; }
            if (p > 0) {
                const char* sp = st + qidx * 136; const f32x2 ml = *(const f32x2*)(sp + 128); m = ml[0]; l = hh ? 0.f : ml[1];
#pragma unroll
                for (int g = 0; g < 4; ++g) { const u32x2 a = *(const u32x2*)(sp + (8 * g + 4 * hh) * 2), bb = *(const u32x2*)(sp + (32 + 8 * g + 4 * hh) * 2);
                    o0[4 * g] = bflo(a[0]); o0[4 * g + 1] = bfhi(a[0]); o0[4 * g + 2] = bflo(a[1]); o0[4 * g + 3] = bfhi(a[1]); o1[4 * g] = bflo(bb[0]); o1[4 * g + 1] = bfhi(bb[0]); o1[4 * g + 2] = bflo(bb[1]); o1[4 * g + 3] = bfhi(bb[1]); }
            }
#pragma unroll 1
            for (int ch = cur.cb; ch < cur.ce; ++ch) {
                const float* btp = bt + p * 192 + 32 + c + 128 - 32 * ch - 4 * hh;
                LDS_FENCE();
#pragma unroll
                for (int i = 0; i < 4; ++i) { *(bf16x8*)(ksw + (8 * i + (lane >> 3)) * LDP + 8 * (lane & 7)) = kfN[i]; *(bf16x8*)(vsw + (8 * i + (lane >> 3)) * LDP + 8 * (lane & 7)) = vvN[i]; }
                { const bool last = ch + 1 == cur.ce; ATask a = cur; int chn = ch + 1; if (last) { a = nxt; chn = nxt.cb; } issue_kv(a, chn); }
                LDS_FENCE();
                const int lk0 = lqb - 128 + 32 * ch;
                bf16x8 kf[4];
#pragma unroll
                for (int s = 0; s < 4; ++s) kf[s] = *(const bf16x8*)(ksw + c * LDP + 16 * s + 8 * hh);
                f32x16 sa;
#pragma unroll
                for (int i = 0; i < 16; ++i) sa[i] = 0.f;
#pragma unroll
                for (int s = 0; s < 4; ++s) sa = MFMA32(kf[s], qf[s], sa);
                float sc[16]; float mx = NEG;
#pragma unroll
                for (int i = 0; i < 16; ++i) sc[i] = btp[-((i & 3) + 8 * (i >> 2))];
                asm volatile("" : "+v"(sc[0]), "+v"(sc[1]), "+v"(sc[2]), "+v"(sc[3]), "+v"(sc[4]), "+v"(sc[5]), "+v"(sc[6]), "+v"(sc[7]), "+v"(sc[8]), "+v"(sc[9]), "+v"(sc[10]), "+v"(sc[11]), "+v"(sc[12]), "+v"(sc[13]), "+v"(sc[14]), "+v"(sc[15]));
                if (t0 + d * lk0 + r >= 0) {
#pragma unroll
                    for (int i = 0; i < 16; ++i) { const float v = fmaf(sa[i], LOG2E, sc[i]); sc[i] = v; mx = fmaxf(mx, v); }
                } else {
#pragma unroll
                    for (int i = 0; i < 16; ++i) {
                        const int kr = (i & 3) + 8 * (i >> 2) + 4 * hh;
                        const float v = (t0 + d * (lk0 + kr) + r >= 0) ? fmaf(sa[i], LOG2E, sc[i]) : NEG; sc[i] = v; mx = fmaxf(mx, v);
                    }
                }
                mx = xmax32(mx);
                if (!__all(mx - m <= 8.f)) {
                    const float mn = fmaxf(m, mx), alpha = __builtin_amdgcn_exp2f(m - mn); m = mn; l *= alpha;
#pragma unroll
                    for (int i = 0; i < 16; ++i) { o0[i] *= alpha; o1[i] *= alpha; }
                }
                float ps = 0.f;
#pragma unroll
                for (int i = 0; i < 16; ++i) { sc[i] = __builtin_amdgcn_exp2f(sc[i] - m); ps += sc[i]; }
                l += ps;
                const VFrag vf = v_tr_read(vtr);
#pragma unroll
                for (int s = 0; s < 2; ++s) {
                    const u32x4 pw = (u32x4){pk2(sc[8 * s], sc[8 * s + 1]), pk2(sc[8 * s + 2], sc[8 * s + 3]), pk2(sc[8 * s + 4], sc[8 * s + 5]), pk2(sc[8 * s + 6], sc[8 * s + 7])};
                    const bf16x8 pf = __builtin_bit_cast(bf16x8, pw);
                    const u32x4 v0 = (u32x4){vf.r[4 * s][0], vf.r[4 * s][1], vf.r[4 * s + 1][0], vf.r[4 * s + 1][1]}, v1 = (u32x4){vf.r[4 * s + 2][0], vf.r[4 * s + 2][1], vf.r[4 * s + 3][0], vf.r[4 * s + 3][1]};
                    o0 = MFMA32(__builtin_bit_cast(bf16x8, v0), pf, o0); o1 = MFMA32(__builtin_bit_cast(bf16x8, v1), pf, o1);
                }
            }
            l = xsum32(l);
            char* sp = st + qidx * 136;
            if (hh == 0) *(f32x2*)(sp + 128) = (f32x2){m, l};
#pragma unroll
            for (int g = 0; g < 4; ++g) { *(u32x2*)(sp + (8 * g + 4 * hh) * 2) = (u32x2){pk2(o0[4 * g], o0[4 * g + 1]), pk2(o0[4 * g + 2], o0[4 * g + 3])}; *(u32x2*)(sp + (32 + 8 * g + 4 * hh) * 2) = (u32x2){pk2(o1[4 * g], o1[4 * g + 1]), pk2(o1[4 * g + 2], o1[4 * g + 3])}; }
        }
        if (task & 1) __syncthreads();
    }
    {
        const char* sp = st + (tid ^ ((tid >> 5) & 15)) * 136; const float inv = 1.f / *(const float*)(sp + 132);
        bf16_t* op = (bf16_t*)(P.ws + WS_MERGED) + (size_t)(b * SEQ + t0 + tid) * 1024 + h * 64; float ss = 0.f;
#pragma unroll
        for (int i = 0; i < 8; ++i) { const u32x2 wa = *(const u32x2*)(sp + 16 * i), wb = *(const u32x2*)(sp + 16 * i + 8); const unsigned w[4] = {wa[0], wa[1], wb[0], wb[1]}; float v[8];
#pragma unroll
            for (int j = 0; j < 4; ++j) { v[2 * j] = bflo(w[j]) * inv; v[2 * j + 1] = bfhi(w[j]) * inv; ss += v[2 * j] * v[2 * j] + v[2 * j + 1] * v[2 * j + 1]; }
            *(u32x4*)(op + 8 * i) = (u32x4){pk2(v[0], v[1]), pk2(v[2], v[3]), pk2(v[4], v[5]), pk2(v[6], v[7])}; }
        ((float*)(P.ws + WS_ATTSQ))[(size_t)(b * SEQ + t0 + tid) * 8 + h] = ss;
    }
    __syncthreads();
}

DI u32x2 tr_read1(unsigned addr) { u32x2 r; asm volatile("ds_read_b64_tr_b16 %0, %1\n\ts_waitcnt lgkmcnt(0)" : "=&v"(r) : "v"(addr) : "memory"); return r; }
struct STr16 { u32x2 r[16]; };
DI STr16 s_tr_read(unsigned addr) {
    STr16 f;
    asm volatile("ds_read_b64_tr_b16 %0, %16\n\tds_read_b64_tr_b16 %1, %16 offset:576\n\tds_read_b64_tr_b16 %2, %16 offset:4608\n\tds_read_b64_tr_b16 %3, %16 offset:5184\n\t"
                 "ds_read_b64_tr_b16 %4, %16 offset:9216\n\tds_read_b64_tr_b16 %5, %16 offset:9792\n\tds_read_b64_tr_b16 %6, %16 offset:13824\n\tds_read_b64_tr_b16 %7, %16 offset:14400\n\t"
                 "ds_read_b64_tr_b16 %8, %16 offset:32\n\tds_read_b64_tr_b16 %9, %16 offset:608\n\tds_read_b64_tr_b16 %10, %16 offset:4640\n\tds_read_b64_tr_b16 %11, %16 offset:5216\n\t"
                 "ds_read_b64_tr_b16 %12, %16 offset:9248\n\tds_read_b64_tr_b16 %13, %16 offset:9824\n\tds_read_b64_tr_b16 %14, %16 offset:13856\n\tds_read_b64_tr_b16 %15, %16 offset:14432\n\ts_waitcnt lgkmcnt(0)"
                 : "=&v"(f.r[0]), "=&v"(f.r[1]), "=&v"(f.r[2]), "=&v"(f.r[3]), "=&v"(f.r[4]), "=&v"(f.r[5]), "=&v"(f.r[6]), "=&v"(f.r[7]),
                   "=&v"(f.r[8]), "=&v"(f.r[9]), "=&v"(f.r[10]), "=&v"(f.r[11]), "=&v"(f.r[12]), "=&v"(f.r[13]), "=&v"(f.r[14]), "=&v"(f.r[15]) : "v"(addr) : "memory");
    return f;
}
template <bool FINAL>
DI void ssm_task(const Params& P, float* buf, int b, int k, int g, int lane, float s_re, float s_im) {
    const int c32 = lane & 31, hh = lane >> 5, fr = lane & 15, fq = lane >> 4;
    const float* ABAR = (const float*)(P.ws + WS_ABAR);
    const float a_re = ABAR[g * 128 + lane], a_im = ABAR[g * 128 + 64 + lane];
    bf16x8 bq[4];
#pragma unroll
    for (int tau = 0; tau < 4; ++tau) bq[tau] = *(const bf16x8*)((const bf16_t*)(P.ws + WS_BCAT) + (size_t)(g * 128 + 32 * tau + c32) * 16 + 8 * hh);
    bf16x8 cq[4]; f32x4 dsk = (f32x4){0.f, 0.f, 0.f, 0.f};
    if (FINAL) {
#pragma unroll
        for (int s = 0; s < 4; ++s) cq[s] = *(const bf16x8*)((const bf16_t*)(P.ws + WS_CCAT) + (size_t)(g * 16 + fr) * 128 + 32 * s + 8 * fq);
        dsk = *(const f32x4*)(P.ssm_d + g * 16 + 4 * fq);
    }
    const bf16_t* ubase = (const bf16_t*)(P.ws + WS_QKVU) + (size_t)(b * SEQ + k * 128) * NPROJ + 1536 + 16 * g;
    bf16x8 ufa[4]; u32x2 uwa[4][2];
#pragma unroll
    for (int sub = 0; sub < 4; ++sub) {
        ufa[sub] = *(const bf16x8*)(ubase + (size_t)(32 * sub + c32) * NPROJ + 8 * hh);
        if (FINAL) { uwa[sub][0] = *(const u32x2*)(ubase + (size_t)(32 * sub + fr) * NPROJ + 4 * fq); uwa[sub][1] = *(const u32x2*)(ubase + (size_t)(32 * sub + 16 + fr) * NPROJ + 4 * fq); }
    }
    const unsigned str = (unsigned)(size_t)buf + (unsigned)((8 * fq + ((lane & 15) >> 2)) * (SSM_PITCH * 4) + (lane & 3) * 8);
#pragma unroll
    for (int sub = 0; sub < 4; ++sub) {
        const bf16x8 uf = ufa[sub];
        LDS_FENCE();
#pragma unroll
        for (int tau = 0; tau < 4; ++tau) {
            f32x16 z;
#pragma unroll
            for (int i = 0; i < 16; ++i) z[i] = 0.f;
            z = MFMA32(uf, bq[tau], z);
#pragma unroll
            for (int gq = 0; gq < 4; ++gq) *(f32x4*)(buf + (32 * tau + c32) * SSM_PITCH + 8 * gq + 4 * hh) = (f32x4){z[4 * gq], z[4 * gq + 1], z[4 * gq + 2], z[4 * gq + 3]};
        }
        LDS_FENCE();
        float* rre = buf + lane * SSM_PITCH; float* rim = buf + (64 + lane) * SSM_PITCH;
#pragma unroll
        for (int tq = 0; tq < 8; ++tq) {
            const f32x4 re4 = *(const f32x4*)(rre + 4 * tq), im4 = *(const f32x4*)(rim + 4 * tq); float sr[4], si[4];
#pragma unroll
            for (int j = 0; j < 4; ++j) { const float nr = fmaf(a_re, s_re, fmaf(-a_im, s_im, re4[j])), ni = fmaf(a_re, s_im, fmaf(a_im, s_re, im4[j])); s_re = nr; s_im = ni; sr[j] = nr; si[j] = ni; }
            if (FINAL) { *(u32x2*)((bf16_t*)rre + 4 * tq) = (u32x2){pk2(sr[0], sr[1]), pk2(sr[2], sr[3])}; *(u32x2*)((bf16_t*)rim + 4 * tq) = (u32x2){pk2(si[0], si[1]), pk2(si[2], si[3])}; }
        }
        if (FINAL) {
            LDS_FENCE();
            const STr16 sf = s_tr_read(str);
#pragma unroll
            for (int tt = 0; tt < 2; ++tt) {
                f32x4 y = (f32x4){0.f, 0.f, 0.f, 0.f};
#pragma unroll
                for (int s = 0; s < 4; ++s) { const u32x4 w = (u32x4){sf.r[8 * tt + 2 * s][0], sf.r[8 * tt + 2 * s][1], sf.r[8 * tt + 2 * s + 1][0], sf.r[8 * tt + 2 * s + 1][1]}; y = MFMA16(cq[s], __builtin_bit_cast(bf16x8, w), y); }
                const int tl = 32 * sub + 16 * tt + fr;
                const u32x2 uw = uwa[sub][tt];
                const float v0 = gelu_tanh(y[0] + dsk[0] * bflo(uw[0])), v1 = gelu_tanh(y[1] + dsk[1] * bfhi(uw[0])), v2 = gelu_tanh(y[2] + dsk[2] * bflo(uw[1])), v3 = gelu_tanh(y[3] + dsk[3] * bfhi(uw[1]));
                *(u32x2*)((bf16_t*)(P.ws + WS_YGL) + (size_t)(b * SEQ + k * 128 + tl) * 512 + 16 * g + 4 * fq) = (u32x2){pk2(v0, v1), pk2(v2, v3)};
            }
        }
    }
    if (!FINAL) { float* E = (float*)(P.ws + WS_E) + (size_t)((b * 64 + k) * 32 + g) * 128; E[lane] = s_re; E[64 + lane] = s_im; }
    LDS_FENCE();
}

DI void p2_mixer(const Params& P, char* lds) {
    const int tid = opaque_tid(), lane = tid & 63, wid = tid >> 6, G = gridDim.x;
    for (int item = blockIdx.x; item < 1536; item += G) {
        if (item < 512) attn_unit(P, lds, item < 256 ? item : (item ^ (15 << 3)));
        else { const int wt = (item - 512) * 8 + wid; ssm_task<false>(P, (float*)(lds + wid * SSM_WAVE_LDS), wt >> 11, (wt >> 5) & 63, wt & 31, lane, 0.f, 0.f); __syncthreads(); }
    }
}

DI void route_token(const float* srow, const float* rbias, int lane, int& e_out, float& g_out) {
    const f32x4 s4 = *(const f32x4*)(srow + 4 * lane); const f32x4 rb = *(const f32x4*)(rbias + 4 * lane);
    float w0 = s4[0] + rb[0], w1 = s4[1] + rb[1], w2 = s4[2] + rb[2], w3 = s4[3] + rb[3];
    float m1, m2;
    { const float a = fmaxf(w0, w1), bb = fminf(w0, w1), cc = fmaxf(w2, w3), dd = fminf(w2, w3); m1 = fmaxf(a, cc); m2 = fmaxf(fminf(a, cc), fmaxf(bb, dd)); }
#define ROUTE_MERGE2(CTRL) { const float o1 = dppf<CTRL>(m1), o2 = dppf<CTRL>(m2); const float n1 = fmaxf(m1, o1), n2 = fmaxf(fminf(m1, o1), fmaxf(m2, o2)); m1 = n1; m2 = n2; }
    ROUTE_MERGE2(DPP_X1) ROUTE_MERGE2(DPP_X2) ROUTE_MERGE2(DPP_HM)
#undef ROUTE_MERGE2
    const float gs = m1 + m2; const int mygrp = lane >> 3; int rank = 0;
#pragma unroll
    for (int j = 0; j < 8; ++j) { const float gj = rdlane(gs, 8 * j); rank += ((gj > gs) || (gj == gs && j < mygrp)) ? 1 : 0; }
    const float NINF = -__builtin_inff();
    if (rank >= 4) { w0 = NINF; w1 = NINF; w2 = NINF; w3 = NINF; }
    int my_e = 0; float my_s = 0.f;
#pragma unroll 1
    for (int k = 0; k < TOPK; ++k) {
        float bv = w0; int bi = 0;
        if (w1 > bv) { bv = w1; bi = 1; } if (w2 > bv) { bv = w2; bi = 2; } if (w3 > bv) { bv = w3; bi = 3; }
        float rm = bv; rm = fmaxf(rm, dppf<DPP_X1>(rm)); rm = fmaxf(rm, dppf<DPP_X2>(rm)); rm = fmaxf(rm, dppf<DPP_HM>(rm)); rm = fmaxf(rm, dppf<DPP_RM>(rm));
        const float wmax = fmaxf(fmaxf(rdlane(rm, 0), rdlane(rm, 16)), fmaxf(rdlane(rm, 32), rdlane(rm, 48)));
        const unsigned long long bal = __ballot(bv == wmax);
        const int owner = __builtin_amdgcn_readfirstlane((int)__ffsll((long long)bal) - 1);
        const int sub = __builtin_amdgcn_readlane(bi, owner), idx = 4 * owner + sub;
        const float mys = bi == 0 ? s4[0] : (bi == 1 ? s4[1] : (bi == 2 ? s4[2] : s4[3]));
        const float sval = rdlane(mys, owner);
        if (lane == owner) { if (sub == 0) w0 = NINF; else if (sub == 1) w1 = NINF; else if (sub == 2) w2 = NINF; else w3 = NINF; }
        if (lane == k) { my_e = idx; my_s = sval; }
    }
    float sum = (lane < 8) ? my_s : 0.f;
    sum += dppf<DPP_X1>(sum); sum += dppf<DPP_X2>(sum); sum += dppf<DPP_HM>(sum);
    e_out = my_e; g_out = my_s / sum * 2.5f;
}

DI void p3a_ssm(const Params& P, char* lds) {
    const int tid = opaque_tid(), lane = tid & 63, wid = tid >> 6;
    float* buf = (float*)(lds + wid * SSM_WAVE_LDS);
    const float* ABARL = (const float*)(P.ws + WS_ABARL); const float* E = (const float*)(P.ws + WS_E);
    for (int wt = blockIdx.x * 8 + wid; wt < 8192; wt += gridDim.x * 8) {
        const int g = wt & 31, kk = (wt >> 5) & 63, b = wt >> 11, k = (b & 1) ? 63 - kk : kk;
        const float lr = ABARL[g * 128 + lane], li = ABARL[g * 128 + 64 + lane];
        float cr = 0.f, ci = 0.f; float er[8], ei[8], fr[8], fi[8];
        const float* eb = E + (size_t)(b * 64 * 32 + g) * 128 + lane;
#define SSM_CARRY_LOAD(R, I, K0) { _Pragma("unroll") for (int j = 0; j < 8; ++j) { const int kj = (K0) + j; const float* ep = eb + (size_t)(kj < 63 ? kj : 63) * (32 * 128); R[j] = ep[0]; I[j] = ep[64]; } }
#define SSM_CARRY_STEP(R, I, K0) { _Pragma("unroll") for (int j = 0; j < 8; ++j) { const bool ok = (K0) + j < k; const float nr = fmaf(lr, cr, fmaf(-li, ci, R[j])), ni = fmaf(lr, ci, fmaf(li, cr, I[j])); cr = ok ? nr : cr; ci = ok ? ni : ci; } }
        SSM_CARRY_LOAD(er, ei, 0)
#pragma unroll 1
        for (int k0 = 0; k0 < k; k0 += 16) {
            SSM_CARRY_LOAD(fr, fi, k0 + 8)
            SSM_CARRY_STEP(er, ei, k0)
            SSM_CARRY_LOAD(er, ei, k0 + 16)
            SSM_CARRY_STEP(fr, fi, k0 + 8)
        }
#undef SSM_CARRY_LOAD
#undef SSM_CARRY_STEP
        ssm_task<true>(P, buf, b, k, g, lane, cr, ci);
    }
}
struct EpiGluE {
    static constexpr bool MID = false, PREP = false;
    const bf16_t* ygl; bf16_t* merged; const float* bglu; float* ssq;
    DI void operator()(const f32x4 (&acc)[2][2][4][2], const pg8::Unit& u, int wr, int wc, int fr, int fq) const {
        f32x4 bv[2][2];
#pragma unroll
        for (int bj = 0; bj < 2; ++bj)
#pragma unroll
            for (int n = 0; n < 2; ++n) bv[bj][n] = *(const f32x4*)(bglu + 256 * u.pn + 128 * bj + 32 * wc + 8 * fq + 4 * n);
#pragma unroll
        for (int ai = 0; ai < 2; ++ai)
#pragma unroll
            for (int m = 0; m < 4; ++m) {
                const size_t row = (size_t)256 * u.pm + 128 * ai + 64 * wr + 16 * m + fr; float ss = 0.f;
#pragma unroll
                for (int bj = 0; bj < 2; ++bj) {
                    const int col = 256 * u.pn + 128 * bj + 32 * wc + 8 * fq; const u32x4 yw = *(const u32x4*)(ygl + row * 512 + col);
                    const f32x4 z0 = acc[ai][bj][m][0] + bv[bj][0], z1 = acc[ai][bj][m][1] + bv[bj][1];
                    const float o0 = bflo(yw[0]) * sigmoidf_(z0[0]), o1 = bfhi(yw[0]) * sigmoidf_(z0[1]), o2 = bflo(yw[1]) * sigmoidf_(z0[2]), o3 = bfhi(yw[1]) * sigmoidf_(z0[3]);
                    const float o4 = bflo(yw[2]) * sigmoidf_(z1[0]), o5 = bfhi(yw[2]) * sigmoidf_(z1[1]), o6 = bflo(yw[3]) * sigmoidf_(z1[2]), o7 = bfhi(yw[3]) * sigmoidf_(z1[3]);
                    ss += (o0 * o0 + o1 * o1) + (o2 * o2 + o3 * o3) + (o4 * o4 + o5 * o5) + (o6 * o6 + o7 * o7);
                    *(u32x4*)(merged + row * 1024 + 512 + col) = (u32x4){pk2(o0, o1), pk2(o2, o3), pk2(o4, o5), pk2(o6, o7)};
                }
                ss = xsum16(ss); ss = xsum32(ss);
                if (fq == 0) ssq[row * 8 + u.pn * 4 + wc] = ss;
                asm volatile("" ::: "memory");
            }
    }
};
DI void p3b_glu(const Params& P, char* lds) {
    pg8::DenseOrder S; S.init(P.ws + WS_YGL, P.ws + WS_WGLU, T, 512, 512, gridDim.x, blockIdx.x);
    EpiGluE E{(const bf16_t*)(P.ws + WS_YGL), (bf16_t*)(P.ws + WS_MERGED), P.b_glu, (float*)(P.ws + WS_SSQ)};
    pg8::gemm_phase<EpiGluE, pg8::DenseOrder, false>((LAS unsigned char*)lds, 512, S, E);
}
struct EpiResidE {
    static constexpr bool MID = false, PREP = false;
    bf16_t* io; const float* ada; int goff;
    DI void operator()(const f32x4 (&acc)[2][2][4][2], const pg8::Unit& u, int wr, int wc, int fr, int fq) const {
        const float* gate = ada + ((256 * u.pm) >> 13) * 6144 + goff + 256 * u.pn + 32 * wc + 8 * fq;
        f32x4 gv[2][2];
#pragma unroll
        for (int bj = 0; bj < 2; ++bj)
#pragma unroll
            for (int n = 0; n < 2; ++n) gv[bj][n] = *(const f32x4*)(gate + 128 * bj + 4 * n);
#pragma unroll
        for (int ai = 0; ai < 2; ++ai)
#pragma unroll
            for (int m = 0; m < 4; ++m) {
                bf16_t* p = io + ((size_t)256 * u.pm + 128 * ai + 64 * wr + 16 * m + fr) * 1024 + 256 * u.pn + 32 * wc + 8 * fq; u32x4 xw[2];
#pragma unroll
                for (int bj = 0; bj < 2; ++bj) xw[bj] = *(const u32x4*)(p + 128 * bj);
#pragma unroll
                for (int bj = 0; bj < 2; ++bj) {
                    const f32x4 a0 = acc[ai][bj][m][0] * gv[bj][0], a1 = acc[ai][bj][m][1] * gv[bj][1]; const u32x4 w = xw[bj];
                    *(u32x4*)(p + 128 * bj) = (u32x4){pk2(ALPHA * bflo(w[0]) + a0[0], ALPHA * bfhi(w[0]) + a0[1]), pk2(ALPHA * bflo(w[1]) + a0[2], ALPHA * bfhi(w[1]) + a0[3]),
                                                      pk2(ALPHA * bflo(w[2]) + a1[0], ALPHA * bfhi(w[2]) + a1[1]), pk2(ALPHA * bflo(w[3]) + a1[2], ALPHA * bfhi(w[3]) + a1[3])};
                }
                asm volatile("" ::: "memory");
            }
    }
};
struct EpiOutProjE {
    static constexpr bool MID = true, PREP = true;
    const float* x; bf16_t* out; const float* ada; const float* attsq; const float* ssq; LAS float* tab;
    DI void prep(const pg8::Unit& u, int tid) const {
        if (tid < 256) {
            const size_t row = (size_t)256 * u.pm + tid;
            const f32x4 p0 = *(const f32x4*)(attsq + row * 8), p1 = *(const f32x4*)(attsq + row * 8 + 4), q0 = *(const f32x4*)(ssq + row * 8), q1 = *(const f32x4*)(ssq + row * 8 + 4);
            const float ra = rsqrtf((((p0[0] + p0[1]) + (p0[2] + p0[3])) + ((p1[0] + p1[1]) + (p1[2] + p1[3]))) * (1.f / 512.f) + EPS);
            const float rs = rsqrtf((((q0[0] + q0[1]) + (q0[2] + q0[3])) + ((q1[0] + q1[1]) + (q1[2] + q1[3]))) * (1.f / 512.f) + EPS);
            *(LAS f32x2*)(tab + (u.aux * 256 + tid) * 2) = (f32x2){ra, rs};
        }
    }
    DI void mid(f32x4 (&acc)[2][2][4][2], const pg8::Unit& u, int wr, int wc, int fr, int fq) const {
#pragma unroll
        for (int ai = 0; ai < 2; ++ai)
#pragma unroll
            for (int m = 0; m < 4; ++m) {
                const f32x2 r2 = *(const LAS f32x2*)(tab + (u.aux * 256 + 128 * ai + 64 * wr + 16 * m + fr) * 2); const float f = r2[0] * __builtin_amdgcn_rcpf(r2[1]);
#pragma unroll
                for (int bj = 0; bj < 2; ++bj)
#pragma unroll
                    for (int n = 0; n < 2; ++n) acc[ai][bj][m][n] *= f;
            }
    }
    DI void operator()(const f32x4 (&acc)[2][2][4][2], const pg8::Unit& u, int wr, int wc, int fr, int fq) const {
        const float* gate = ada + ((256 * u.pm) >> 13) * 6144 + 2048 + 256 * u.pn + 32 * wc + 8 * fq;
        f32x4 gv[2][2];
#pragma unroll
        for (int bj = 0; bj < 2; ++bj)
#pragma unroll
            for (int n = 0; n < 2; ++n) gv[bj][n] = *(const f32x4*)(gate + 128 * bj + 4 * n);
#pragma unroll
        for (int ai = 0; ai < 2; ++ai)
#pragma unroll
            for (int m = 0; m < 4; ++m) {
                const int rl = 128 * ai + 64 * wr + 16 * m + fr; const size_t row = (size_t)256 * u.pm + rl; const size_t o = row * 1024 + 256 * u.pn + 32 * wc + 8 * fq; f32x4 xv[2][2];
                const float r_s = tab[(u.aux * 256 + rl) * 2 + 1];
#pragma unroll
                for (int bj = 0; bj < 2; ++bj)
#pragma unroll
                    for (int n = 0; n < 2; ++n) xv[bj][n] = *(const f32x4*)(x + o + 128 * bj + 4 * n);
#pragma unroll
                for (int bj = 0; bj < 2; ++bj) {
                    const f32x4 v0 = ALPHA * xv[bj][0] + (gv[bj][0] * r_s) * acc[ai][bj][m][0], v1 = ALPHA * xv[bj][1] + (gv[bj][1] * r_s) * acc[ai][bj][m][1];
                    *(u32x4*)(out + o + 128 * bj) = (u32x4){pk2(v0[0], v0[1]), pk2(v0[2], v0[3]), pk2(v1[0], v1[1]), pk2(v1[2], v1[3])};
                }
                asm volatile("" ::: "memory");
            }
    }
};
DI void p3d_outproj(const Params& P, char* lds) {
    pg8::DenseOrder S; S.init(P.ws + WS_MERGED, P.ws + WS_WOUT, T, 1024, 1024, gridDim.x, blockIdx.x);
    EpiOutProjE E{P.x, (bf16_t*)(P.ws + WS_XZ), (const float*)(P.ws + WS_ADA), (const float*)(P.ws + WS_ATTSQ), (const float*)(P.ws + WS_SSQ), (LAS float*)((LAS unsigned char*)lds + P5TAB_OFF)};
    pg8::gemm_phase<EpiOutProjE, pg8::DenseOrder, false>((LAS unsigned char*)lds, 1024, S, E);
}
DI void p3e_ln1(const Params& P) {
    const int tid = opaque_tid(), lane = tid & 63, wid = tid >> 6;
    bf16_t* H2 = (bf16_t*)(P.ws + WS_H2); bf16_t* XZ = (bf16_t*)(P.ws + WS_XZ);
    for (int row = blockIdx.x * 8 + wid; row < T; row += gridDim.x * 8) {
        const float* ADA = (const float*)(P.ws + WS_ADA) + (row >> 13) * 6144;
        bf16_t* vp = XZ + (size_t)row * 1024 + 8 * lane; float v[16]; float s = 0.f;
#pragma unroll
        for (int j = 0; j < 2; ++j) { const u32x4 w = *(const u32x4*)(vp + 512 * j);
#pragma unroll
            for (int i = 0; i < 4; ++i) { v[8 * j + 2 * i] = bflo(w[i]); v[8 * j + 2 * i + 1] = bfhi(w[i]); s += v[8 * j + 2 * i] + v[8 * j + 2 * i + 1]; } }
        const float mean = wave_sum(s) * (1.f / 1024.f); float q = 0.f;
#pragma unroll
        for (int i = 0; i < 16; ++i) { v[i] -= mean; q += v[i] * v[i]; }
        const float rstd = rsqrtf(wave_sum(q) * (1.f / 1024.f) + EPS);
#pragma unroll
        for (int j = 0; j < 2; ++j) {
            const int col = 8 * lane + 512 * j; float x1[8], hv[8];
#pragma unroll
            for (int i = 0; i < 2; ++i) {
                const f32x4 g = *(const f32x4*)(P.ln1_g + col + 4 * i), bb = *(const f32x4*)(P.ln1_b + col + 4 * i), sc2 = *(const f32x4*)(ADA + 4096 + col + 4 * i), sh2 = *(const f32x4*)(ADA + 3072 + col + 4 * i);
#pragma unroll
                for (int t = 0; t < 4; ++t) { x1[4 * i + t] = v[8 * j + 4 * i + t] * rstd * g[t] + bb[t]; hv[4 * i + t] = x1[4 * i + t] * (1.f + sc2[t]) + sh2[t]; }
            }
            *(u32x4*)(vp + 512 * j) = (u32x4){pk2(x1[0], x1[1]), pk2(x1[2], x1[3]), pk2(x1[4], x1[5]), pk2(x1[6], x1[7])};
            *(u32x4*)(H2 + (size_t)row * 1024 + col) = (u32x4){pk2(hv[0], hv[1]), pk2(hv[2], hv[3]), pk2(hv[4], hv[5]), pk2(hv[6], hv[7])};
        }
    }
}
struct EpiRouterSharedE {
    static constexpr bool MID = false, PREP = false;
    float* sc; bf16_t* hids;
    DI void operator()(const f32x4 (&acc)[2][2][4][2], const pg8::Unit& u, int wr, int wc, int fr, int fq) const {
#pragma unroll
        for (int ai = 0; ai < 2; ++ai)
#pragma unroll
            for (int m = 0; m < 4; ++m) {
                const size_t row = (size_t)256 * u.pm + 128 * ai + 64 * wr + 16 * m + fr;
                if (u.pn == 0) {
#pragma unroll
                    for (int bj = 0; bj < 2; ++bj)
#pragma unroll
                        for (int n = 0; n < 2; ++n) { const f32x4 v = acc[ai][bj][m][n]; *(f32x4*)(sc + row * 256 + 128 * bj + 32 * wc + 8 * fq + 4 * n) = (f32x4){sigmoidf_(v[0]), sigmoidf_(v[1]), sigmoidf_(v[2]), sigmoidf_(v[3])}; }
                } else {
                    const f32x4 g0 = acc[ai][0][m][0], g1 = acc[ai][0][m][1], u0 = acc[ai][1][m][0], u1 = acc[ai][1][m][1];
                    *(u32x4*)(hids + row * 256 + 128 * (u.pn - 1) + 32 * wc + 8 * fq) = (u32x4){pk2(siluf_(g0[0]) * u0[0], siluf_(g0[1]) * u0[1]), pk2(siluf_(g0[2]) * u0[2], siluf_(g0[3]) * u0[3]),
                                                                                                 pk2(siluf_(g1[0]) * u1[0], siluf_(g1[1]) * u1[1]), pk2(siluf_(g1[2]) * u1[2], siluf_(g1[3]) * u1[3])};
                }
                asm volatile("" ::: "memory");
            }
    }
};
DI void p3f_router_shared(const Params& P, char* lds) {
    pg8::DenseOrder S; S.init(P.ws + WS_H2, P.ws + WS_WR, T, 768, 1024, gridDim.x, blockIdx.x);
    EpiRouterSharedE E{(float*)(P.ws + WS_SCORES), (bf16_t*)(P.ws + WS_HIDS)};
    pg8::gemm_phase<EpiRouterSharedE, pg8::DenseOrder, false>((LAS unsigned char*)lds, 1024, S, E);
    const int nb = fill_blocks(), G = gridDim.x;
    if (nb > 0 && nb < G && (int)blockIdx.x >= G - nb) conv_experts_block(P, lds, CONV_NT - nb * FILL_TILES_PER_WG + ((int)blockIdx.x - (G - nb)), CONV_NT, nb);
}
DI void p3g_route_shared_down(const Params& P, char* lds) {
    const int tid = opaque_tid(), lane = tid & 63, wid = tid >> 6;
    int* hist = (int*)(lds + P5TAB_OFF); int* base = hist + 256; int* hist2 = base + 256; int* rt_e = hist2 + 256; float* rt_g = (float*)(rt_e + 1024);
    for (int pm = blockIdx.x; pm < 256; pm += gridDim.x) {
        const int row0 = pm * 128; const float* SC = (const float*)(P.ws + WS_SCORES) + (size_t)row0 * 256;
        __syncthreads();
        if (tid < 256) hist[tid] = 0;
        __syncthreads();
        for (int tl = wid * 16; tl < wid * 16 + 16; ++tl) {
            int e; float gte; route_token(SC + (size_t)tl * 256, P.router_bias, lane, e, gte);
            if (lane < 8) { rt_e[tl * 8 + lane] = e; rt_g[tl * 8 + lane] = gte; atomicAdd(&hist[e], 1); }
        }
        __syncthreads();
        if (tid < 256) { const int cnt = hist[tid]; base[tid] = cnt ? atomicAdd((int*)(P.ws + WS_CNT) + tid, cnt) : 0; hist2[tid] = 0; }
        __syncthreads();
        for (int a = tid; a < 1024; a += NTHR) {
            const int e = rt_e[a]; const int pos = base[e] + atomicAdd(&hist2[e], 1); const int slot = (row0 + (a >> 3)) * 8 + (a & 7);
            ((int*)(P.ws + WS_BINS))[(size_t)e * T + pos] = slot; ((float*)(P.ws + WS_BING))[(size_t)e * T + pos] = rt_g[a]; ((int*)(P.ws + WS_EIDX))[slot] = e; ((int*)(P.ws + WS_EPOS))[slot] = pos;
        }
    }
    __syncthreads();
    pg8::DenseOrder S; S.init(P.ws + WS_HIDS, P.ws + WS_WSD, T, 1024, 256, gridDim.x, blockIdx.x);
    EpiResidE E{(bf16_t*)(P.ws + WS_XZ), (const float*)(P.ws + WS_ADA), 5120};
    pg8::gemm_phase<EpiResidE, pg8::DenseOrder, false>((LAS unsigned char*)lds, 256, S, E);
}

DI void moe_tables(const Params& P, char* lds) {
    LAS int* tstart = (LAS int*)((LAS unsigned char*)lds + P5TAB_OFF); LAS int* estart = tstart + 260;
    const int tid = opaque_tid();
    if (tid < 64) {
        const int* gc = (const int*)(P.ws + WS_CNT) + 4 * tid; const int c0 = gc[0], c1 = gc[1], c2 = gc[2], c3 = gc[3];
        const int t0 = (c0 + 255) >> 8, t1 = (c1 + 255) >> 8, t2 = (c2 + 255) >> 8, t3 = (c3 + 255) >> 8;
        int cs = c0 + c1 + c2 + c3, ts = t0 + t1 + t2 + t3; const int cown = cs, town = ts;
#pragma unroll
        for (int o = 1; o < 64; o <<= 1) { const int a = __shfl_up(cs, o), b = __shfl_up(ts, o); if (tid >= o) { cs += a; ts += b; } }
        int ce = cs - cown, te = ts - town;
        estart[4 * tid] = ce; tstart[4 * tid] = te; ce += c0; te += t0; estart[4 * tid + 1] = ce; tstart[4 * tid + 1] = te; ce += c1; te += t1;
        estart[4 * tid + 2] = ce; tstart[4 * tid + 2] = te; ce += c2; te += t2; estart[4 * tid + 3] = ce; tstart[4 * tid + 3] = te;
        if (tid == 63) { estart[256] = cs; tstart[256] = ts; }
    }
    __syncthreads();
}
struct MoeOrder {
    static constexpr bool RAGGED = true;
    const LAS int* tstart; const LAS int* estart; const char* Abase; const char* Bbase; const int* bins; int nunits, per, G, vb, mode;
    DI bool next(int i, pg8::Unit& u) const {
        const long L = (long)i * G + vb; if (L >= (long)nunits) return false;
        const int tile = (int)(L / per), sub = (int)(L % per);
        int lo = 0, hi = NEXP;
        while (hi - lo > 1) { const int mid = (lo + hi) >> 1; if (tstart[mid] <= tile) lo = mid; else hi = mid; }
        const int e = lo, rb = tile - tstart[e], cnt = estart[e + 1] - estart[e];
        u.rows = (cnt - 256 * rb) < 256 ? (cnt - 256 * rb) : 256; u.pm = estart[e] + 256 * rb; u.pn = sub; u.aux = e * T + 256 * rb;
        if (mode == 0) { u.A = Abase; u.B = Bbase + ((size_t)e * 512 + 256 * sub) * 2048; }
        else { u.A = Abase + (size_t)u.pm * 512; u.B = Bbase + ((size_t)e * 1024 + 256 * sub) * 512; }
        return true;
    }
    DI unsigned row_off(const pg8::Unit& u, int r) const { const int v = bins[u.aux + (r < u.rows ? r : u.rows - 1)]; return (unsigned)(v >> 3) * 2048u; }
};
struct EpiGateUp {
    static constexpr bool MID = false, PREP = false;
    bf16_t* H; const float* bing;
    DI void operator()(const f32x4 (&acc)[2][2][4][2], const pg8::Unit& u, int wr, int wc, int fr, int fq) const {
        float gt[2][4];
#pragma unroll
        for (int ai = 0; ai < 2; ++ai)
#pragma unroll
            for (int m = 0; m < 4; ++m) { const int r = 128 * ai + 64 * wr + 16 * m + fr; gt[ai][m] = bing[u.aux + (r < u.rows ? r : u.rows - 1)]; }
#pragma unroll
        for (int ai = 0; ai < 2; ++ai)
#pragma unroll
            for (int m = 0; m < 4; ++m) {
                const int r = 128 * ai + 64 * wr + 16 * m + fr; const float g = gt[ai][m];
                const f32x4 g0 = acc[ai][0][m][0], g1 = acc[ai][0][m][1], u0 = acc[ai][1][m][0], u1 = acc[ai][1][m][1];
                const u32x4 w = (u32x4){pk2(siluf_(g0[0]) * u0[0] * g, siluf_(g0[1]) * u0[1] * g), pk2(siluf_(g0[2]) * u0[2] * g, siluf_(g0[3]) * u0[3] * g),
                                        pk2(siluf_(g1[0]) * u1[0] * g, siluf_(g1[1]) * u1[1] * g), pk2(siluf_(g1[2]) * u1[2] * g, siluf_(g1[3]) * u1[3] * g)};
                if (r < u.rows) *(u32x4*)(H + (size_t)(u.pm + r) * 256 + 128 * u.pn + 32 * wc + 8 * fq) = w;
                asm volatile("" ::: "memory");
            }
    }
};
struct EpiDown {
    static constexpr bool MID = false, PREP = false;
    unsigned char* OA; unsigned char* OB;
    DI void operator()(const f32x4 (&acc)[2][2][4][2], const pg8::Unit& u, int wr, int wc, int fr, int fq) const {
#pragma unroll
        for (int ai = 0; ai < 2; ++ai)
#pragma unroll
            for (int m = 0; m < 4; ++m) {
                const int r = 128 * ai + 64 * wr + 16 * m + fr;
                if (r < u.rows) {
                    const int pos = u.pm + r; unsigned char* rowp = (pos < T * 4 ? OA + (size_t)pos * 1024 : OB + (size_t)(pos - T * 4) * 1024) + 256 * u.pn + 64 * wc + 16 * fq;
                    int pk[4];
#pragma unroll
                    for (int bj = 0; bj < 2; ++bj) {
                        f32x4 v0 = acc[ai][bj][m][0] * OUT_SCALE, v1 = acc[ai][bj][m][1] * OUT_SCALE;
#pragma unroll
                        for (int i = 0; i < 4; ++i) { v0[i] = fminf(fmaxf(v0[i], -448.f), 448.f); v1[i] = fminf(fmaxf(v1[i], -448.f), 448.f); }
                        int lo = 0, hi = 0;
                        lo = __builtin_amdgcn_cvt_pk_fp8_f32(v0[0], v0[1], lo, false); lo = __builtin_amdgcn_cvt_pk_fp8_f32(v0[2], v0[3], lo, true);
                        hi = __builtin_amdgcn_cvt_pk_fp8_f32(v1[0], v1[1], hi, false); hi = __builtin_amdgcn_cvt_pk_fp8_f32(v1[2], v1[3], hi, true);
                        pk[2 * bj] = lo; pk[2 * bj + 1] = hi;
                    }
                    *(u32x4*)rowp = (u32x4){(unsigned)pk[0], (unsigned)pk[1], (unsigned)pk[2], (unsigned)pk[3]};
                }
                asm volatile("" ::: "memory");
            }
    }
};
DI int xcd_vb() { const int G = gridDim.x; return (G % 8 == 0) ? (int)(blockIdx.x % 8) * (G / 8) + (int)(blockIdx.x / 8) : (int)blockIdx.x; }
DI void p5a_gateup(const Params& P, char* lds) {
    moe_tables(P, lds);
    const LAS int* tstart = (const LAS int*)((LAS unsigned char*)lds + P5TAB_OFF);
    MoeOrder S{tstart, tstart + 260, (const char*)(P.ws + WS_H2), (const char*)(P.ws + WS_WEGU), (const int*)(P.ws + WS_BINS), tstart[256] * 2, 2, (int)gridDim.x, xcd_vb(), 0};
    EpiGateUp E{(bf16_t*)(P.ws + WS_HIDALL), (const float*)(P.ws + WS_BING)};
    pg8::gemm_phase<EpiGateUp, MoeOrder, true>((LAS unsigned char*)lds, 1024, S, E);
}
DI void p5b_down(const Params& P, char* lds) {
    const LAS int* tstart = (const LAS int*)((LAS unsigned char*)lds + P5TAB_OFF);
    MoeOrder S{tstart, tstart + 260, (const char*)(P.ws + WS_HIDALL), (const char*)(P.ws + WS_WED), (const int*)(P.ws + WS_BINS), tstart[256] * 4, 4, (int)gridDim.x, xcd_vb(), 1};
    EpiDown E{P.ws + WS_OUTA, P.ws + WS_OUTB};
    pg8::gemm_phase<EpiDown, MoeOrder, false>((LAS unsigned char*)lds, 256, S, E);
}

DI void p6_combine(const Params& P, char* lds) {
    const LAS int* estart = (const LAS int*)((LAS unsigned char*)lds + P5TAB_OFF) + 260;
    const int tid = opaque_tid(), lane = tid & 63, wid = tid >> 6;
    const unsigned char* OA = P.ws + WS_OUTA; const unsigned char* OB = P.ws + WS_OUTB;
    for (int row = blockIdx.x * 8 + wid; row < T; row += gridDim.x * 8) {
        const float* ADA = (const float*)(P.ws + WS_ADA) + (row >> 13) * 6144 + 5120;
        int mypos = 0;
        if (lane < 8) { const int e = ((const int*)(P.ws + WS_EIDX))[row * 8 + lane]; mypos = estart[e] + ((const int*)(P.ws + WS_EPOS))[row * 8 + lane]; }
        u32x4 w[8];
#pragma unroll
        for (int s = 0; s < 8; ++s) { const int pos = __builtin_amdgcn_readlane(mypos, s); w[s] = *(const u32x4*)((pos < T * 4 ? OA + (size_t)pos * 1024 : OB + (size_t)(pos - T * 4) * 1024) + lane * 16); }
        float f[16];
#pragma unroll
        for (int i = 0; i < 16; ++i) f[i] = 0.f;
#pragma unroll
        for (int s = 0; s < 8; ++s)
#pragma unroll
            for (int q = 0; q < 4; ++q) { const f32x2 a = __builtin_amdgcn_cvt_pk_f32_fp8((int)w[s][q], false), bb = __builtin_amdgcn_cvt_pk_f32_fp8((int)w[s][q], true);
                f[4 * q] += a[0]; f[4 * q + 1] += a[1]; f[4 * q + 2] += bb[0]; f[4 * q + 3] += bb[1]; }
        float* op = P.out + (size_t)row * 1024 + 16 * lane; float z[16]; float sm = 0.f;
        const bf16_t* zp = (const bf16_t*)(P.ws + WS_XZ) + (size_t)row * 1024 + 16 * lane; const u32x4 zw0 = *(const u32x4*)zp, zw1 = *(const u32x4*)(zp + 8);
#pragma unroll
        for (int i = 0; i < 4; ++i) { const f32x4 g = *(const f32x4*)(ADA + 16 * lane + 4 * i); const unsigned wa = (i < 2 ? zw0 : zw1)[2 * (i & 1)], wb = (i < 2 ? zw0 : zw1)[2 * (i & 1) + 1];
            const f32x4 zs = (f32x4){bflo(wa), bfhi(wa), bflo(wb), bfhi(wb)};
#pragma unroll
            for (int q = 0; q < 4; ++q) { const float v = zs[q] + g[q] * (f[4 * i + q] * (1.f / OUT_SCALE)); z[4 * i + q] = v; sm += v; } }
        const float mean = wave_sum(sm) * (1.f / 1024.f); float qv = 0.f;
#pragma unroll
        for (int i = 0; i < 16; ++i) { z[i] -= mean; qv += z[i] * z[i]; }
        const float rstd = rsqrtf(wave_sum(qv) * (1.f / 1024.f) + EPS);
#pragma unroll
        for (int i = 0; i < 4; ++i) { const f32x4 g = *(const f32x4*)(P.ln2_g + 16 * lane + 4 * i), bb = *(const f32x4*)(P.ln2_b + 16 * lane + 4 * i);
            *(f32x4*)(op + 4 * i) = (f32x4){z[4 * i] * rstd * g[0] + bb[0], z[4 * i + 1] * rstd * g[1] + bb[1], z[4 * i + 2] * rstd * g[2] + bb[2], z[4 * i + 3] * rstd * g[3] + bb[3]}; }
    }
}

__global__ void __launch_bounds__(NTHR) fwd_megakernel(Params P) {
    extern __shared__ __attribute__((aligned(16))) char lds[];
    volatile LAS unsigned* bst = (volatile LAS unsigned*)((LAS unsigned char*)lds + BARLDS_OFF);
    if (threadIdx.x < 2) bst[threadIdx.x] = 0u;
    __syncthreads();
    const XcdBarrier bar = xcd_barrier_post((unsigned*)(P.ws + WS_BAR), bst);
    p0_prologue(P, lds);
    xcd_barrier(bar);
    p1_inproj_and_experts(P, lds);
    xcd_barrier(bar);
    p2_mixer(P, lds);
    xcd_barrier(bar);
    p3a_ssm(P, lds);
    xcd_barrier(bar);
    p3b_glu(P, lds);
    xcd_barrier(bar);
    p3d_outproj(P, lds);
    xcd_barrier(bar);
    p3e_ln1(P);
    xcd_barrier(bar);
    p3f_router_shared(P, lds);
    xcd_barrier(bar);
    p3g_route_shared_down(P, lds);
    xcd_barrier(bar);
    p5a_gateup(P, lds);
    xcd_barrier(bar);
    p5b_down(P, lds);
    xcd_barrier(bar);
    p6_combine(P, lds);
}


#ifdef ANALYZE_PHASES
template <int PH> __global__ void __launch_bounds__(NTHR) phase_kernel(Params P) {
    extern __shared__ __attribute__((aligned(16))) char lds[];
    if (PH == 0) p0_prologue(P, lds);
    if (PH == 1) p1_inproj_and_experts(P, lds);
    if (PH == 2) p2_mixer(P, lds);
    if (PH == 3) p3a_ssm(P, lds);
    if (PH == 7) p3b_glu(P, lds);
    if (PH == 9) p3d_outproj(P, lds);
    if (PH == 10) p3e_ln1(P);
    if (PH == 11) p3f_router_shared(P, lds);
    if (PH == 12) p3g_route_shared_down(P, lds);
    if (PH == 4) p5a_gateup(P, lds);
    if (PH == 5) p5b_down(P, lds);
    if (PH == 6) p6_combine(P, lds);
}
template __global__ void phase_kernel<0>(Params); template __global__ void phase_kernel<1>(Params); template __global__ void phase_kernel<2>(Params); template __global__ void phase_kernel<3>(Params);
template __global__ void phase_kernel<4>(Params); template __global__ void phase_kernel<5>(Params); template __global__ void phase_kernel<6>(Params);
template __global__ void phase_kernel<7>(Params); template __global__ void phase_kernel<8>(Params); template __global__ void phase_kernel<9>(Params); template __global__ void phase_kernel<10>(Params); template __global__ void phase_kernel<11>(Params); template __global__ void phase_kernel<12>(Params);
#endif

extern "C" void kernel_launch(void* const* d_in, const int* in_sizes, int n_in, void* d_out, int out_size, void* d_ws, size_t ws_size, hipStream_t stream) {
    static int grid = 0;
    if (grid == 0) {
        if (n_in != 31 || out_size != T * D || ws_size < WS_END) { fprintf(stderr, "kernel_launch: unexpected problem (n_in %d, out %d, ws %zu < %zu)\n", n_in, out_size, ws_size, (size_t)WS_END); grid = -1; return; }
        int dev = 0, cus = 0, per_cu = 0;
        (void)hipGetDevice(&dev); (void)hipDeviceGetAttribute(&cus, hipDeviceAttributeMultiprocessorCount, dev);
        (void)hipFuncSetAttribute((const void*)fwd_megakernel, hipFuncAttributeMaxDynamicSharedMemorySize, LDS_BYTES);
        (void)hipOccupancyMaxActiveBlocksPerMultiprocessor(&per_cu, (const void*)fwd_megakernel, NTHR, LDS_BYTES);
        if (per_cu < 1) { fprintf(stderr, "kernel_launch: occupancy query says %d blocks per CU\n", per_cu); grid = -1; return; }
        grid = cus * 1;
        if (grid > 256) grid = 256;
    }
    if (grid < 0) return;
    (void)hipMemsetAsync(d_ws, 0, 65536, stream);
    Params p{};
    const float** pf = (const float**)&p;
    for (int i = 0; i < 31; ++i) pf[i] = (const float*)d_in[i];
    p.out = (float*)d_out; p.ws = (unsigned char*)d_ws;
    void* args[] = {&p};
    hipError_t e = hipLaunchCooperativeKernel((const void*)fwd_megakernel, dim3(grid), dim3(NTHR), args, LDS_BYTES, stream);
    if (e != hipSuccess) fprintf(stderr, "cooperative launch failed: %s (grid %d)\n", hipGetErrorString(e), grid);
}
```

```cpp
#include <hip/hip_runtime.h>
#include <cstdio>
#include <cstdint>

#define DI __device__ __forceinline__
typedef unsigned short bf16_t;
typedef short bf16x8 __attribute__((ext_vector_type(8)));
typedef float f32x2 __attribute__((ext_vector_type(2)));
typedef float f32x4 __attribute__((ext_vector_type(4)));
typedef float f32x16 __attribute__((ext_vector_type(16)));
typedef unsigned u32x2 __attribute__((ext_vector_type(2)));
typedef unsigned u32x4 __attribute__((ext_vector_type(4)));
typedef __bf16 bf16v2 __attribute__((ext_vector_type(2)));

#define MFMA16(a, b, c) __builtin_amdgcn_mfma_f32_16x16x32_bf16((a), (b), (c), 0, 0, 0)
#define MFMA32(a, b, c) __builtin_amdgcn_mfma_f32_32x32x16_bf16((a), (b), (c), 0, 0, 0)
#define LDS_FENCE() asm volatile("s_waitcnt lgkmcnt(0)" ::: "memory")

constexpr int D = 1024, BATCH = 4, SEQ = 8192, T = BATCH * SEQ, NPROJ = 2048;
constexpr int NTHR = 512;
constexpr int NEXP = 256, TOPK = 8;
constexpr float ALPHA = 1.189207115002721f;
constexpr float EPS = 1e-5f;
constexpr float NEG = -1e30f;
constexpr float OUT_SCALE = 64.f;

constexpr size_t MiB = 1u << 20;
constexpr size_t WS_CNT = 0;
constexpr size_t WS_ADACNT = 2048;
constexpr size_t WS_BAR = 16384;
constexpr size_t WS_ADA = 64 * 1024;
constexpr size_t WS_ABAR = 192 * 1024;
constexpr size_t WS_ABARL = 208 * 1024;
constexpr size_t WS_BCAT = 256 * 1024;
constexpr size_t WS_CCAT = 384 * 1024;
constexpr size_t WS_WIN = 2 * MiB;
constexpr size_t WS_WGLU = 6 * MiB;
constexpr size_t WS_WR = 6 * MiB + 512 * 1024;
constexpr size_t WS_WSGU = 7 * MiB;
constexpr size_t WS_WOUT = 8 * MiB;
constexpr size_t WS_WSD = 10 * MiB;
constexpr size_t WS_EIDX = 11 * MiB;
constexpr size_t WS_EPOS = 12 * MiB;
constexpr size_t WS_HIDS = 14 * MiB;
constexpr size_t WS_BINS = 30 * MiB;
constexpr size_t WS_BING = 62 * MiB;
constexpr size_t WS_H2 = 94 * MiB;
constexpr size_t WS_WEGU = 158 * MiB;
constexpr size_t WS_WED = 414 * MiB;
constexpr size_t WS_H1 = 542 * MiB;
constexpr size_t WS_QKVU = 606 * MiB;
constexpr size_t WS_MERGED = 734 * MiB;
constexpr size_t WS_YGL = 798 * MiB;
constexpr size_t WS_SCORES = 830 * MiB;
constexpr size_t WS_E = 862 * MiB;
constexpr size_t WS_ATTSQ = 866 * MiB;
constexpr size_t WS_SSQ = 867 * MiB;
constexpr size_t WS_RS = 868 * MiB;
constexpr size_t WS_HIDALL = 542 * MiB;
constexpr size_t WS_OUTA = 158 * MiB;
constexpr size_t WS_OUTB = 670 * MiB;
constexpr size_t WS_XZ = 926 * MiB;
constexpr size_t WS_END = 1022 * MiB;

constexpr int LDP = 72;
constexpr int GEMM_LDS = (128 + 256) * LDP * 2;
constexpr int MISC_OFF = 57344;
constexpr int SSM_PITCH = 36;
constexpr int SSM_WAVE_LDS = 128 * SSM_PITCH * 4;
constexpr int P5TAB_OFF = 131072;
constexpr int BARLDS_OFF = 148 * 1024;
constexpr int LDS_BYTES = 148 * 1024 + 64;

struct Params {
    const float *x, *c, *rel_bias, *w_ada, *b_ada, *w_in, *a_re, *a_im, *b_re, *b_im, *c_re, *c_im, *ssm_d, *log_dt, *w_glu, *b_glu, *g_att, *g_ssm, *w_out,
        *ln1_g, *ln1_b, *w_router, *router_bias, *w_e_gate, *w_e_up, *w_e_down, *w_s_gate, *w_s_up, *w_s_down, *ln2_g, *ln2_b;
    float* out;
    unsigned char* ws;
};

DI int opaque_tid() { int t = threadIdx.x; asm volatile("" : "+v"(t)); return t; }
DI unsigned pk2(float a, float b) { f32x2 f = {a, b}; bf16v2 r = __builtin_convertvector(f, bf16v2); return __builtin_bit_cast(unsigned, r); }
DI bf16_t f2bf(float a) { return (bf16_t)(pk2(a, 0.f) & 0xffffu); }
DI float bflo(unsigned w) { return __uint_as_float(w << 16); }
DI float bfhi(unsigned w) { return __uint_as_float(w & 0xffff0000u); }
DI float sigmoidf_(float x) { return __builtin_amdgcn_rcpf(1.f + __expf(-x)); }
DI float siluf_(float x) { return x * __builtin_amdgcn_rcpf(1.f + __expf(-x)); }
DI float gelu_tanh(float x) { const float u = 0.7978845608028654f * (x + 0.044715f * x * x * x); const float e = __expf(2.f * u); const float th = 1.f - 2.f * __builtin_amdgcn_rcpf(e + 1.f); return 0.5f * x * (1.f + th); }
template <int CTRL> DI float dppf(float v) { return __builtin_bit_cast(float, __builtin_amdgcn_update_dpp(0, __builtin_bit_cast(int, v), CTRL, 0xF, 0xF, true)); }
DI float rdlane(float v, int l) { return __builtin_bit_cast(float, __builtin_amdgcn_readlane(__builtin_bit_cast(int, v), l)); }
constexpr int DPP_X1 = 0xB1, DPP_X2 = 0x4E, DPP_HM = 0x141, DPP_RM = 0x140;
DI float xsum16(float x) { auto t = __builtin_amdgcn_permlane16_swap(__float_as_uint(x), __float_as_uint(x), false, false); return __uint_as_float(t[0]) + __uint_as_float(t[1]); }
DI float xsum32(float x) { auto t = __builtin_amdgcn_permlane32_swap(__float_as_uint(x), __float_as_uint(x), false, false); return __uint_as_float(t[0]) + __uint_as_float(t[1]); }
DI float xmax32(float x) { auto t = __builtin_amdgcn_permlane32_swap(__float_as_uint(x), __float_as_uint(x), false, false); return fmaxf(__uint_as_float(t[0]), __uint_as_float(t[1])); }
DI float wave_sum(float v) {
    v += dppf<DPP_X1>(v); v += dppf<DPP_X2>(v); v += dppf<DPP_HM>(v); v += dppf<DPP_RM>(v); v = xsum16(v); return xsum32(v);
}

#define LAS __attribute__((address_space(3)))
#define XB_TMO      128
#define XB_XCNT(j)  (256  + 64 * (j))
#define XB_XSUB(j)  (1280 + 64 * (j))
#define XB_XGEN(j)  (2304 + 64 * (j))
#define XB_TOP      3328
#define XB_TOPGEN   3392
#define XB_SPIN_CAP (1u << 18)
DI unsigned xb_ld(unsigned* p) { return __hip_atomic_load(p, __ATOMIC_RELAXED, __HIP_MEMORY_SCOPE_AGENT); }
DI unsigned xb_add(unsigned* p, unsigned v) { return __hip_atomic_fetch_add(p, v, __ATOMIC_RELAXED, __HIP_MEMORY_SCOPE_AGENT); }
DI unsigned xb_xcc_id() { return (unsigned)__builtin_amdgcn_s_getreg((3 << 11) | 20) & 0xFu; }
#define XB_SPIN(cond, bar) do { unsigned _sp = 0; while (cond) { __builtin_amdgcn_s_sleep(1); \
    if ((++_sp & 255u) == 0u) { if (xb_ld(&(bar)[XB_TMO])) break; if (_sp > XB_SPIN_CAP) { atomicAdd(&(bar)[XB_TMO], 1u); break; } } } } while (0)
struct XcdBarrier { unsigned* bar; unsigned x; volatile LAS unsigned* st; };
DI XcdBarrier xcd_barrier_post(unsigned* bar, volatile LAS unsigned* st) {
    XcdBarrier b; b.bar = bar; b.x = xb_xcc_id(); b.st = st;
    if (threadIdx.x == 0) (void)xb_add(&bar[XB_XCNT(b.x)], 1u);
    return b;
}
DI void xcd_barrier_complete(unsigned* bar, unsigned x, unsigned& nloc, unsigned& nx) {
    const unsigned G = gridDim.x * gridDim.y * gridDim.z;
    unsigned sum, cnt, mine, sp = 0u;
    for (;;) {
        sum = 0u; cnt = 0u; mine = 0u;
#pragma unroll
        for (unsigned j = 0; j < 16; ++j) { const unsigned c = xb_ld(&bar[XB_XCNT(j)]); sum += c; cnt += (c > 0u) ? 1u : 0u; mine = (j == x) ? c : mine; }
        if (sum == G) break;
        __builtin_amdgcn_s_sleep(1);
        if ((++sp & 255u) == 0u) { if (xb_ld(&bar[XB_TMO])) break; if (sp > XB_SPIN_CAP) { atomicAdd(&bar[XB_TMO], 1u); break; } }
    }
    nloc = mine > 0u ? mine : 1u; nx = cnt > 0u ? cnt : 1u;
}
DI void xcd_barrier(const XcdBarrier& b) {
    asm volatile("s_waitcnt vmcnt(0)" ::: "memory");
    __syncthreads();
    if (threadIdx.x == 0) {
        unsigned* bar = b.bar;
        __builtin_amdgcn_s_waitcnt(0);
        unsigned nloc = b.st[0], nx = b.st[1];
        if (nloc == 0u) { xcd_barrier_complete(bar, b.x, nloc, nx); b.st[0] = nloc; b.st[1] = nx; }
        const unsigned old = xb_add(&bar[XB_XSUB(b.x)], 1u);
        const unsigned gen = old / nloc;
        if (old + 1u == (gen + 1u) * nloc) {
            __builtin_amdgcn_fence(__ATOMIC_RELEASE, "agent");
            asm volatile("s_waitcnt vmcnt(0)" ::: "memory");
            const unsigned og = xb_add(&bar[XB_TOP], 1u);
            const unsigned tg = og / nx;
            if (og + 1u == (tg + 1u) * nx) xb_add(&bar[XB_TOPGEN], 1u);
            else XB_SPIN(xb_ld(&bar[XB_TOPGEN]) == tg, bar);
            __builtin_amdgcn_fence(__ATOMIC_ACQUIRE, "agent");
            xb_add(&bar[XB_XGEN(b.x)], 1u);
            asm volatile("s_waitcnt vmcnt(0)" ::: "memory");
        } else {
            XB_SPIN(xb_ld(&bar[XB_XGEN(b.x)]) == gen, bar);
            __builtin_amdgcn_fence(__ATOMIC_ACQUIRE, "agent");
            asm volatile("s_waitcnt vmcnt(0)" ::: "memory");
        }
    }
    __syncthreads();
}

namespace pg8 {
constexpr int BM = 256, BK = 64, HALF = 128, HTB = HALF * BK * 2, STAGE_BYTES = 8 * HTB;
DI int lds_byte(int r, int c) { const int st = (r >> 4) * 2 + (c >> 5), rr = r & 15, cc = c & 31, ob = rr * 64 + cc * 2; return st * 1024 + (ob ^ (((ob >> 9) & 1) << 5)); }
DI void stage_rc(int b, int& R, int& C) { const int st = b / 1024, sb = b % 1024, swz = sb ^ (((sb >> 9) & 1) << 5); R = (st >> 1) * 16 + swz / 64; C = (st & 1) * 32 + (swz % 64) / 2; }
DI int perm32(int rho) { const int n = rho >> 4, i = rho & 15; return 8 * (i >> 2) + 4 * n + (i & 3); }
struct Unit { const char* A; const char* B; int pm, pn, rows, aux; };

template <class Epi, class Sched, bool GATHER>
DI void gemm_phase(LAS unsigned char* lds, const int K, const Sched& S, const Epi& E) {
    int tid = threadIdx.x; asm volatile("" : "+v"(tid));
    const int wid = __builtin_amdgcn_readfirstlane(tid >> 6), lane = tid & 63, wr = wid >> 2, wc = wid & 3, fr = lane & 15, fq = lane >> 4;
    const int nt = K / BK;
    unsigned voffA[2], voffB[2]; int Rr[2], Cc[2];
#pragma unroll
    for (int i = 0; i < 2; ++i) { int R, C; stage_rc(tid * 16 + i * 8192, R, C); const int Rb = (R & ~31) + perm32(R & 31); Rr[i] = R; Cc[i] = C;
        voffA[i] = (unsigned)(R * K + C) * 2u; voffB[i] = (unsigned)(Rb * K + C) * 2u; }
    const size_t kstep = (size_t)(BK * 2);
    const size_t hstep = (size_t)HALF * K * 2;
    const unsigned ldsw = (unsigned)wid * 1024u;
    const int aoff = lds_byte(wr * 64 + fr, fq * 8), boff = lds_byte(wc * 32 + fr, fq * 8);
#define PG8_SA(b, h) (((b) * 2 + (h)) * HTB)
#define PG8_SB(b, h) ((4 + (b) * 2 + (h)) * HTB)
#define PG8_STAGE(bufoff, gbase, voff) do { _Pragma("unroll") for (int _i = 0; _i < 2; ++_i) \
        __builtin_amdgcn_global_load_lds((const unsigned*)((const char*)(gbase) + (voff)[_i]), (LAS unsigned*)(lds + (bufoff) + ldsw + _i * 8192), 16, 0, 0); } while (0)
#define PG8_STAGEA(bufoff, gbase, h, nx) do { if constexpr (GATHER) { unsigned _o[2]; _o[0] = (nx) ? na[h][0] : ga[h][0]; _o[1] = (nx) ? na[h][1] : ga[h][1]; PG8_STAGE(bufoff, gbase, _o); } \
        else { PG8_STAGE(bufoff, (gbase) + (h) * hstep, voffA); } } while (0)
#define PG8_LDA(dst, b, h) do { _Pragma("unroll") for (int m = 0; m < 4; ++m) _Pragma("unroll") for (int k = 0; k < 2; ++k) dst[m][k] = *(const LAS bf16x8*)(lds + PG8_SA(b, h) + aoff + m * 2048 + k * 1024); } while (0)
#define PG8_LDB(dst, b, h) do { _Pragma("unroll") for (int n = 0; n < 2; ++n) _Pragma("unroll") for (int k = 0; k < 2; ++k) dst[n][k] = *(const LAS bf16x8*)(lds + PG8_SB(b, h) + boff + n * 2048 + k * 1024); } while (0)
#define PG8_MMA(ai, bj, At, Bt) do { __builtin_amdgcn_s_setprio(1); _Pragma("unroll") for (int m = 0; m < 4; ++m) _Pragma("unroll") for (int n = 0; n < 2; ++n) _Pragma("unroll") for (int k = 0; k < 2; ++k) \
        acc[ai][bj][m][n] = __builtin_amdgcn_mfma_f32_16x16x32_bf16(Bt[n][k], At[m][k], acc[ai][bj][m][n], 0, 0, 0); __builtin_amdgcn_s_setprio(0); } while (0)
#define PG8_WAIT_V(n) asm volatile("s_waitcnt vmcnt(" #n ")" ::: "memory")
#define PG8_WAIT_L(n) asm volatile("s_waitcnt lgkmcnt(" #n ")" ::: "memory")
#define PG8_BAR __builtin_amdgcn_s_barrier()
#define PG8_SCHED __builtin_amdgcn_sched_barrier(0)
    Unit cur, nxt; int ui = 0;
    if (!S.next(0, cur)) return;
    f32x4 acc[2][2][4][2];
#pragma unroll
    for (int a = 0; a < 2; ++a)
#pragma unroll
        for (int b = 0; b < 2; ++b)
#pragma unroll
            for (int m = 0; m < 4; ++m)
#pragma unroll
                for (int n = 0; n < 2; ++n) acc[a][b][m][n] = (f32x4){0.f, 0.f, 0.f, 0.f};
    bf16x8 At[4][2], B0[2][2], B1[2][2];
    const char* cA = cur.A; const char* cB = cur.B;
    if constexpr (Epi::PREP) E.prep(cur, tid);
    unsigned ga[2][2], na[2][2];
    if constexpr (GATHER) {
#pragma unroll
        for (int h = 0; h < 2; ++h)
#pragma unroll
            for (int i = 0; i < 2; ++i) { ga[h][i] = S.row_off(cur, 128 * h + Rr[i]) + (unsigned)Cc[i] * 2u; na[h][i] = ga[h][i]; }
    }
    PG8_STAGE(PG8_SB(0, 0), cB, voffB); PG8_STAGE(PG8_SB(0, 1), cB + hstep, voffB); PG8_STAGEA(PG8_SA(0, 0), cA, 0, false); PG8_STAGEA(PG8_SA(0, 1), cA, 1, false);
    if (wr == 1) PG8_BAR;
    PG8_WAIT_V(2); PG8_BAR;
    PG8_STAGE(PG8_SB(1, 0), cB + kstep, voffB); PG8_STAGEA(PG8_SA(1, 0), cA + kstep, 0, false); PG8_STAGE(PG8_SB(1, 1), cB + hstep + kstep, voffB);
    PG8_WAIT_V(6); PG8_BAR;
    for (;;) {
        const bool has_next = S.next(ui + 1, nxt);
        if constexpr (Epi::PREP) { if (has_next) E.prep(nxt, tid); }
        const char* nA = has_next ? nxt.A : cA; const char* nB = has_next ? nxt.B : cB;
        if constexpr (GATHER) {
            if (has_next) {
#pragma unroll
                for (int h = 0; h < 2; ++h)
#pragma unroll
                    for (int i = 0; i < 2; ++i) na[h][i] = S.row_off(nxt, 128 * h + Rr[i]) + (unsigned)Cc[i] * 2u;
            }
        }
        const bool do0 = !Sched::RAGGED || cur.rows > 64 * wr, do1 = !Sched::RAGGED || cur.rows > 128 + 64 * wr;
#pragma unroll 1
        for (int t = 0; t < nt; t += 2) {
            const bool last = (t == nt - 2);
            const char* a1 = cA + (size_t)(t + 1) * kstep;
            const char* a2 = last ? nA : cA + (size_t)(t + 2) * kstep; const char* b2 = last ? nB : cB + (size_t)(t + 2) * kstep;
            const char* a3 = a2 + kstep; const char* b3 = b2 + kstep;
            PG8_LDB(B0, 0, 0); PG8_LDB(B1, 0, 1); PG8_SCHED; PG8_LDA(At, 0, 0); PG8_STAGEA(PG8_SA(1, 1), a1, 1, false);
            PG8_WAIT_V(8); PG8_WAIT_L(0); PG8_BAR; if (do0) { PG8_MMA(0, 0, At, B0); PG8_MMA(0, 1, At, B1); } PG8_BAR; PG8_SCHED;
            PG8_LDA(At, 0, 1); PG8_STAGE(PG8_SB(0, 0), b2, voffB); PG8_STAGE(PG8_SB(0, 1), b2 + hstep, voffB); PG8_STAGEA(PG8_SA(0, 0), a2, 0, last);
            PG8_WAIT_V(8); PG8_WAIT_L(0); PG8_BAR; if (do1) { PG8_MMA(1, 0, At, B0); PG8_MMA(1, 1, At, B1); } PG8_BAR; PG8_SCHED;
            PG8_LDB(B0, 1, 0); PG8_LDB(B1, 1, 1); PG8_SCHED; PG8_LDA(At, 1, 0); PG8_STAGEA(PG8_SA(0, 1), a2, 1, last);
            PG8_WAIT_V(8); PG8_WAIT_L(0); PG8_BAR; if (do0) { PG8_MMA(0, 0, At, B0); PG8_MMA(0, 1, At, B1); } PG8_BAR; PG8_SCHED;
            PG8_LDA(At, 1, 1); PG8_STAGE(PG8_SB(1, 0), b3, voffB); PG8_STAGE(PG8_SB(1, 1), b3 + hstep, voffB); PG8_STAGEA(PG8_SA(1, 0), a3, 0, last);
            PG8_WAIT_V(8); PG8_WAIT_L(0); PG8_BAR; if (do1) { PG8_MMA(1, 0, At, B0); PG8_MMA(1, 1, At, B1); } PG8_BAR; PG8_SCHED;
            if constexpr (Epi::MID) { if (t == nt / 2 - 2) E.mid(acc, cur, wr, wc, fr, fq); }
        }
        if (wr == 0) PG8_BAR;
        E(acc, cur, wr, wc, fr, fq);
        if (!has_next) break;
#pragma unroll
        for (int a = 0; a < 2; ++a)
#pragma unroll
            for (int b = 0; b < 2; ++b)
#pragma unroll
                for (int m = 0; m < 4; ++m)
#pragma unroll
                    for (int n = 0; n < 2; ++n) acc[a][b][m][n] = (f32x4){0.f, 0.f, 0.f, 0.f};
        cur = nxt; cA = nA; cB = nB; ++ui;
        if constexpr (GATHER) {
#pragma unroll
            for (int h = 0; h < 2; ++h)
#pragma unroll
                for (int i = 0; i < 2; ++i) ga[h][i] = na[h][i];
        }
        if (wr == 1) PG8_BAR;
    }
    PG8_WAIT_V(0);
    PG8_BAR;
#undef PG8_SA
#undef PG8_SB
#undef PG8_STAGE
#undef PG8_STAGEA
#undef PG8_LDA
#undef PG8_LDB
#undef PG8_MMA
#undef PG8_WAIT_V
#undef PG8_WAIT_L
#undef PG8_BAR
#undef PG8_SCHED
}

struct DenseOrder {
    static constexpr bool RAGGED = false;
    const char* A; const char* Bt; int K, nM, nN, nwg, G, c;
    DI void init(const void* A_, const void* Bt_, int M, int N, int K_, int G_, int c_) { A = (const char*)A_; Bt = (const char*)Bt_; K = K_; nM = M / BM; nN = N / BM; nwg = nM * nN; G = G_; c = c_; }
    DI bool next(int i, Unit& u) const {
        const long L = (long)i * G + c; if (L >= nwg) return false;
        int wgid = (int)L; { const int q = nwg / 8, r = nwg % 8, xcd = wgid % 8, off = wgid / 8; wgid = (xcd < r ? xcd * (q + 1) : r * (q + 1) + (xcd - r) * q) + off; }
        const int nig = 8 * nN, gid = wgid / nig, fm = gid * 8, gsz = (nM - fm) < 8 ? (nM - fm) : 8;
        u.pm = fm + ((wgid % nig) % gsz); u.pn = (wgid % nig) / gsz; u.rows = 256; u.aux = i % 3;
        u.A = A + (size_t)u.pm * 256 * K * 2; u.B = Bt + (size_t)u.pn * 256 * K * 2; return true;
    }
    DI unsigned row_off(const Unit&, int) const { return 0u; }
};
struct EpiStoreBf16 {
    static constexpr bool MID = false, PREP = false;
    bf16_t* O; int ld;
    DI void operator()(const f32x4 (&acc)[2][2][4][2], const Unit& u, int wr, int wc, int fr, int fq) const {
        bf16_t* base = O + (size_t)(u.pm * 256 + wr * 64 + fr) * ld + u.pn * 256 + wc * 32 + 8 * fq;
#pragma unroll
        for (int ai = 0; ai < 2; ++ai)
#pragma unroll
            for (int m = 0; m < 4; ++m) { bf16_t* rowp = base + (size_t)(ai * HALF + m * 16) * ld;
#pragma unroll
                for (int bj = 0; bj < 2; ++bj) { const f32x4 v0 = acc[ai][bj][m][0], v1 = acc[ai][bj][m][1];
                    *(u32x4*)(rowp + bj * HALF) = (u32x4){pk2(v0[0], v0[1]), pk2(v0[2], v0[3]), pk2(v1[0], v1[1]), pk2(v1[2], v1[3])}; } }
    }
};
}

DI void sincos_d(double ang, double& s, double& c) {
    const double r = ang * 0.63661977236758134308; const double q = __builtin_rint(r);
    const double y = (ang - q * 1.57079632679489655800) - q * 6.12323399573676603587e-17;
    const double y2 = y * y;
    double sp = -1.0 / 1307674368000.0; sp = sp * y2 + 1.0 / 6227020800.0; sp = sp * y2 - 1.0 / 39916800.0; sp = sp * y2 + 1.0 / 362880.0; sp = sp * y2 - 1.0 / 5040.0; sp = sp * y2 + 1.0 / 120.0; sp = sp * y2 - 1.0 / 6.0; sp = sp * y2 + 1.0;
    const double sy = y * sp;
    double cp = 1.0 / 87178291200.0; cp = cp * y2 - 1.0 / 479001600.0; cp = cp * y2 + 1.0 / 3628800.0; cp = cp * y2 - 1.0 / 40320.0; cp = cp * y2 + 1.0 / 720.0; cp = cp * y2 - 1.0 / 24.0; cp = cp * y2 + 0.5; const double cy = 1.0 - y2 * cp;
    const int qi = ((int)q) & 3;
    s = (qi == 0) ? sy : (qi == 1) ? cy : (qi == 2) ? -sy : -cy;
    c = (qi == 0) ? cy : (qi == 1) ? -sy : (qi == 2) ? -cy : sy;
}
DI void ssm_tables(const Params& P, int g, int p) {
    float* ABAR = (float*)(P.ws + WS_ABAR); float* ABARL = (float*)(P.ws + WS_ABARL); bf16_t* BCAT = (bf16_t*)(P.ws + WS_BCAT); bf16_t* CCAT = (bf16_t*)(P.ws + WS_CCAT);
    const double dt = (double)expf(P.log_dt[g]);
    const double ar = P.a_re[g * 64 + p], ai = P.a_im[g * 64 + p];
    double sn, cs; sincos_d(dt * ai, sn, cs);
    const double mag = (double)expf((float)(dt * ar));
    const double abr = mag * cs, abi = mag * sn;
    ABAR[g * 128 + p] = (float)abr; ABAR[g * 128 + 64 + p] = (float)abi;
    double snL, csL; sincos_d(128.0 * dt * ai, snL, csL);
    const double magL = (double)expf((float)(128.0 * dt * ar));
    ABARL[g * 128 + p] = (float)(magL * csL); ABARL[g * 128 + 64 + p] = (float)(magL * snL);
    const double xr = abr - 1.0, xi = abi, den = ar * ar + ai * ai;
    const double qr = (xr * ar + xi * ai) / den, qi = (xi * ar - xr * ai) / den;
    for (int c = 0; c < 16; ++c) {
        const double br = P.b_re[(g * 64 + p) * 16 + c], bi = P.b_im[(g * 64 + p) * 16 + c];
        BCAT[(g * 128 + p) * 16 + c] = f2bf((float)(qr * br - qi * bi));
        BCAT[(g * 128 + 64 + p) * 16 + c] = f2bf((float)(qr * bi + qi * br));
        CCAT[(g * 16 + c) * 128 + p] = f2bf(P.c_re[(g * 16 + c) * 64 + p]);
        CCAT[(g * 16 + c) * 128 + 64 + p] = f2bf(-P.c_im[(g * 16 + c) * 64 + p]);
    }
}
DI void ada_item(const Params& P, char* lds, int item) {
    float* red = (float*)lds; const int tid = opaque_tid(), lane = tid & 63, wid = tid >> 6;
    const int n = item * 64 + lane, k0 = wid * 128;
    float a0 = 0.f, a1 = 0.f, a2 = 0.f, a3 = 0.f;
#pragma unroll 1
    for (int kb = k0; kb < k0 + 128; kb += 32) {
        float w[32];
#pragma unroll
        for (int j = 0; j < 32; ++j) w[j] = P.w_ada[(size_t)(kb + j) * 6144 + n];
#pragma unroll
        for (int j = 0; j < 32; ++j) { const int k = kb + j; a0 += siluf_(P.c[k]) * w[j]; a1 += siluf_(P.c[1024 + k]) * w[j]; a2 += siluf_(P.c[2048 + k]) * w[j]; a3 += siluf_(P.c[3072 + k]) * w[j]; }
    }
    red[(wid * 4 + 0) * 64 + lane] = a0; red[(wid * 4 + 1) * 64 + lane] = a1; red[(wid * 4 + 2) * 64 + lane] = a2; red[(wid * 4 + 3) * 64 + lane] = a3;
    __syncthreads();
    if (tid < 256) {
        const int b = tid >> 6, l = tid & 63; float s = 0.f;
#pragma unroll
        for (int w = 0; w < 8; ++w) s += red[(w * 4 + b) * 64 + l];
        ((float*)(P.ws + WS_ADA))[b * 6144 + item * 64 + l] = s + P.b_ada[item * 64 + l];
    }
    asm volatile("s_waitcnt vmcnt(0)" ::: "memory");
    __syncthreads();
    if (tid == 0) {
        __builtin_amdgcn_fence(__ATOMIC_RELEASE, "agent"); asm volatile("s_waitcnt vmcnt(0)" ::: "memory");
        __hip_atomic_fetch_add((unsigned*)(P.ws + WS_ADACNT), 1u, __ATOMIC_RELAXED, __HIP_MEMORY_SCOPE_AGENT);
    }
}
DI void tr_item(const float* __restrict__ W, int K, int N, bf16_t* __restrict__ WT, int item, float* scr, int lane, int mode, int s, bool qscale, const float* ks0 = nullptr, const float* ks1 = nullptr) {
    const int nblk = N >> 6, kb = item / nblk, nb = item % nblk, k0 = 64 * kb, n0 = 64 * nb;
    const float* src = W + (size_t)(k0 + (lane >> 4)) * N + n0 + 4 * (lane & 15);
    f32x4 wv[16];
#pragma unroll
    for (int i = 0; i < 16; ++i) wv[i] = *(const f32x4*)(src + (size_t)(4 * i) * N);
    if (ks0) {
#pragma unroll
        for (int i = 0; i < 16; ++i) { const int k = k0 + 4 * i + (lane >> 4); wv[i] = wv[i] * ((k < 512) ? ks0[k] : ks1[k - 512]); }
    }
#pragma unroll
    for (int i = 0; i < 16; ++i) { float* d = scr + (4 * i + (lane >> 4)) * 65 + 4 * (lane & 15); d[0] = wv[i][0]; d[1] = wv[i][1]; d[2] = wv[i][2]; d[3] = wv[i][3]; }
    LDS_FENCE();
    const int c = lane & 7; const float sc = (qscale && n0 < 512) ? 0.125f : 1.f;
#pragma unroll
    for (int j = 0; j < 8; ++j) {
        const int n = (lane >> 3) + 8 * j; const float* sp = scr + (8 * c) * 65 + n;
        const u32x4 o = (u32x4){pk2(sp[0] * sc, sp[65] * sc), pk2(sp[130] * sc, sp[195] * sc), pk2(sp[260] * sc, sp[325] * sc), pk2(sp[390] * sc, sp[455] * sc)};
        const int nn = n0 + n; const int drow = mode == 0 ? nn : (mode == 1 ? (64 * (nn >> 5) + 32 * s + (nn & 31)) : (mode == 2 ? (256 * (nn >> 7) + 128 * s + (nn & 127)) :
            ((nn & ~255) + 128 * ((nn >> 3) & 1) + 32 * ((nn >> 6) & 3) + 8 * ((nn >> 4) & 3) + (nn & 7))));
        *(u32x4*)(WT + (size_t)drow * K + k0 + 8 * c) = o;
    }
    LDS_FENCE();
}
constexpr int CI_IN = 512, CI_GLU = 64, CI_OUT = 256, CI_R = 64, CI_SG = 64, CI_SU = 64, CI_SD = 64, CI_SMALL = CI_IN + CI_GLU + CI_OUT + CI_R + CI_SG + CI_SU + CI_SD;
DI void conv_item(const Params& P, int r, float* scr, int lane) {
    if (r < CI_IN) { tr_item(P.w_in, 1024, 2048, (bf16_t*)(P.ws + WS_WIN), r, scr, lane, 0, 0, true); return; } r -= CI_IN;
    if (r < CI_GLU) { tr_item(P.w_glu, 512, 512, (bf16_t*)(P.ws + WS_WGLU), r, scr, lane, 0, 0, false); return; } r -= CI_GLU;
    if (r < CI_OUT) { tr_item(P.w_out, 1024, 1024, (bf16_t*)(P.ws + WS_WOUT), r, scr, lane, 0, 0, false, P.g_att, P.g_ssm); return; } r -= CI_OUT;
    if (r < CI_R) { tr_item(P.w_router, 1024, 256, (bf16_t*)(P.ws + WS_WR), r, scr, lane, 0, 0, false); return; } r -= CI_R;
    if (r < CI_SG) { tr_item(P.w_s_gate, 1024, 256, (bf16_t*)(P.ws + WS_WSGU), r, scr, lane, 2, 0, false); return; } r -= CI_SG;
    if (r < CI_SU) { tr_item(P.w_s_up, 1024, 256, (bf16_t*)(P.ws + WS_WSGU), r, scr, lane, 2, 1, false); return; } r -= CI_SU;
    if (r < CI_SD) tr_item(P.w_s_down, 256, 1024, (bf16_t*)(P.ws + WS_WSD), r, scr, lane, 0, 0, false);
}
DI void p0_prologue(const Params& P, char* lds) {
    const int tid = opaque_tid(), lane = tid & 63, wid = tid >> 6, G = gridDim.x;
    { const int gt = blockIdx.x * NTHR + tid; if (gt < 2048) ssm_tables(P, gt >> 6, gt & 63); }
    for (int item = blockIdx.x; item < 96; item += G) ada_item(P, lds, item);
    float* scr = (float*)(lds + wid * 16640);
    const int gw = blockIdx.x * 8 + wid, NGW = G * 8;
    if (blockIdx.x >= 96 || G <= 96) { const int w0 = (G > 96) ? gw - 96 * 8 : gw, nw = (G > 96) ? (G - 96) * 8 : NGW; for (int it = w0; it < CI_SMALL; it += nw) conv_item(P, it, scr, lane); }
    if (tid == 0) {
        unsigned* ctr = (unsigned*)(P.ws + WS_ADACNT); unsigned sp = 0;
        while (__hip_atomic_load(ctr, __ATOMIC_RELAXED, __HIP_MEMORY_SCOPE_AGENT) < 96u) { __builtin_amdgcn_s_sleep(2); if (++sp > (1u << 22)) break; }
        __builtin_amdgcn_fence(__ATOMIC_ACQUIRE, "agent"); asm volatile("s_waitcnt vmcnt(0)" ::: "memory");
    }
    __syncthreads();
    {
        const float* ADA = (const float*)(P.ws + WS_ADA); bf16_t* H1 = (bf16_t*)(P.ws + WS_H1);
        for (int row = gw; row < T; row += NGW) {
            const float* xr = P.x + (size_t)row * 1024 + 4 * lane; const float* ad = ADA + (row >> 13) * 6144 + 4 * lane;
#pragma unroll
            for (int j = 0; j < 4; ++j) {
                const f32x4 xv = *(const f32x4*)(xr + 256 * j), sc = *(const f32x4*)(ad + 1024 + 256 * j), sh = *(const f32x4*)(ad + 256 * j);
                const f32x4 hv = xv * (1.f + sc) + sh;
                *(u32x2*)(H1 + (size_t)row * 1024 + 4 * lane + 256 * j) = (u32x2){pk2(hv[0], hv[1]), pk2(hv[2], hv[3])};
            }
        }
    }
}

DI void p1_inproj(const Params& P, char* lds) {
    pg8::DenseOrder S; S.init(P.ws + WS_H1, P.ws + WS_WIN, T, NPROJ, 1024, gridDim.x, blockIdx.x);
    pg8::EpiStoreBf16 E{(bf16_t*)(P.ws + WS_QKVU), NPROJ};
    pg8::gemm_phase<pg8::EpiStoreBf16, pg8::DenseOrder, false>((LAS unsigned char*)lds, 1024, S, E);
}

constexpr int CONV_NT = 3 * 256 * 16, CONV_TP = 257, FILL_TILES_PER_WG = 8;
struct ConvTile { const float* src; bf16_t* WT; int pitch, K, k0, n0, mode, s; };
DI ConvTile conv_tile(const Params& P, int t) {
    const int kind = t / 4096, e = (t % 4096) >> 4, sub = t & 15;
    if (kind < 2) return ConvTile{(kind ? P.w_e_up : P.w_e_gate) + (size_t)e * 262144 + (size_t)(64 * sub) * 256, (bf16_t*)(P.ws + WS_WEGU) + (size_t)e * 524288, 256, 1024, 64 * sub, 0, 2, kind};
    return ConvTile{P.w_e_down + (size_t)e * 262144 + (size_t)(64 * (sub >> 2)) * 1024 + 256 * (sub & 3), (bf16_t*)(P.ws + WS_WED) + (size_t)e * 262144, 1024, 256, 64 * (sub >> 2), 256 * (sub & 3), 3, 0};
}
DI void conv_tile_load(const ConvTile& d, int wid, int lane, f32x4 (&w)[8]) {
#pragma unroll
    for (int i = 0; i < 8; ++i) w[i] = __builtin_nontemporal_load((const f32x4*)(d.src + (size_t)(8 * wid + i) * d.pitch + 4 * lane));
}
DI void conv_experts_block(const Params& P, char* lds, int t, const int NT, const int stride) {
    const int tid = opaque_tid(), lane = tid & 63, wid = tid >> 6;
    if (t >= NT) return;
    float* buf0 = (float*)lds; float* buf1 = buf0 + 64 * CONV_TP;
    ConvTile d = conv_tile(P, t); f32x4 w[8]; conv_tile_load(d, wid, lane, w);
    int par = 0;
    for (;;) {
        float* buf = par ? buf1 : buf0;
#pragma unroll
        for (int i = 0; i < 8; ++i) { float* p = buf + (8 * wid + i) * CONV_TP + 4 * lane; p[0] = w[i][0]; p[1] = w[i][1]; p[2] = w[i][2]; p[3] = w[i][3]; }
        const int tn = t + stride; const ConvTile dn = conv_tile(P, tn < NT ? tn : t);
        conv_tile_load(dn, wid, lane, w);
        __syncthreads();
        const int c = lane & 7;
#pragma unroll
        for (int it = 0; it < 4; ++it) {
            const int n = 8 * wid + (lane >> 3) + 64 * it; const float* sp = buf + (8 * c) * CONV_TP + n;
            const u32x4 o = (u32x4){pk2(sp[0], sp[CONV_TP]), pk2(sp[2 * CONV_TP], sp[3 * CONV_TP]), pk2(sp[4 * CONV_TP], sp[5 * CONV_TP]), pk2(sp[6 * CONV_TP], sp[7 * CONV_TP])};
            const int nn = d.n0 + n; const int drow = d.mode == 2 ? (256 * (nn >> 7) + 128 * d.s + (nn & 127)) : ((nn & ~255) + 128 * ((nn >> 3) & 1) + 32 * ((nn >> 6) & 3) + 8 * ((nn >> 4) & 3) + (nn & 7));
            *(u32x4*)(d.WT + (size_t)drow * d.K + d.k0 + 8 * c) = o;
        }
        t = tn; if (t >= NT) break;
        d = dn; par ^= 1;
    }
    __syncthreads();
}
DI int fill_blocks() { const int G = gridDim.x, rounds = (384 + G - 1) / G; return rounds * G - 384; }
DI void p1_inproj_and_experts(const Params& P, char* lds) {
    const bool conv_first = ((blockIdx.x >> 3) & 1) == 0;
    const int nb = fill_blocks(), fill = (nb > 0 && nb < (int)gridDim.x) ? nb * FILL_TILES_PER_WG : 0;
    if (conv_first) conv_experts_block(P, lds, blockIdx.x, CONV_NT - fill, gridDim.x);
    p1_inproj(P, lds);
    if (!conv_first) conv_experts_block(P, lds, blockIdx.x, CONV_NT - fill, gridDim.x);
}

DI int t5_bucket(int dist) {
    if (dist < 16) return dist;
    const float v = logf((float)dist / 16.0f) / 4.852030263919617f * 16.0f;
    int l = 16 + (int)v; return l < 31 ? l : 31;
}
struct VFrag { u32x2 r[8]; };
DI VFrag v_tr_read(unsigned addr) {
    VFrag f;
    asm volatile("ds_read_b64_tr_b16 %0, %8\n\tds_read_b64_tr_b16 %1, %8 offset:1152\n\tds_read_b64_tr_b16 %2, %8 offset:64\n\tds_read_b64_tr_b16 %3, %8 offset:1216\n\t"
                 "ds_read_b64_tr_b16 %4, %8 offset:2304\n\tds_read_b64_tr_b16 %5, %8 offset:3456\n\tds_read_b64_tr_b16 %6, %8 offset:2368\n\tds_read_b64_tr_b16 %7, %8 offset:3520\n\ts_waitcnt lgkmcnt(0)"
                 : "=&v"(f.r[0]), "=&v"(f.r[1]), "=&v"(f.r[2]), "=&v"(f.r[3]), "=&v"(f.r[4]), "=&v"(f.r[5]), "=&v"(f.r[6]), "=&v"(f.r[7]) : "v"(addr) : "memory");
    return f;
}
DI void attn_task_params(int task, int wid, int& d, int& r, int& lqb, int& p) {
    p = task >> 1; const int tk = wid + 8 * (task & 1);
    if (p == 0) { d = 1; r = 0; lqb = 32 * tk; } else if (p == 1) { d = 4; r = tk >> 2; lqb = 32 * (tk & 3); } else { d = 16; r = tk; lqb = 0; }
}
struct ATask { int d, r, lqb, p, cb, ce; };
DI ATask attn_task(int task, int wid, int t0) {
    ATask a; attn_task_params(task, wid, a.d, a.r, a.lqb, a.p);
    a.ce = a.p > 0 ? 4 : 5;
    const int base = t0 + a.r + a.d * (a.lqb - 97);
    const int cb = base >= 0 ? 0 : ((-base + 32 * a.d - 1) >> (5 + 2 * a.p));
    a.cb = cb < a.ce ? cb : a.ce;
    return a;
}
DI void attn_unit(const Params& P, char* lds, int unit) {
    int tid = threadIdx.x; asm volatile("" : "+v"(tid));
    const int lane = tid & 63, wid = __builtin_amdgcn_readfirstlane(tid >> 6), c = lane & 31, hh = lane >> 5;
    const int b = unit >> 7, qb = (unit >> 3) & 15, h = unit & 7, t0 = qb * 512;
    char* st = lds;
    float* bt = (float*)(lds + 512 * 136);
    bf16_t* ksw = (bf16_t*)(bt + 3 * 192) + wid * (64 * LDP);
    bf16_t* vsw = ksw + 32 * LDP;
    const unsigned vtr = (unsigned)(size_t)vsw + (unsigned)(((4 * hh + ((lane & 15) >> 2)) * LDP + 16 * ((lane >> 4) & 1) + 4 * (lane & 3)) * 2);
    const bf16_t* qkv = (const bf16_t*)(P.ws + WS_QKVU) + (size_t)(b * SEQ) * NPROJ;
    constexpr float LOG2E = 1.4426950408889634f;
    for (int i = tid; i < 3 * 192; i += NTHR) {
        const int p = i / 192, j = i % 192 - 32; const int dist = (j < 0 ? 0 : j) << (2 * p); float v = NEG;
        if (j >= (p ? 33 : 0) && j <= 128) {
            const int mult = (p == 0) ? 1 + ((j & 3) == 0) + ((j & 15) == 0) : (p == 1 ? 1 + ((j & 3) == 0) : 1);
            v = P.rel_bias[t5_bucket(dist) * 8 + h] * LOG2E + (mult == 1 ? 0.f : (mult == 2 ? 1.f : 1.5849625007211562f));
        }
        bt[i] = v;
    }
    __syncthreads();
    bf16x8 kfN[4], vvN[4], qfN[4];
    auto issue_kv = [&](const ATask& a, int ch) __attribute__((always_inline)) {
        const int tkv = t0 + a.r + a.d * (a.lqb - 128 + 32 * ch) + ((lane >> 3) << (2 * a.p));
#pragma unroll
        for (int i = 0; i < 4; ++i) {
            int tk = tkv + 8 * i * a.d; tk = tk < 0 ? 0 : tk;
            const bf16_t* rp = qkv + (size_t)(unsigned)tk * NPROJ + 512 + h * 64 + 8 * (lane & 7);
            kfN[i] = *(const bf16x8*)rp; vvN[i] = *(const bf16x8*)(rp + 512);
        }
    };
    auto issue_q = [&](const ATask& a) __attribute__((always_inline)) {
        const bf16_t* qrow = qkv + (size_t)(unsigned)(t0 + a.d * (a.lqb + c) + a.r) * NPROJ + h * 64 + 8 * hh;
#pragma unroll
        for (int s = 0; s < 4; ++s) qfN[s] = *(const bf16x8*)(qrow + 16 * s);
    };
    { const ATask a0 = attn_task(0, wid, t0); issue_q(a0); issue_kv(a0, a0.cb); }
#pragma unroll 1
    for (int task = 0; task < 6; ++task) {
        const ATask cur = attn_task(task, wid, t0);
        if (cur.cb < cur.ce) {
            ATask nxt = cur;
#pragma unroll 1
            for (int t2 = task + 1; t2 < 6; ++t2) { const ATask c2 = attn_task(t2, wid, t0); if (c2.cb < c2.ce) { nxt = c2; break; } }
            const int d = cur.d, r = cur.r, lqb = cur.lqb, p = cur.p;
            int qidx = d * (lqb + c) + r; qidx ^= (qidx >> 5) & 15;
            bf16x8 qf[4];
#pragma unroll
            for (int s = 0; s < 4; ++s) qf[s] = qfN[s];
            issue_q(nxt);
            float m = NEG, l = 0.f; f32x16 o0, o1;
#pragma unroll
            for (int i = 0; i < 16; ++i) { o0[i] = 0.f; o1[i] = 0.f; }
            if (p > 0) {
                const char* sp = st + qidx * 136; const f32x2 ml = *(const f32x2*)(sp + 128); m = ml[0]; l = hh ? 0.f : ml[1];
#pragma unroll
                for (int g = 0; g < 4; ++g) { const u32x2 a = *(const u32x2*)(sp + (8 * g + 4 * hh) * 2), bb = *(const u32x2*)(sp + (32 + 8 * g + 4 * hh) * 2);
                    o0[4 * g] = bflo(a[0]); o0[4 * g + 1] = bfhi(a[0]); o0[4 * g + 2] = bflo(a[1]); o0[4 * g + 3] = bfhi(a[1]); o1[4 * g] = bflo(bb[0]); o1[4 * g + 1] = bfhi(bb[0]); o1[4 * g + 2] = bflo(bb[1]); o1[4 * g + 3] = bfhi(bb[1]); }
            }
#pragma unroll 1
            for (int ch = cur.cb; ch < cur.ce; ++ch) {
                const float* btp = bt + p * 192 + 32 + c + 128 - 32 * ch - 4 * hh;
                LDS_FENCE();
#pragma unroll
                for (int i = 0; i < 4; ++i) { *(bf16x8*)(ksw + (8 * i + (lane >> 3)) * LDP + 8 * (lane & 7)) = kfN[i]; *(bf16x8*)(vsw + (8 * i + (lane >> 3)) * LDP + 8 * (lane & 7)) = vvN[i]; }
                { const bool last = ch + 1 == cur.ce; ATask a = cur; int chn = ch + 1; if (last) { a = nxt; chn = nxt.cb; } issue_kv(a, chn); }
                LDS_FENCE();
                const int lk0 = lqb - 128 + 32 * ch;
                bf16x8 kf[4];
#pragma unroll
                for (int s = 0; s < 4; ++s) kf[s] = *(const bf16x8*)(ksw + c * LDP + 16 * s + 8 * hh);
                f32x16 sa;
#pragma unroll
                for (int i = 0; i < 16; ++i) sa[i] = 0.f;
#pragma unroll
                for (int s = 0; s < 4; ++s) sa = MFMA32(kf[s], qf[s], sa);
                float sc[16]; float mx = NEG;
#pragma unroll
                for (int i = 0; i < 16; ++i) sc[i] = btp[-((i & 3) + 8 * (i >> 2))];
                asm volatile("" : "+v"(sc[0]), "+v"(sc[1]), "+v"(sc[2]), "+v"(sc[3]), "+v"(sc[4]), "+v"(sc[5]), "+v"(sc[6]), "+v"(sc[7]), "+v"(sc[8]), "+v"(sc[9]), "+v"(sc[10]), "+v"(sc[11]), "+v"(sc[12]), "+v"(sc[13]), "+v"(sc[14]), "+v"(sc[15]));
                if (t0 + d * lk0 + r >= 0) {
#pragma unroll
                    for (int i = 0; i < 16; ++i) { const float v = fmaf(sa[i], LOG2E, sc[i]); sc[i] = v; mx = fmaxf(mx, v); }
                } else {
#pragma unroll
                    for (int i = 0; i < 16; ++i) {
                        const int kr = (i & 3) + 8 * (i >> 2) + 4 * hh;
                        const float v = (t0 + d * (lk0 + kr) + r >= 0) ? fmaf(sa[i], LOG2E, sc[i]) : NEG; sc[i] = v; mx = fmaxf(mx, v);
                    }
                }
                mx = xmax32(mx);
                if (!__all(mx - m <= 8.f)) {
                    const float mn = fmaxf(m, mx), alpha = __builtin_amdgcn_exp2f(m - mn); m = mn; l *= alpha;
#pragma unroll
                    for (int i = 0; i < 16; ++i) { o0[i] *= alpha; o1[i] *= alpha; }
                }
                float ps = 0.f;
#pragma unroll
                for (int i = 0; i < 16; ++i) { sc[i] = __builtin_amdgcn_exp2f(sc[i] - m); ps += sc[i]; }
                l += ps;
                const VFrag vf = v_tr_read(vtr);
#pragma unroll
                for (int s = 0; s < 2; ++s) {
                    const u32x4 pw = (u32x4){pk2(sc[8 * s], sc[8 * s + 1]), pk2(sc[8 * s + 2], sc[8 * s + 3]), pk2(sc[8 * s + 4], sc[8 * s + 5]), pk2(sc[8 * s + 6], sc[8 * s + 7])};
                    const bf16x8 pf = __builtin_bit_cast(bf16x8, pw);
                    const u32x4 v0 = (u32x4){vf.r[4 * s][0], vf.r[4 * s][1], vf.r[4 * s + 1][0], vf.r[4 * s + 1][1]}, v1 = (u32x4){vf.r[4 * s + 2][0], vf.r[4 * s + 2][1], vf.r[4 * s + 3][0], vf.r[4 * s + 3][1]};
                    o0 = MFMA32(__builtin_bit_cast(bf16x8, v0), pf, o0); o1 = MFMA32(__builtin_bit_cast(bf16x8, v1), pf, o1);
                }
            }
            l = xsum32(l);
            char* sp = st + qidx * 136;
            if (hh == 0) *(f32x2*)(sp + 128) = (f32x2){m, l};
#pragma unroll
            for (int g = 0; g < 4; ++g) { *(u32x2*)(sp + (8 * g + 4 * hh) * 2) = (u32x2){pk2(o0[4 * g], o0[4 * g + 1]), pk2(o0[4 * g + 2], o0[4 * g + 3])}; *(u32x2*)(sp + (32 + 8 * g + 4 * hh) * 2) = (u32x2){pk2(o1[4 * g], o1[4 * g + 1]), pk2(o1[4 * g + 2], o1[4 * g + 3])}; }
        }
        if (task & 1) __syncthreads();
    }
    {
        const char* sp = st + (tid ^ ((tid >> 5) & 15)) * 136; const float inv = 1.f / *(const float*)(sp + 132);
        bf16_t* op = (bf16_t*)(P.ws + WS_MERGED) + (size_t)(b * SEQ + t0 + tid) * 1024 + h * 64; float ss = 0.f;
#pragma unroll
        for (int i = 0; i < 8; ++i) { const u32x2 wa = *(const u32x2*)(sp + 16 * i), wb = *(const u32x2*)(sp + 16 * i + 8); const unsigned w[4] = {wa[0], wa[1], wb[0], wb[1]}; float v[8];
#pragma unroll
            for (int j = 0; j < 4; ++j) { v[2 * j] = bflo(w[j]) * inv; v[2 * j + 1] = bfhi(w[j]) * inv; ss += v[2 * j] * v[2 * j] + v[2 * j + 1] * v[2 * j + 1]; }
            *(u32x4*)(op + 8 * i) = (u32x4){pk2(v[0], v[1]), pk2(v[2], v[3]), pk2(v[4], v[5]), pk2(v[6], v[7])}; }
        ((float*)(P.ws + WS_ATTSQ))[(size_t)(b * SEQ + t0 + tid) * 8 + h] = ss;
    }
    __syncthreads();
}

DI u32x2 tr_read1(unsigned addr) { u32x2 r; asm volatile("ds_read_b64_tr_b16 %0, %1\n\ts_waitcnt lgkmcnt(0)" : "=&v"(r) : "v"(addr) : "memory"); return r; }
struct STr16 { u32x2 r[16]; };
DI STr16 s_tr_read(unsigned addr) {
    STr16 f;
    asm volatile("ds_read_b64_tr_b16 %0, %16\n\tds_read_b64_tr_b16 %1, %16 offset:576\n\tds_read_b64_tr_b16 %2, %16 offset:4608\n\tds_read_b64_tr_b16 %3, %16 offset:5184\n\t"
                 "ds_read_b64_tr_b16 %4, %16 offset:9216\n\tds_read_b64_tr_b16 %5, %16 offset:9792\n\tds_read_b64_tr_b16 %6, %16 offset:13824\n\tds_read_b64_tr_b16 %7, %16 offset:14400\n\t"
                 "ds_read_b64_tr_b16 %8, %16 offset:32\n\tds_read_b64_tr_b16 %9, %16 offset:608\n\tds_read_b64_tr_b16 %10, %16 offset:4640\n\tds_read_b64_tr_b16 %11, %16 offset:5216\n\t"
                 "ds_read_b64_tr_b16 %12, %16 offset:9248\n\tds_read_b64_tr_b16 %13, %16 offset:9824\n\tds_read_b64_tr_b16 %14, %16 offset:13856\n\tds_read_b64_tr_b16 %15, %16 offset:14432\n\ts_waitcnt lgkmcnt(0)"
                 : "=&v"(f.r[0]), "=&v"(f.r[1]), "=&v"(f.r[2]), "=&v"(f.r[3]), "=&v"(f.r[4]), "=&v"(f.r[5]), "=&v"(f.r[6]), "=&v"(f.r[7]),
                   "=&v"(f.r[8]), "=&v"(f.r[9]), "=&v"(f.r[10]), "=&v"(f.r[11]), "=&v"(f.r[12]), "=&v"(f.r[13]), "=&v"(f.r[14]), "=&v"(f.r[15]) : "v"(addr) : "memory");
    return f;
}
struct SsmConst { float a_re, a_im; bf16x8 bq[4], cq[4]; f32x4 dsk; };
struct SsmU { bf16x8 ufa[4]; u32x2 uwa[4][2]; };
template <bool FINAL>
DI void ssm_load_const(const Params& P, int g, int lane, SsmConst& C) {
    const int c32 = lane & 31, hh = lane >> 5, fr = lane & 15, fq = lane >> 4;
    const float* ABAR = (const float*)(P.ws + WS_ABAR);
    C.a_re = ABAR[g * 128 + lane]; C.a_im = ABAR[g * 128 + 64 + lane];
#pragma unroll
    for (int tau = 0; tau < 4; ++tau) C.bq[tau] = *(const bf16x8*)((const bf16_t*)(P.ws + WS_BCAT) + (size_t)(g * 128 + 32 * tau + c32) * 16 + 8 * hh);
    C.dsk = (f32x4){0.f, 0.f, 0.f, 0.f};
    if (FINAL) {
#pragma unroll
        for (int s = 0; s < 4; ++s) C.cq[s] = *(const bf16x8*)((const bf16_t*)(P.ws + WS_CCAT) + (size_t)(g * 16 + fr) * 128 + 32 * s + 8 * fq);
        C.dsk = *(const f32x4*)(P.ssm_d + g * 16 + 4 * fq);
    }
}
template <bool FINAL>
DI void ssm_load_u(const Params& P, int b, int k, int g, int lane, SsmU& U) {
    const int c32 = lane & 31, hh = lane >> 5, fr = lane & 15, fq = lane >> 4;
    const bf16_t* ubase = (const bf16_t*)(P.ws + WS_QKVU) + (size_t)(b * SEQ + k * 128) * NPROJ + 1536 + 16 * g;
#pragma unroll
    for (int sub = 0; sub < 4; ++sub) {
        U.ufa[sub] = *(const bf16x8*)(ubase + (size_t)(32 * sub + c32) * NPROJ + 8 * hh);
        if (FINAL) { U.uwa[sub][0] = *(const u32x2*)(ubase + (size_t)(32 * sub + fr) * NPROJ + 4 * fq); U.uwa[sub][1] = *(const u32x2*)(ubase + (size_t)(32 * sub + 16 + fr) * NPROJ + 4 * fq); }
    }
}
template <bool FINAL>
DI void ssm_task(const Params& P, float* buf, int b, int k, int g, int lane, float s_re, float s_im, const SsmConst& C, const SsmU& U) {
    const int c32 = lane & 31, hh = lane >> 5, fr = lane & 15, fq = lane >> 4;
    const float a_re = C.a_re, a_im = C.a_im;
    const unsigned str = (unsigned)(size_t)buf + (unsigned)((8 * fq + ((lane & 15) >> 2)) * (SSM_PITCH * 4) + (lane & 3) * 8);
#pragma unroll
    for (int sub = 0; sub < 4; ++sub) {
        const bf16x8 uf = U.ufa[sub];
        f32x16 zr0, zr1, zi0, zi1;
#pragma unroll
        for (int i = 0; i < 16; ++i) { zr0[i] = 0.f; zr1[i] = 0.f; zi0[i] = 0.f; zi1[i] = 0.f; }
        zr0 = MFMA32(uf, C.bq[0], zr0); zr1 = MFMA32(uf, C.bq[1], zr1); zi0 = MFMA32(uf, C.bq[2], zi0); zi1 = MFMA32(uf, C.bq[3], zi1);
        float* rre = buf + lane * SSM_PITCH; float* rim = buf + (64 + lane) * SSM_PITCH;
#pragma unroll
        for (int gq = 0; gq < 4; ++gq) {
            float re8[8], im8[8];
#pragma unroll
            for (int j = 0; j < 4; ++j) {
                const auto tr = __builtin_amdgcn_permlane32_swap(__float_as_uint(zr0[4 * gq + j]), __float_as_uint(zr1[4 * gq + j]), false, false);
                const auto ti = __builtin_amdgcn_permlane32_swap(__float_as_uint(zi0[4 * gq + j]), __float_as_uint(zi1[4 * gq + j]), false, false);
                re8[j] = __uint_as_float(tr[0]); re8[4 + j] = __uint_as_float(tr[1]); im8[j] = __uint_as_float(ti[0]); im8[4 + j] = __uint_as_float(ti[1]);
            }
#pragma unroll
            for (int half = 0; half < 2; ++half) {
                const int tq = 2 * gq + half; float sr[4], si[4];
#pragma unroll
                for (int j = 0; j < 4; ++j) { const float nr = fmaf(a_re, s_re, fmaf(-a_im, s_im, re8[4 * half + j])), ni = fmaf(a_re, s_im, fmaf(a_im, s_re, im8[4 * half + j])); s_re = nr; s_im = ni; sr[j] = nr; si[j] = ni; }
                if (FINAL) { *(u32x2*)((bf16_t*)rre + 4 * tq) = (u32x2){pk2(sr[0], sr[1]), pk2(sr[2], sr[3])}; *(u32x2*)((bf16_t*)rim + 4 * tq) = (u32x2){pk2(si[0], si[1]), pk2(si[2], si[3])}; }
            }
        }
        if (FINAL) {
            LDS_FENCE();
            const STr16 sf = s_tr_read(str);
#pragma unroll
            for (int tt = 0; tt < 2; ++tt) {
                f32x4 y = (f32x4){0.f, 0.f, 0.f, 0.f};
#pragma unroll
                for (int s = 0; s < 4; ++s) { const u32x4 w = (u32x4){sf.r[8 * tt + 2 * s][0], sf.r[8 * tt + 2 * s][1], sf.r[8 * tt + 2 * s + 1][0], sf.r[8 * tt + 2 * s + 1][1]}; y = MFMA16(C.cq[s], __builtin_bit_cast(bf16x8, w), y); }
                const int tl = 32 * sub + 16 * tt + fr;
                const u32x2 uw = U.uwa[sub][tt];
                const float v0 = gelu_tanh(y[0] + C.dsk[0] * bflo(uw[0])), v1 = gelu_tanh(y[1] + C.dsk[1] * bfhi(uw[0])), v2 = gelu_tanh(y[2] + C.dsk[2] * bflo(uw[1])), v3 = gelu_tanh(y[3] + C.dsk[3] * bfhi(uw[1]));
                *(u32x2*)((bf16_t*)(P.ws + WS_YGL) + (size_t)(b * SEQ + k * 128 + tl) * 512 + 16 * g + 4 * fq) = (u32x2){pk2(v0, v1), pk2(v2, v3)};
            }
        }
    }
    if (!FINAL) { float* E = (float*)(P.ws + WS_E) + (size_t)((b * 64 + k) * 32 + g) * 128; E[lane] = s_re; E[64 + lane] = s_im; }
    LDS_FENCE();
}

DI void p2_mixer(const Params& P, char* lds) {
    const int tid = opaque_tid(), lane = tid & 63, wid = tid >> 6, G = gridDim.x;
    for (int item = blockIdx.x; item < 512; item += G) attn_unit(P, lds, item < 256 ? item : (item ^ (15 << 3)));
    float* buf = (float*)(lds + wid * SSM_WAVE_LDS);
    int wt = blockIdx.x * 8 + wid;
    if (wt < 8192) {
        const int g = wt & 31; SsmConst C; ssm_load_const<false>(P, g, lane, C);
        SsmU U; ssm_load_u<false>(P, wt >> 11, (wt >> 5) & 63, g, lane, U);
#pragma unroll 1
        for (; wt < 8192; wt += G * 8) {
            const int wn = wt + G * 8 < 8192 ? wt + G * 8 : wt; SsmU Un; ssm_load_u<false>(P, wn >> 11, (wn >> 5) & 63, wn & 31, lane, Un);
            if ((G * 8) & 31) ssm_load_const<false>(P, wt & 31, lane, C);
            ssm_task<false>(P, buf, wt >> 11, (wt >> 5) & 63, wt & 31, lane, 0.f, 0.f, C, U);
            U = Un;
        }
    }
}

DI void route_token(const float* srow, const float* rbias, int lane, int& e_out, float& g_out) {
    const f32x4 s4 = *(const f32x4*)(srow + 4 * lane); const f32x4 rb = *(const f32x4*)(rbias + 4 * lane);
    float w0 = s4[0] + rb[0], w1 = s4[1] + rb[1], w2 = s4[2] + rb[2], w3 = s4[3] + rb[3];
    float m1, m2;
    { const float a = fmaxf(w0, w1), bb = fminf(w0, w1), cc = fmaxf(w2, w3), dd = fminf(w2, w3); m1 = fmaxf(a, cc); m2 = fmaxf(fminf(a, cc), fmaxf(bb, dd)); }
#define ROUTE_MERGE2(CTRL) { const float o1 = dppf<CTRL>(m1), o2 = dppf<CTRL>(m2); const float n1 = fmaxf(m1, o1), n2 = fmaxf(fminf(m1, o1), fmaxf(m2, o2)); m1 = n1; m2 = n2; }
    ROUTE_MERGE2(DPP_X1) ROUTE_MERGE2(DPP_X2) ROUTE_MERGE2(DPP_HM)
#undef ROUTE_MERGE2
    const float gs = m1 + m2; const int mygrp = lane >> 3; int rank = 0;
#pragma unroll
    for (int j = 0; j < 8; ++j) { const float gj = rdlane(gs, 8 * j); rank += ((gj > gs) || (gj == gs && j < mygrp)) ? 1 : 0; }
    const float NINF = -__builtin_inff();
    if (rank >= 4) { w0 = NINF; w1 = NINF; w2 = NINF; w3 = NINF; }
    int my_e = 0; float my_s = 0.f;
#pragma unroll 1
    for (int k = 0; k < TOPK; ++k) {
        float bv = w0; int bi = 0;
        if (w1 > bv) { bv = w1; bi = 1; } if (w2 > bv) { bv = w2; bi = 2; } if (w3 > bv) { bv = w3; bi = 3; }
        float rm = bv; rm = fmaxf(rm, dppf<DPP_X1>(rm)); rm = fmaxf(rm, dppf<DPP_X2>(rm)); rm = fmaxf(rm, dppf<DPP_HM>(rm)); rm = fmaxf(rm, dppf<DPP_RM>(rm));
        const float wmax = fmaxf(fmaxf(rdlane(rm, 0), rdlane(rm, 16)), fmaxf(rdlane(rm, 32), rdlane(rm, 48)));
        const unsigned long long bal = __ballot(bv == wmax);
        const int owner = __builtin_amdgcn_readfirstlane((int)__ffsll((long long)bal) - 1);
        const int sub = __builtin_amdgcn_readlane(bi, owner), idx = 4 * owner + sub;
        const float mys = bi == 0 ? s4[0] : (bi == 1 ? s4[1] : (bi == 2 ? s4[2] : s4[3]));
        const float sval = rdlane(mys, owner);
        if (lane == owner) { if (sub == 0) w0 = NINF; else if (sub == 1) w1 = NINF; else if (sub == 2) w2 = NINF; else w3 = NINF; }
        if (lane == k) { my_e = idx; my_s = sval; }
    }
    float sum = (lane < 8) ? my_s : 0.f;
    sum += dppf<DPP_X1>(sum); sum += dppf<DPP_X2>(sum); sum += dppf<DPP_HM>(sum);
    e_out = my_e; g_out = my_s / sum * 2.5f;
}

DI void p3a_ssm(const Params& P, char* lds) {
    const int tid = opaque_tid(), lane = tid & 63, wid = tid >> 6;
    float* buf = (float*)(lds + wid * SSM_WAVE_LDS);
    const float* ABARL = (const float*)(P.ws + WS_ABARL); const float* E = (const float*)(P.ws + WS_E);
    int wt = blockIdx.x * 8 + wid;
    if (wt >= 8192) return;
    SsmConst C; ssm_load_const<true>(P, wt & 31, lane, C);
    SsmU U; { const int kk = (wt >> 5) & 63, b = wt >> 11; ssm_load_u<true>(P, b, (b & 1) ? 63 - kk : kk, wt & 31, lane, U); }
#pragma unroll 1
    for (; wt < 8192; wt += gridDim.x * 8) {
        const int g = wt & 31, kk = (wt >> 5) & 63, b = wt >> 11, k = (b & 1) ? 63 - kk : kk;
        SsmU Un; { const int wn = wt + (int)gridDim.x * 8 < 8192 ? wt + (int)gridDim.x * 8 : wt; const int kn = (wn >> 5) & 63, bn = wn >> 11; ssm_load_u<true>(P, bn, (bn & 1) ? 63 - kn : kn, wn & 31, lane, Un); }
        const float lr = ABARL[g * 128 + lane], li = ABARL[g * 128 + 64 + lane];
        float cr = 0.f, ci = 0.f; float er[8], ei[8], fr[8], fi[8];
        const float* eb = E + (size_t)(b * 64 * 32 + g) * 128 + lane;
#define SSM_CARRY_LOAD(R, I, K0) { _Pragma("unroll") for (int j = 0; j < 8; ++j) { const int kj = (K0) + j; const float* ep = eb + (size_t)(kj < 63 ? kj : 63) * (32 * 128); R[j] = ep[0]; I[j] = ep[64]; } }
#define SSM_CARRY_STEP(R, I, K0) { _Pragma("unroll") for (int j = 0; j < 8; ++j) { const bool ok = (K0) + j < k; const float nr = fmaf(lr, cr, fmaf(-li, ci, R[j])), ni = fmaf(lr, ci, fmaf(li, cr, I[j])); cr = ok ? nr : cr; ci = ok ? ni : ci; } }
        SSM_CARRY_LOAD(er, ei, 0)
#pragma unroll 1
        for (int k0 = 0; k0 < k; k0 += 16) {
            SSM_CARRY_LOAD(fr, fi, k0 + 8)
            SSM_CARRY_STEP(er, ei, k0)
            SSM_CARRY_LOAD(er, ei, k0 + 16)
            SSM_CARRY_STEP(fr, fi, k0 + 8)
        }
#undef SSM_CARRY_LOAD
#undef SSM_CARRY_STEP
        if ((gridDim.x * 8) & 31) ssm_load_const<true>(P, g, lane, C);
        ssm_task<true>(P, buf, b, k, g, lane, cr, ci, C, U);
        U = Un;
    }
}
struct EpiGluE {
    static constexpr bool MID = false, PREP = false;
    const bf16_t* ygl; bf16_t* merged; const float* bglu; float* ssq;
    DI void operator()(const f32x4 (&acc)[2][2][4][2], const pg8::Unit& u, int wr, int wc, int fr, int fq) const {
        f32x4 bv[2][2];
#pragma unroll
        for (int bj = 0; bj < 2; ++bj)
#pragma unroll
            for (int n = 0; n < 2; ++n) bv[bj][n] = *(const f32x4*)(bglu + 256 * u.pn + 128 * bj + 32 * wc + 8 * fq + 4 * n);
#pragma unroll
        for (int ai = 0; ai < 2; ++ai)
#pragma unroll
            for (int m = 0; m < 4; ++m) {
                const size_t row = (size_t)256 * u.pm + 128 * ai + 64 * wr + 16 * m + fr; float ss = 0.f;
#pragma unroll
                for (int bj = 0; bj < 2; ++bj) {
                    const int col = 256 * u.pn + 128 * bj + 32 * wc + 8 * fq; const u32x4 yw = *(const u32x4*)(ygl + row * 512 + col);
                    const f32x4 z0 = acc[ai][bj][m][0] + bv[bj][0], z1 = acc[ai][bj][m][1] + bv[bj][1];
                    const float o0 = bflo(yw[0]) * sigmoidf_(z0[0]), o1 = bfhi(yw[0]) * sigmoidf_(z0[1]), o2 = bflo(yw[1]) * sigmoidf_(z0[2]), o3 = bfhi(yw[1]) * sigmoidf_(z0[3]);
                    const float o4 = bflo(yw[2]) * sigmoidf_(z1[0]), o5 = bfhi(yw[2]) * sigmoidf_(z1[1]), o6 = bflo(yw[3]) * sigmoidf_(z1[2]), o7 = bfhi(yw[3]) * sigmoidf_(z1[3]);
                    ss += (o0 * o0 + o1 * o1) + (o2 * o2 + o3 * o3) + (o4 * o4 + o5 * o5) + (o6 * o6 + o7 * o7);
                    *(u32x4*)(merged + row * 1024 + 512 + col) = (u32x4){pk2(o0, o1), pk2(o2, o3), pk2(o4, o5), pk2(o6, o7)};
                }
                ss = xsum16(ss); ss = xsum32(ss);
                if (fq == 0) ssq[row * 8 + u.pn * 4 + wc] = ss;
                asm volatile("" ::: "memory");
            }
    }
};
DI void p3b_glu(const Params& P, char* lds) {
    pg8::DenseOrder S; S.init(P.ws + WS_YGL, P.ws + WS_WGLU, T, 512, 512, gridDim.x, blockIdx.x);
    EpiGluE E{(const bf16_t*)(P.ws + WS_YGL), (bf16_t*)(P.ws + WS_MERGED), P.b_glu, (float*)(P.ws + WS_SSQ)};
    pg8::gemm_phase<EpiGluE, pg8::DenseOrder, false>((LAS unsigned char*)lds, 512, S, E);
}
struct EpiResidE {
    static constexpr bool MID = false, PREP = false;
    bf16_t* io; const float* ada; int goff;
    DI void operator()(const f32x4 (&acc)[2][2][4][2], const pg8::Unit& u, int wr, int wc, int fr, int fq) const {
        const float* gate = ada + ((256 * u.pm) >> 13) * 6144 + goff + 256 * u.pn + 32 * wc + 8 * fq;
        f32x4 gv[2][2];
#pragma unroll
        for (int bj = 0; bj < 2; ++bj)
#pragma unroll
            for (int n = 0; n < 2; ++n) gv[bj][n] = *(const f32x4*)(gate + 128 * bj + 4 * n);
#pragma unroll
        for (int ai = 0; ai < 2; ++ai)
#pragma unroll
            for (int m = 0; m < 4; ++m) {
                bf16_t* p = io + ((size_t)256 * u.pm + 128 * ai + 64 * wr + 16 * m + fr) * 1024 + 256 * u.pn + 32 * wc + 8 * fq; u32x4 xw[2];
#pragma unroll
                for (int bj = 0; bj < 2; ++bj) xw[bj] = *(const u32x4*)(p + 128 * bj);
#pragma unroll
                for (int bj = 0; bj < 2; ++bj) {
                    const f32x4 a0 = acc[ai][bj][m][0] * gv[bj][0], a1 = acc[ai][bj][m][1] * gv[bj][1]; const u32x4 w = xw[bj];
                    *(u32x4*)(p + 128 * bj) = (u32x4){pk2(ALPHA * bflo(w[0]) + a0[0], ALPHA * bfhi(w[0]) + a0[1]), pk2(ALPHA * bflo(w[1]) + a0[2], ALPHA * bfhi(w[1]) + a0[3]),
                                                      pk2(ALPHA * bflo(w[2]) + a1[0], ALPHA * bfhi(w[2]) + a1[1]), pk2(ALPHA * bflo(w[3]) + a1[2], ALPHA * bfhi(w[3]) + a1[3])};
                }
                asm volatile("" ::: "memory");
            }
    }
};
struct EpiOutProjE {
    static constexpr bool MID = true, PREP = true;
    const float* x; bf16_t* out; const float* ada; const float* attsq; const float* ssq; LAS float* tab;
    DI void prep(const pg8::Unit& u, int tid) const {
        if (tid < 256) {
            const size_t row = (size_t)256 * u.pm + tid;
            const f32x4 p0 = *(const f32x4*)(attsq + row * 8), p1 = *(const f32x4*)(attsq + row * 8 + 4), q0 = *(const f32x4*)(ssq + row * 8), q1 = *(const f32x4*)(ssq + row * 8 + 4);
            const float ra = rsqrtf((((p0[0] + p0[1]) + (p0[2] + p0[3])) + ((p1[0] + p1[1]) + (p1[2] + p1[3]))) * (1.f / 512.f) + EPS);
            const float rs = rsqrtf((((q0[0] + q0[1]) + (q0[2] + q0[3])) + ((q1[0] + q1[1]) + (q1[2] + q1[3]))) * (1.f / 512.f) + EPS);
            *(LAS f32x2*)(tab + (u.aux * 256 + tid) * 2) = (f32x2){ra, rs};
        }
    }
    DI void mid(f32x4 (&acc)[2][2][4][2], const pg8::Unit& u, int wr, int wc, int fr, int fq) const {
#pragma unroll
        for (int ai = 0; ai < 2; ++ai)
#pragma unroll
            for (int m = 0; m < 4; ++m) {
                const f32x2 r2 = *(const LAS f32x2*)(tab + (u.aux * 256 + 128 * ai + 64 * wr + 16 * m + fr) * 2); const float f = r2[0] * __builtin_amdgcn_rcpf(r2[1]);
#pragma unroll
                for (int bj = 0; bj < 2; ++bj)
#pragma unroll
                    for (int n = 0; n < 2; ++n) acc[ai][bj][m][n] *= f;
            }
    }
    DI void operator()(const f32x4 (&acc)[2][2][4][2], const pg8::Unit& u, int wr, int wc, int fr, int fq) const {
        const float* gate = ada + ((256 * u.pm) >> 13) * 6144 + 2048 + 256 * u.pn + 32 * wc + 8 * fq;
        f32x4 gv[2][2];
#pragma unroll
        for (int bj = 0; bj < 2; ++bj)
#pragma unroll
            for (int n = 0; n < 2; ++n) gv[bj][n] = *(const f32x4*)(gate + 128 * bj + 4 * n);
#pragma unroll
        for (int ai = 0; ai < 2; ++ai)
#pragma unroll
            for (int m = 0; m < 4; ++m) {
                const int rl = 128 * ai + 64 * wr + 16 * m + fr; const size_t row = (size_t)256 * u.pm + rl; const size_t o = row * 1024 + 256 * u.pn + 32 * wc + 8 * fq; f32x4 xv[2][2];
                const float r_s = tab[(u.aux * 256 + rl) * 2 + 1];
#pragma unroll
                for (int bj = 0; bj < 2; ++bj)
#pragma unroll
                    for (int n = 0; n < 2; ++n) xv[bj][n] = *(const f32x4*)(x + o + 128 * bj + 4 * n);
#pragma unroll
                for (int bj = 0; bj < 2; ++bj) {
                    const f32x4 v0 = ALPHA * xv[bj][0] + (gv[bj][0] * r_s) * acc[ai][bj][m][0], v1 = ALPHA * xv[bj][1] + (gv[bj][1] * r_s) * acc[ai][bj][m][1];
                    *(u32x4*)(out + o + 128 * bj) = (u32x4){pk2(v0[0], v0[1]), pk2(v0[2], v0[3]), pk2(v1[0], v1[1]), pk2(v1[2], v1[3])};
                }
                asm volatile("" ::: "memory");
            }
    }
};
DI void p3d_outproj(const Params& P, char* lds) {
    pg8::DenseOrder S; S.init(P.ws + WS_MERGED, P.ws + WS_WOUT, T, 1024, 1024, gridDim.x, blockIdx.x);
    EpiOutProjE E{P.x, (bf16_t*)(P.ws + WS_XZ), (const float*)(P.ws + WS_ADA), (const float*)(P.ws + WS_ATTSQ), (const float*)(P.ws + WS_SSQ), (LAS float*)((LAS unsigned char*)lds + P5TAB_OFF)};
    pg8::gemm_phase<EpiOutProjE, pg8::DenseOrder, false>((LAS unsigned char*)lds, 1024, S, E);
}
DI void p3e_ln1(const Params& P) {
    const int tid = opaque_tid(), lane = tid & 63, wid = tid >> 6;
    bf16_t* H2 = (bf16_t*)(P.ws + WS_H2); bf16_t* XZ = (bf16_t*)(P.ws + WS_XZ);
    for (int row = blockIdx.x * 8 + wid; row < T; row += gridDim.x * 8) {
        const float* ADA = (const float*)(P.ws + WS_ADA) + (row >> 13) * 6144;
        bf16_t* vp = XZ + (size_t)row * 1024 + 8 * lane; float v[16]; float s = 0.f;
#pragma unroll
        for (int j = 0; j < 2; ++j) { const u32x4 w = *(const u32x4*)(vp + 512 * j);
#pragma unroll
            for (int i = 0; i < 4; ++i) { v[8 * j + 2 * i] = bflo(w[i]); v[8 * j + 2 * i + 1] = bfhi(w[i]); s += v[8 * j + 2 * i] + v[8 * j + 2 * i + 1]; } }
        const float mean = wave_sum(s) * (1.f / 1024.f); float q = 0.f;
#pragma unroll
        for (int i = 0; i < 16; ++i) { v[i] -= mean; q += v[i] * v[i]; }
        const float rstd = rsqrtf(wave_sum(q) * (1.f / 1024.f) + EPS);
#pragma unroll
        for (int j = 0; j < 2; ++j) {
            const int col = 8 * lane + 512 * j; float x1[8], hv[8];
#pragma unroll
            for (int i = 0; i < 2; ++i) {
                const f32x4 g = *(const f32x4*)(P.ln1_g + col + 4 * i), bb = *(const f32x4*)(P.ln1_b + col + 4 * i), sc2 = *(const f32x4*)(ADA + 4096 + col + 4 * i), sh2 = *(const f32x4*)(ADA + 3072 + col + 4 * i);
#pragma unroll
                for (int t = 0; t < 4; ++t) { x1[4 * i + t] = v[8 * j + 4 * i + t] * rstd * g[t] + bb[t]; hv[4 * i + t] = x1[4 * i + t] * (1.f + sc2[t]) + sh2[t]; }
            }
            *(u32x4*)(vp + 512 * j) = (u32x4){pk2(x1[0], x1[1]), pk2(x1[2], x1[3]), pk2(x1[4], x1[5]), pk2(x1[6], x1[7])};
            *(u32x4*)(H2 + (size_t)row * 1024 + col) = (u32x4){pk2(hv[0], hv[1]), pk2(hv[2], hv[3]), pk2(hv[4], hv[5]), pk2(hv[6], hv[7])};
        }
    }
}
struct EpiRouterSharedE {
    static constexpr bool MID = false, PREP = false;
    float* sc; bf16_t* hids;
    DI void operator()(const f32x4 (&acc)[2][2][4][2], const pg8::Unit& u, int wr, int wc, int fr, int fq) const {
#pragma unroll
        for (int ai = 0; ai < 2; ++ai)
#pragma unroll
            for (int m = 0; m < 4; ++m) {
                const size_t row = (size_t)256 * u.pm + 128 * ai + 64 * wr + 16 * m + fr;
                if (u.pn == 0) {
#pragma unroll
                    for (int bj = 0; bj < 2; ++bj)
#pragma unroll
                        for (int n = 0; n < 2; ++n) { const f32x4 v = acc[ai][bj][m][n]; *(f32x4*)(sc + row * 256 + 128 * bj + 32 * wc + 8 * fq + 4 * n) = (f32x4){sigmoidf_(v[0]), sigmoidf_(v[1]), sigmoidf_(v[2]), sigmoidf_(v[3])}; }
                } else {
                    const f32x4 g0 = acc[ai][0][m][0], g1 = acc[ai][0][m][1], u0 = acc[ai][1][m][0], u1 = acc[ai][1][m][1];
                    *(u32x4*)(hids + row * 256 + 128 * (u.pn - 1) + 32 * wc + 8 * fq) = (u32x4){pk2(siluf_(g0[0]) * u0[0], siluf_(g0[1]) * u0[1]), pk2(siluf_(g0[2]) * u0[2], siluf_(g0[3]) * u0[3]),
                                                                                                 pk2(siluf_(g1[0]) * u1[0], siluf_(g1[1]) * u1[1]), pk2(siluf_(g1[2]) * u1[2], siluf_(g1[3]) * u1[3])};
                }
                asm volatile("" ::: "memory");
            }
    }
};
DI void p3f_router_shared(const Params& P, char* lds) {
    pg8::DenseOrder S; S.init(P.ws + WS_H2, P.ws + WS_WR, T, 768, 1024, gridDim.x, blockIdx.x);
    EpiRouterSharedE E{(float*)(P.ws + WS_SCORES), (bf16_t*)(P.ws + WS_HIDS)};
    pg8::gemm_phase<EpiRouterSharedE, pg8::DenseOrder, false>((LAS unsigned char*)lds, 1024, S, E);
    const int nb = fill_blocks(), G = gridDim.x;
    if (nb > 0 && nb < G && (int)blockIdx.x >= G - nb) conv_experts_block(P, lds, CONV_NT - nb * FILL_TILES_PER_WG + ((int)blockIdx.x - (G - nb)), CONV_NT, nb);
}
DI void p3g_route_shared_down(const Params& P, char* lds) {
    const int tid = opaque_tid(), lane = tid & 63, wid = tid >> 6;
    int* hist = (int*)(lds + P5TAB_OFF); int* base = hist + 256; int* hist2 = base + 256; int* rt_e = hist2 + 256; float* rt_g = (float*)(rt_e + 1024);
    for (int pm = blockIdx.x; pm < 256; pm += gridDim.x) {
        const int row0 = pm * 128; const float* SC = (const float*)(P.ws + WS_SCORES) + (size_t)row0 * 256;
        __syncthreads();
        if (tid < 256) hist[tid] = 0;
        __syncthreads();
        for (int tl = wid * 16; tl < wid * 16 + 16; ++tl) {
            int e; float gte; route_token(SC + (size_t)tl * 256, P.router_bias, lane, e, gte);
            if (lane < 8) { rt_e[tl * 8 + lane] = e; rt_g[tl * 8 + lane] = gte; atomicAdd(&hist[e], 1); }
        }
        __syncthreads();
        if (tid < 256) { const int cnt = hist[tid]; base[tid] = cnt ? atomicAdd((int*)(P.ws + WS_CNT) + tid, cnt) : 0; hist2[tid] = 0; }
        __syncthreads();
        for (int a = tid; a < 1024; a += NTHR) {
            const int e = rt_e[a]; const int pos = base[e] + atomicAdd(&hist2[e], 1); const int slot = (row0 + (a >> 3)) * 8 + (a & 7);
            ((int*)(P.ws + WS_BINS))[(size_t)e * T + pos] = slot; ((float*)(P.ws + WS_BING))[(size_t)e * T + pos] = rt_g[a]; ((int*)(P.ws + WS_EIDX))[slot] = e; ((int*)(P.ws + WS_EPOS))[slot] = pos;
        }
    }
    __syncthreads();
    pg8::DenseOrder S; S.init(P.ws + WS_HIDS, P.ws + WS_WSD, T, 1024, 256, gridDim.x, blockIdx.x);
    EpiResidE E{(bf16_t*)(P.ws + WS_XZ), (const float*)(P.ws + WS_ADA), 5120};
    pg8::gemm_phase<EpiResidE, pg8::DenseOrder, false>((LAS unsigned char*)lds, 256, S, E);
}

DI void moe_tables(const Params& P, char* lds) {
    LAS int* tstart = (LAS int*)((LAS unsigned char*)lds + P5TAB_OFF); LAS int* estart = tstart + 260;
    const int tid = opaque_tid();
    if (tid < 64) {
        const int* gc = (const int*)(P.ws + WS_CNT) + 4 * tid; const int c0 = gc[0], c1 = gc[1], c2 = gc[2], c3 = gc[3];
        const int t0 = (c0 + 255) >> 8, t1 = (c1 + 255) >> 8, t2 = (c2 + 255) >> 8, t3 = (c3 + 255) >> 8;
        int cs = c0 + c1 + c2 + c3, ts = t0 + t1 + t2 + t3; const int cown = cs, town = ts;
#pragma unroll
        for (int o = 1; o < 64; o <<= 1) { const int a = __shfl_up(cs, o), b = __shfl_up(ts, o); if (tid >= o) { cs += a; ts += b; } }
        int ce = cs - cown, te = ts - town;
        estart[4 * tid] = ce; tstart[4 * tid] = te; ce += c0; te += t0; estart[4 * tid + 1] = ce; tstart[4 * tid + 1] = te; ce += c1; te += t1;
        estart[4 * tid + 2] = ce; tstart[4 * tid + 2] = te; ce += c2; te += t2; estart[4 * tid + 3] = ce; tstart[4 * tid + 3] = te;
        if (tid == 63) { estart[256] = cs; tstart[256] = ts; }
    }
    __syncthreads();
}
struct MoeOrder {
    static constexpr bool RAGGED = true;
    const LAS int* tstart; const LAS int* estart; const char* Abase; const char* Bbase; const int* bins; int nunits, per, G, vb, mode;
    DI bool next(int i, pg8::Unit& u) const {
        const long L = (long)i * G + vb; if (L >= (long)nunits) return false;
        const int tile = (int)(L / per), sub = (int)(L % per);
        int lo = 0, hi = NEXP;
        while (hi - lo > 1) { const int mid = (lo + hi) >> 1; if (tstart[mid] <= tile) lo = mid; else hi = mid; }
        const int e = lo, rb = tile - tstart[e], cnt = estart[e + 1] - estart[e];
        u.rows = (cnt - 256 * rb) < 256 ? (cnt - 256 * rb) : 256; u.pm = estart[e] + 256 * rb; u.pn = sub; u.aux = e * T + 256 * rb;
        if (mode == 0) { u.A = Abase; u.B = Bbase + ((size_t)e * 512 + 256 * sub) * 2048; }
        else { u.A = Abase + (size_t)u.pm * 512; u.B = Bbase + ((size_t)e * 1024 + 256 * sub) * 512; }
        return true;
    }
    DI unsigned row_off(const pg8::Unit& u, int r) const { const int v = bins[u.aux + (r < u.rows ? r : u.rows - 1)]; return (unsigned)(v >> 3) * 2048u; }
};
struct EpiGateUp {
    static constexpr bool MID = false, PREP = false;
    bf16_t* H; const float* bing;
    DI void operator()(const f32x4 (&acc)[2][2][4][2], const pg8::Unit& u, int wr, int wc, int fr, int fq) const {
        float gt[2][4];
#pragma unroll
        for (int ai = 0; ai < 2; ++ai)
#pragma unroll
            for (int m = 0; m < 4; ++m) { const int r = 128 * ai + 64 * wr + 16 * m + fr; gt[ai][m] = bing[u.aux + (r < u.rows ? r : u.rows - 1)]; }
#pragma unroll
        for (int ai = 0; ai < 2; ++ai)
#pragma unroll
            for (int m = 0; m < 4; ++m) {
                const int r = 128 * ai + 64 * wr + 16 * m + fr; const float g = gt[ai][m];
                const f32x4 g0 = acc[ai][0][m][0], g1 = acc[ai][0][m][1], u0 = acc[ai][1][m][0], u1 = acc[ai][1][m][1];
                const u32x4 w = (u32x4){pk2(siluf_(g0[0]) * u0[0] * g, siluf_(g0[1]) * u0[1] * g), pk2(siluf_(g0[2]) * u0[2] * g, siluf_(g0[3]) * u0[3] * g),
                                        pk2(siluf_(g1[0]) * u1[0] * g, siluf_(g1[1]) * u1[1] * g), pk2(siluf_(g1[2]) * u1[2] * g, siluf_(g1[3]) * u1[3] * g)};
                if (r < u.rows) *(u32x4*)(H + (size_t)(u.pm + r) * 256 + 128 * u.pn + 32 * wc + 8 * fq) = w;
                asm volatile("" ::: "memory");
            }
    }
};
struct EpiDown {
    static constexpr bool MID = false, PREP = false;
    unsigned char* OA; unsigned char* OB;
    DI void operator()(const f32x4 (&acc)[2][2][4][2], const pg8::Unit& u, int wr, int wc, int fr, int fq) const {
#pragma unroll
        for (int ai = 0; ai < 2; ++ai)
#pragma unroll
            for (int m = 0; m < 4; ++m) {
                const int r = 128 * ai + 64 * wr + 16 * m + fr;
                if (r < u.rows) {
                    const int pos = u.pm + r; unsigned char* rowp = (pos < T * 4 ? OA + (size_t)pos * 1024 : OB + (size_t)(pos - T * 4) * 1024) + 256 * u.pn + 64 * wc + 16 * fq;
                    int pk[4];
#pragma unroll
                    for (int bj = 0; bj < 2; ++bj) {
                        f32x4 v0 = acc[ai][bj][m][0] * OUT_SCALE, v1 = acc[ai][bj][m][1] * OUT_SCALE;
#pragma unroll
                        for (int i = 0; i < 4; ++i) { v0[i] = fminf(fmaxf(v0[i], -448.f), 448.f); v1[i] = fminf(fmaxf(v1[i], -448.f), 448.f); }
                        int lo = 0, hi = 0;
                        lo = __builtin_amdgcn_cvt_pk_fp8_f32(v0[0], v0[1], lo, false); lo = __builtin_amdgcn_cvt_pk_fp8_f32(v0[2], v0[3], lo, true);
                        hi = __builtin_amdgcn_cvt_pk_fp8_f32(v1[0], v1[1], hi, false); hi = __builtin_amdgcn_cvt_pk_fp8_f32(v1[2], v1[3], hi, true);
                        pk[2 * bj] = lo; pk[2 * bj + 1] = hi;
                    }
                    *(u32x4*)rowp = (u32x4){(unsigned)pk[0], (unsigned)pk[1], (unsigned)pk[2], (unsigned)pk[3]};
                }
                asm volatile("" ::: "memory");
            }
    }
};
DI int xcd_vb() { const int G = gridDim.x; return (G % 8 == 0) ? (int)(blockIdx.x % 8) * (G / 8) + (int)(blockIdx.x / 8) : (int)blockIdx.x; }
DI void p5a_gateup(const Params& P, char* lds) {
    moe_tables(P, lds);
    const LAS int* tstart = (const LAS int*)((LAS unsigned char*)lds + P5TAB_OFF);
    MoeOrder S{tstart, tstart + 260, (const char*)(P.ws + WS_H2), (const char*)(P.ws + WS_WEGU), (const int*)(P.ws + WS_BINS), tstart[256] * 2, 2, (int)gridDim.x, xcd_vb(), 0};
    EpiGateUp E{(bf16_t*)(P.ws + WS_HIDALL), (const float*)(P.ws + WS_BING)};
    pg8::gemm_phase<EpiGateUp, MoeOrder, true>((LAS unsigned char*)lds, 1024, S, E);
}
DI void p5b_down(const Params& P, char* lds) {
    const LAS int* tstart = (const LAS int*)((LAS unsigned char*)lds + P5TAB_OFF);
    MoeOrder S{tstart, tstart + 260, (const char*)(P.ws + WS_HIDALL), (const char*)(P.ws + WS_WED), (const int*)(P.ws + WS_BINS), tstart[256] * 4, 4, (int)gridDim.x, xcd_vb(), 1};
    EpiDown E{P.ws + WS_OUTA, P.ws + WS_OUTB};
    pg8::gemm_phase<EpiDown, MoeOrder, false>((LAS unsigned char*)lds, 256, S, E);
}

DI void p6_combine(const Params& P, char* lds) {
    const LAS int* estart = (const LAS int*)((LAS unsigned char*)lds + P5TAB_OFF) + 260;
    const int tid = opaque_tid(), lane = tid & 63, wid = tid >> 6;
    const unsigned char* OA = P.ws + WS_OUTA; const unsigned char* OB = P.ws + WS_OUTB;
    for (int row = blockIdx.x * 8 + wid; row < T; row += gridDim.x * 8) {
        const float* ADA = (const float*)(P.ws + WS_ADA) + (row >> 13) * 6144 + 5120;
        int mypos = 0;
        if (lane < 8) { const int e = ((const int*)(P.ws + WS_EIDX))[row * 8 + lane]; mypos = estart[e] + ((const int*)(P.ws + WS_EPOS))[row * 8 + lane]; }
        u32x4 w[8];
#pragma unroll
        for (int s = 0; s < 8; ++s) { const int pos = __builtin_amdgcn_readlane(mypos, s); w[s] = *(const u32x4*)((pos < T * 4 ? OA + (size_t)pos * 1024 : OB + (size_t)(pos - T * 4) * 1024) + lane * 16); }
        float f[16];
#pragma unroll
        for (int i = 0; i < 16; ++i) f[i] = 0.f;
#pragma unroll
        for (int s = 0; s < 8; ++s)
#pragma unroll
            for (int q = 0; q < 4; ++q) { const f32x2 a = __builtin_amdgcn_cvt_pk_f32_fp8((int)w[s][q], false), bb = __builtin_amdgcn_cvt_pk_f32_fp8((int)w[s][q], true);
                f[4 * q] += a[0]; f[4 * q + 1] += a[1]; f[4 * q + 2] += bb[0]; f[4 * q + 3] += bb[1]; }
        float* op = P.out + (size_t)row * 1024 + 16 * lane; float z[16]; float sm = 0.f;
        const bf16_t* zp = (const bf16_t*)(P.ws + WS_XZ) + (size_t)row * 1024 + 16 * lane; const u32x4 zw0 = *(const u32x4*)zp, zw1 = *(const u32x4*)(zp + 8);
#pragma unroll
        for (int i = 0; i < 4; ++i) { const f32x4 g = *(const f32x4*)(ADA + 16 * lane + 4 * i); const unsigned wa = (i < 2 ? zw0 : zw1)[2 * (i & 1)], wb = (i < 2 ? zw0 : zw1)[2 * (i & 1) + 1];
            const f32x4 zs = (f32x4){bflo(wa), bfhi(wa), bflo(wb), bfhi(wb)};
#pragma unroll
            for (int q = 0; q < 4; ++q) { const float v = zs[q] + g[q] * (f[4 * i + q] * (1.f / OUT_SCALE)); z[4 * i + q] = v; sm += v; } }
        const float mean = wave_sum(sm) * (1.f / 1024.f); float qv = 0.f;
#pragma unroll
        for (int i = 0; i < 16; ++i) { z[i] -= mean; qv += z[i] * z[i]; }
        const float rstd = rsqrtf(wave_sum(qv) * (1.f / 1024.f) + EPS);
#pragma unroll
        for (int i = 0; i < 4; ++i) { const f32x4 g = *(const f32x4*)(P.ln2_g + 16 * lane + 4 * i), bb = *(const f32x4*)(P.ln2_b + 16 * lane + 4 * i);
            *(f32x4*)(op + 4 * i) = (f32x4){z[4 * i] * rstd * g[0] + bb[0], z[4 * i + 1] * rstd * g[1] + bb[1], z[4 * i + 2] * rstd * g[2] + bb[2], z[4 * i + 3] * rstd * g[3] + bb[3]}; }
    }
}

__global__ void __launch_bounds__(NTHR) fwd_megakernel(Params P) {
    extern __shared__ __attribute__((aligned(16))) char lds[];
    volatile LAS unsigned* bst = (volatile LAS unsigned*)((LAS unsigned char*)lds + BARLDS_OFF);
    if (threadIdx.x < 2) bst[threadIdx.x] = 0u;
    __syncthreads();
    const XcdBarrier bar = xcd_barrier_post((unsigned*)(P.ws + WS_BAR), bst);
    p0_prologue(P, lds);
    xcd_barrier(bar);
    p1_inproj_and_experts(P, lds);
    xcd_barrier(bar);
    p2_mixer(P, lds);
    xcd_barrier(bar);
    p3a_ssm(P, lds);
    xcd_barrier(bar);
    p3b_glu(P, lds);
    xcd_barrier(bar);
    p3d_outproj(P, lds);
    xcd_barrier(bar);
    p3e_ln1(P);
    xcd_barrier(bar);
    p3f_router_shared(P, lds);
    xcd_barrier(bar);
    p3g_route_shared_down(P, lds);
    xcd_barrier(bar);
    p5a_gateup(P, lds);
    xcd_barrier(bar);
    p5b_down(P, lds);
    xcd_barrier(bar);
    p6_combine(P, lds);
}


#ifdef ANALYZE_PHASES
template <int PH> __global__ void __launch_bounds__(NTHR) phase_kernel(Params P) {
    extern __shared__ __attribute__((aligned(16))) char lds[];
    if (PH == 0) p0_prologue(P, lds);
    if (PH == 1) p1_inproj_and_experts(P, lds);
    if (PH == 2) p2_mixer(P, lds);
    if (PH == 3) p3a_ssm(P, lds);
    if (PH == 7) p3b_glu(P, lds);
    if (PH == 9) p3d_outproj(P, lds);
    if (PH == 10) p3e_ln1(P);
    if (PH == 11) p3f_router_shared(P, lds);
    if (PH == 12) p3g_route_shared_down(P, lds);
    if (PH == 4) p5a_gateup(P, lds);
    if (PH == 5) p5b_down(P, lds);
    if (PH == 6) p6_combine(P, lds);
}
template __global__ void phase_kernel<0>(Params); template __global__ void phase_kernel<1>(Params); template __global__ void phase_kernel<2>(Params); template __global__ void phase_kernel<3>(Params);
template __global__ void phase_kernel<4>(Params); template __global__ void phase_kernel<5>(Params); template __global__ void phase_kernel<6>(Params);
template __global__ void phase_kernel<7>(Params); template __global__ void phase_kernel<8>(Params); template __global__ void phase_kernel<9>(Params); template __global__ void phase_kernel<10>(Params); template __global__ void phase_kernel<11>(Params); template __global__ void phase_kernel<12>(Params);
#endif

extern "C" void kernel_launch(void* const* d_in, const int* in_sizes, int n_in, void* d_out, int out_size, void* d_ws, size_t ws_size, hipStream_t stream) {
    static int grid = 0;
    if (grid == 0) {
        if (n_in != 31 || out_size != T * D || ws_size < WS_END) { fprintf(stderr, "kernel_launch: unexpected problem (n_in %d, out %d, ws %zu < %zu)\n", n_in, out_size, ws_size, (size_t)WS_END); grid = -1; return; }
        int dev = 0, cus = 0, per_cu = 0;
        (void)hipGetDevice(&dev); (void)hipDeviceGetAttribute(&cus, hipDeviceAttributeMultiprocessorCount, dev);
        (void)hipFuncSetAttribute((const void*)fwd_megakernel, hipFuncAttributeMaxDynamicSharedMemorySize, LDS_BYTES);
        (void)hipOccupancyMaxActiveBlocksPerMultiprocessor(&per_cu, (const void*)fwd_megakernel, NTHR, LDS_BYTES);
        if (per_cu < 1) { fprintf(stderr, "kernel_launch: occupancy query says %d blocks per CU\n", per_cu); grid = -1; return; }
        grid = cus * 1;
        if (grid > 256) grid = 256;
    }
    if (grid < 0) return;
    (void)hipMemsetAsync(d_ws, 0, 65536, stream);
    Params p{};
    const float** pf = (const float**)&p;
    for (int i = 0; i < 31; ++i) pf[i] = (const float*)d_in[i];
    p.out = (float*)d_out; p.ws = (unsigned char*)d_ws;
    void* args[] = {&p};
    hipError_t e = hipLaunchCooperativeKernel((const void*)fwd_megakernel, dim3(grid), dim3(NTHR), args, LDS_BYTES, stream);
    if (e != hipSuccess) fprintf(stderr, "cooperative launch failed: %s (grid %d)\n", hipGetErrorString(e), grid);
}
```

```cpp
#include <hip/hip_runtime.h>
#include <cstdio>
#include <cstdint>

#define DI __device__ __forceinline__
typedef unsigned short bf16_t;
typedef short bf16x8 __attribute__((ext_vector_type(8)));
typedef float f32x2 __attribute__((ext_vector_type(2)));
typedef float f32x4 __attribute__((ext_vector_type(4)));
typedef float f32x16 __attribute__((ext_vector_type(16)));
typedef unsigned u32x2 __attribute__((ext_vector_type(2)));
typedef unsigned u32x4 __attribute__((ext_vector_type(4)));
typedef __bf16 bf16v2 __attribute__((ext_vector_type(2)));

#define MFMA16(a, b, c) __builtin_amdgcn_mfma_f32_16x16x32_bf16((a), (b), (c), 0, 0, 0)
#define MFMA32(a, b, c) __builtin_amdgcn_mfma_f32_32x32x16_bf16((a), (b), (c), 0, 0, 0)
#define LDS_FENCE() asm volatile("s_waitcnt lgkmcnt(0)" ::: "memory")

constexpr int D = 1024, BATCH = 4, SEQ = 8192, T = BATCH * SEQ, NPROJ = 2048;
constexpr int NTHR = 512;
constexpr int NEXP = 256, TOPK = 8;
constexpr float ALPHA = 1.189207115002721f;
constexpr float EPS = 1e-5f;
constexpr float NEG = -1e30f;
constexpr float OUT_SCALE = 64.f;

constexpr size_t MiB = 1u << 20;
constexpr size_t WS_CNT = 0;
constexpr size_t WS_ADACNT = 2048;
constexpr size_t WS_BAR = 16384;
constexpr size_t WS_ADA = 64 * 1024;
constexpr size_t WS_ABAR = 192 * 1024;
constexpr size_t WS_ABARL = 208 * 1024;
constexpr size_t WS_BCAT = 256 * 1024;
constexpr size_t WS_CCAT = 384 * 1024;
constexpr size_t WS_WIN = 2 * MiB;
constexpr size_t WS_WGLU = 6 * MiB;
constexpr size_t WS_WR = 6 * MiB + 512 * 1024;
constexpr size_t WS_WSGU = 7 * MiB;
constexpr size_t WS_WOUT = 8 * MiB;
constexpr size_t WS_WSD = 10 * MiB;
constexpr size_t WS_EIDX = 11 * MiB;
constexpr size_t WS_EPOS = 12 * MiB;
constexpr size_t WS_HIDS = 14 * MiB;
constexpr size_t WS_BINS = 30 * MiB;
constexpr size_t WS_BING = 62 * MiB;
constexpr size_t WS_H2 = 94 * MiB;
constexpr size_t WS_WEGU = 158 * MiB;
constexpr size_t WS_WED = 414 * MiB;
constexpr size_t WS_H1 = 542 * MiB;
constexpr size_t WS_QKVU = 606 * MiB;
constexpr size_t WS_MERGED = 734 * MiB;
constexpr size_t WS_YGL = 798 * MiB;
constexpr size_t WS_SCORES = 830 * MiB;
constexpr size_t WS_E = 862 * MiB;
constexpr size_t WS_ATTSQ = 866 * MiB;
constexpr size_t WS_SSQ = 867 * MiB;
constexpr size_t WS_RS = 868 * MiB;
constexpr size_t WS_HIDALL = 542 * MiB;
constexpr size_t WS_OUTA = 158 * MiB;
constexpr size_t WS_OUTB = 670 * MiB;
constexpr size_t WS_XZ = 926 * MiB;
constexpr size_t WS_END = 1022 * MiB;

constexpr int LDP = 72;
constexpr int GEMM_LDS = (128 + 256) * LDP * 2;
constexpr int MISC_OFF = 57344;
constexpr int SSM_PITCH = 36;
constexpr int SSM_WAVE_LDS = 128 * SSM_PITCH * 4;
constexpr int P5TAB_OFF = 131072;
constexpr int BARLDS_OFF = 148 * 1024;
constexpr int LDS_BYTES = 148 * 1024 + 64;

struct Params {
    const float *x, *c, *rel_bias, *w_ada, *b_ada, *w_in, *a_re, *a_im, *b_re, *b_im, *c_re, *c_im, *ssm_d, *log_dt, *w_glu, *b_glu, *g_att, *g_ssm, *w_out,
        *ln1_g, *ln1_b, *w_router, *router_bias, *w_e_gate, *w_e_up, *w_e_down, *w_s_gate, *w_s_up, *w_s_down, *ln2_g, *ln2_b;
    float* out;
    unsigned char* ws;
};

DI int opaque_tid() { int t = threadIdx.x; asm volatile("" : "+v"(t)); return t; }
DI unsigned pk2(float a, float b) { f32x2 f = {a, b}; bf16v2 r = __builtin_convertvector(f, bf16v2); return __builtin_bit_cast(unsigned, r); }
DI bf16_t f2bf(float a) { return (bf16_t)(pk2(a, 0.f) & 0xffffu); }
DI float bflo(unsigned w) { return __uint_as_float(w << 16); }
DI float bfhi(unsigned w) { return __uint_as_float(w & 0xffff0000u); }
DI float sigmoidf_(float x) { return __builtin_amdgcn_rcpf(1.f + __expf(-x)); }
DI float siluf_(float x) { return x * __builtin_amdgcn_rcpf(1.f + __expf(-x)); }
DI float gelu_tanh(float x) { const float u = 0.7978845608028654f * (x + 0.044715f * x * x * x); const float e = __expf(2.f * u); const float th = 1.f - 2.f * __builtin_amdgcn_rcpf(e + 1.f); return 0.5f * x * (1.f + th); }
template <int CTRL> DI float dppf(float v) { return __builtin_bit_cast(float, __builtin_amdgcn_update_dpp(0, __builtin_bit_cast(int, v), CTRL, 0xF, 0xF, true)); }
DI float rdlane(float v, int l) { return __builtin_bit_cast(float, __builtin_amdgcn_readlane(__builtin_bit_cast(int, v), l)); }
constexpr int DPP_X1 = 0xB1, DPP_X2 = 0x4E, DPP_HM = 0x141, DPP_RM = 0x140;
DI float xsum16(float x) { auto t = __builtin_amdgcn_permlane16_swap(__float_as_uint(x), __float_as_uint(x), false, false); return __uint_as_float(t[0]) + __uint_as_float(t[1]); }
DI float xsum32(float x) { auto t = __builtin_amdgcn_permlane32_swap(__float_as_uint(x), __float_as_uint(x), false, false); return __uint_as_float(t[0]) + __uint_as_float(t[1]); }
DI float xmax32(float x) { auto t = __builtin_amdgcn_permlane32_swap(__float_as_uint(x), __float_as_uint(x), false, false); return fmaxf(__uint_as_float(t[0]), __uint_as_float(t[1])); }
DI float wave_sum(float v) {
    v += dppf<DPP_X1>(v); v += dppf<DPP_X2>(v); v += dppf<DPP_HM>(v); v += dppf<DPP_RM>(v); v = xsum16(v); return xsum32(v);
}

#define LAS __attribute__((address_space(3)))
#define XB_TMO      128
#define XB_XCNT(j)  (256  + 64 * (j))
#define XB_XSUB(j)  (1280 + 64 * (j))
#define XB_XGEN(j)  (2304 + 64 * (j))
#define XB_TOP      3328
#define XB_TOPGEN   3392
#define XB_SPIN_CAP (1u << 18)
DI unsigned xb_ld(unsigned* p) { return __hip_atomic_load(p, __ATOMIC_RELAXED, __HIP_MEMORY_SCOPE_AGENT); }
DI unsigned xb_add(unsigned* p, unsigned v) { return __hip_atomic_fetch_add(p, v, __ATOMIC_RELAXED, __HIP_MEMORY_SCOPE_AGENT); }
DI unsigned xb_xcc_id() { return (unsigned)__builtin_amdgcn_s_getreg((3 << 11) | 20) & 0xFu; }
#define XB_SPIN(cond, bar) do { unsigned _sp = 0; while (cond) { __builtin_amdgcn_s_sleep(1); \
    if ((++_sp & 255u) == 0u) { if (xb_ld(&(bar)[XB_TMO])) break; if (_sp > XB_SPIN_CAP) { atomicAdd(&(bar)[XB_TMO], 1u); break; } } } } while (0)
struct XcdBarrier { unsigned* bar; unsigned x; volatile LAS unsigned* st; };
DI XcdBarrier xcd_barrier_post(unsigned* bar, volatile LAS unsigned* st) {
    XcdBarrier b; b.bar = bar; b.x = xb_xcc_id(); b.st = st;
    if (threadIdx.x == 0) (void)xb_add(&bar[XB_XCNT(b.x)], 1u);
    return b;
}
DI void xcd_barrier_complete(unsigned* bar, unsigned x, unsigned& nloc, unsigned& nx) {
    const unsigned G = gridDim.x * gridDim.y * gridDim.z;
    unsigned sum, cnt, mine, sp = 0u;
    for (;;) {
        sum = 0u; cnt = 0u; mine = 0u;
#pragma unroll
        for (unsigned j = 0; j < 16; ++j) { const unsigned c = xb_ld(&bar[XB_XCNT(j)]); sum += c; cnt += (c > 0u) ? 1u : 0u; mine = (j == x) ? c : mine; }
        if (sum == G) break;
        __builtin_amdgcn_s_sleep(1);
        if ((++sp & 255u) == 0u) { if (xb_ld(&bar[XB_TMO])) break; if (sp > XB_SPIN_CAP) { atomicAdd(&bar[XB_TMO], 1u); break; } }
    }
    nloc = mine > 0u ? mine : 1u; nx = cnt > 0u ? cnt : 1u;
}
DI void xcd_barrier(const XcdBarrier& b) {
    asm volatile("s_waitcnt vmcnt(0)" ::: "memory");
    __syncthreads();
    if (threadIdx.x == 0) {
        unsigned* bar = b.bar;
        __builtin_amdgcn_s_waitcnt(0);
        unsigned nloc = b.st[0], nx = b.st[1];
        if (nloc == 0u) { xcd_barrier_complete(bar, b.x, nloc, nx); b.st[0] = nloc; b.st[1] = nx; }
        const unsigned old = xb_add(&bar[XB_XSUB(b.x)], 1u);
        const unsigned gen = old / nloc;
        if (old + 1u == (gen + 1u) * nloc) {
            __builtin_amdgcn_fence(__ATOMIC_RELEASE, "agent");
            asm volatile("s_waitcnt vmcnt(0)" ::: "memory");
            const unsigned og = xb_add(&bar[XB_TOP], 1u);
            const unsigned tg = og / nx;
            if (og + 1u == (tg + 1u) * nx) xb_add(&bar[XB_TOPGEN], 1u);
            else XB_SPIN(xb_ld(&bar[XB_TOPGEN]) == tg, bar);
            __builtin_amdgcn_fence(__ATOMIC_ACQUIRE, "agent");
            xb_add(&bar[XB_XGEN(b.x)], 1u);
            asm volatile("s_waitcnt vmcnt(0)" ::: "memory");
        } else {
            XB_SPIN(xb_ld(&bar[XB_XGEN(b.x)]) == gen, bar);
            __builtin_amdgcn_fence(__ATOMIC_ACQUIRE, "agent");
            asm volatile("s_waitcnt vmcnt(0)" ::: "memory");
        }
    }
    __syncthreads();
}

namespace pg8 {
constexpr int BM = 256, BK = 64, HALF = 128, HTB = HALF * BK * 2, STAGE_BYTES = 8 * HTB;
DI int lds_byte(int r, int c) { const int st = (r >> 4) * 2 + (c >> 5), rr = r & 15, cc = c & 31, ob = rr * 64 + cc * 2; return st * 1024 + (ob ^ (((ob >> 9) & 1) << 5)); }
DI void stage_rc(int b, int& R, int& C) { const int st = b / 1024, sb = b % 1024, swz = sb ^ (((sb >> 9) & 1) << 5); R = (st >> 1) * 16 + swz / 64; C = (st & 1) * 32 + (swz % 64) / 2; }
DI int perm32(int rho) { const int n = rho >> 4, i = rho & 15; return 8 * (i >> 2) + 4 * n + (i & 3); }
struct Unit { const char* A; const char* B; int pm, pn, rows, aux; };

template <class Epi, class Sched, bool GATHER>
DI void gemm_phase(LAS unsigned char* lds, const int K, const Sched& S, const Epi& E) {
    int tid = threadIdx.x; asm volatile("" : "+v"(tid));
    const int wid = __builtin_amdgcn_readfirstlane(tid >> 6), lane = tid & 63, wr = wid >> 2, wc = wid & 3, fr = lane & 15, fq = lane >> 4;
    const int nt = K / BK;
    unsigned voffA[2], voffB[2]; int Rr[2], Cc[2];
#pragma unroll
    for (int i = 0; i < 2; ++i) { int R, C; stage_rc(tid * 16 + i * 8192, R, C); const int Rb = (R & ~31) + perm32(R & 31); Rr[i] = R; Cc[i] = C;
        voffA[i] = (unsigned)(R * K + C) * 2u; voffB[i] = (unsigned)(Rb * K + C) * 2u; }
    const size_t kstep = (size_t)(BK * 2);
    const size_t hstep = (size_t)HALF * K * 2;
    const unsigned ldsw = (unsigned)wid * 1024u;
    const int aoff = lds_byte(wr * 64 + fr, fq * 8), boff = lds_byte(wc * 32 + fr, fq * 8);
#define PG8_SA(b, h) (((b) * 2 + (h)) * HTB)
#define PG8_SB(b, h) ((4 + (b) * 2 + (h)) * HTB)
#define PG8_STAGE(bufoff, gbase, voff) do { _Pragma("unroll") for (int _i = 0; _i < 2; ++_i) \
        __builtin_amdgcn_global_load_lds((const unsigned*)((const char*)(gbase) + (voff)[_i]), (LAS unsigned*)(lds + (bufoff) + ldsw + _i * 8192), 16, 0, 0); } while (0)
#define PG8_STAGEA(bufoff, gbase, h, nx) do { if constexpr (GATHER) { unsigned _o[2]; _o[0] = (nx) ? na[h][0] : ga[h][0]; _o[1] = (nx) ? na[h][1] : ga[h][1]; PG8_STAGE(bufoff, gbase, _o); } \
        else { PG8_STAGE(bufoff, (gbase) + (h) * hstep, voffA); } } while (0)
#define PG8_LDA(dst, b, h) do { _Pragma("unroll") for (int m = 0; m < 4; ++m) _Pragma("unroll") for (int k = 0; k < 2; ++k) dst[m][k] = *(const LAS bf16x8*)(lds + PG8_SA(b, h) + aoff + m * 2048 + k * 1024); } while (0)
#define PG8_LDB(dst, b, h) do { _Pragma("unroll") for (int n = 0; n < 2; ++n) _Pragma("unroll") for (int k = 0; k < 2; ++k) dst[n][k] = *(const LAS bf16x8*)(lds + PG8_SB(b, h) + boff + n * 2048 + k * 1024); } while (0)
#define PG8_MMA(ai, bj, At, Bt) do { __builtin_amdgcn_s_setprio(1); _Pragma("unroll") for (int m = 0; m < 4; ++m) _Pragma("unroll") for (int n = 0; n < 2; ++n) _Pragma("unroll") for (int k = 0; k < 2; ++k) \
        acc[ai][bj][m][n] = __builtin_amdgcn_mfma_f32_16x16x32_bf16(Bt[n][k], At[m][k], acc[ai][bj][m][n], 0, 0, 0); __builtin_amdgcn_s_setprio(0); } while (0)
#define PG8_WAIT_V(n) asm volatile("s_waitcnt vmcnt(" #n ")" ::: "memory")
#define PG8_WAIT_L(n) asm volatile("s_waitcnt lgkmcnt(" #n ")" ::: "memory")
#define PG8_BAR __builtin_amdgcn_s_barrier()
#define PG8_SCHED __builtin_amdgcn_sched_barrier(0)
    Unit cur, nxt; int ui = 0;
    if (!S.next(0, cur)) return;
    f32x4 acc[2][2][4][2];
#pragma unroll
    for (int a = 0; a < 2; ++a)
#pragma unroll
        for (int b = 0; b < 2; ++b)
#pragma unroll
            for (int m = 0; m < 4; ++m)
#pragma unroll
                for (int n = 0; n < 2; ++n) acc[a][b][m][n] = (f32x4){0.f, 0.f, 0.f, 0.f};
    bf16x8 At[4][2], B0[2][2], B1[2][2];
    const char* cA = cur.A; const char* cB = cur.B;
    if constexpr (Epi::PREP) E.prep(cur, tid);
    unsigned ga[2][2], na[2][2];
    if constexpr (GATHER) {
#pragma unroll
        for (int h = 0; h < 2; ++h)
#pragma unroll
            for (int i = 0; i < 2; ++i) { ga[h][i] = S.row_off(cur, 128 * h + Rr[i]) + (unsigned)Cc[i] * 2u; na[h][i] = ga[h][i]; }
    }
    PG8_STAGE(PG8_SB(0, 0), cB, voffB); PG8_STAGE(PG8_SB(0, 1), cB + hstep, voffB); PG8_STAGEA(PG8_SA(0, 0), cA, 0, false); PG8_STAGEA(PG8_SA(0, 1), cA, 1, false);
    if (wr == 1) PG8_BAR;
    PG8_WAIT_V(2); PG8_BAR;
    PG8_STAGE(PG8_SB(1, 0), cB + kstep, voffB); PG8_STAGEA(PG8_SA(1, 0), cA + kstep, 0, false); PG8_STAGE(PG8_SB(1, 1), cB + hstep + kstep, voffB);
    PG8_WAIT_V(6); PG8_BAR;
    for (;;) {
        const bool has_next = S.next(ui + 1, nxt);
        if constexpr (Epi::PREP) { if (has_next) E.prep(nxt, tid); }
        const char* nA = has_next ? nxt.A : cA; const char* nB = has_next ? nxt.B : cB;
        if constexpr (GATHER) {
            if (has_next) {
#pragma unroll
                for (int h = 0; h < 2; ++h)
#pragma unroll
                    for (int i = 0; i < 2; ++i) na[h][i] = S.row_off(nxt, 128 * h + Rr[i]) + (unsigned)Cc[i] * 2u;
            }
        }
        const bool do0 = !Sched::RAGGED || cur.rows > 64 * wr, do1 = !Sched::RAGGED || cur.rows > 128 + 64 * wr;
#pragma unroll 1
        for (int t = 0; t < nt; t += 2) {
            const bool last = (t == nt - 2);
            const char* a1 = cA + (size_t)(t + 1) * kstep;
            const char* a2 = last ? nA : cA + (size_t)(t + 2) * kstep; const char* b2 = last ? nB : cB + (size_t)(t + 2) * kstep;
            const char* a3 = a2 + kstep; const char* b3 = b2 + kstep;
            PG8_LDB(B0, 0, 0); PG8_LDB(B1, 0, 1); PG8_SCHED; PG8_LDA(At, 0, 0); PG8_STAGEA(PG8_SA(1, 1), a1, 1, false);
            PG8_WAIT_V(8); PG8_WAIT_L(0); PG8_BAR; if (do0) { PG8_MMA(0, 0, At, B0); PG8_MMA(0, 1, At, B1); } PG8_BAR; PG8_SCHED;
            PG8_LDA(At, 0, 1); PG8_STAGE(PG8_SB(0, 0), b2, voffB); PG8_STAGE(PG8_SB(0, 1), b2 + hstep, voffB); PG8_STAGEA(PG8_SA(0, 0), a2, 0, last);
            PG8_WAIT_V(8); PG8_WAIT_L(0); PG8_BAR; if (do1) { PG8_MMA(1, 0, At, B0); PG8_MMA(1, 1, At, B1); } PG8_BAR; PG8_SCHED;
            PG8_LDB(B0, 1, 0); PG8_LDB(B1, 1, 1); PG8_SCHED; PG8_LDA(At, 1, 0); PG8_STAGEA(PG8_SA(0, 1), a2, 1, last);
            PG8_WAIT_V(8); PG8_WAIT_L(0); PG8_BAR; if (do0) { PG8_MMA(0, 0, At, B0); PG8_MMA(0, 1, At, B1); } PG8_BAR; PG8_SCHED;
            PG8_LDA(At, 1, 1); PG8_STAGE(PG8_SB(1, 0), b3, voffB); PG8_STAGE(PG8_SB(1, 1), b3 + hstep, voffB); PG8_STAGEA(PG8_SA(1, 0), a3, 0, last);
            PG8_WAIT_V(8); PG8_WAIT_L(0); PG8_BAR; if (do1) { PG8_MMA(1, 0, At, B0); PG8_MMA(1, 1, At, B1); } PG8_BAR; PG8_SCHED;
            if constexpr (Epi::MID) { if (t == nt / 2 - 2) E.mid(acc, cur, wr, wc, fr, fq); }
        }
        if (wr == 0) PG8_BAR;
        E(acc, cur, wr, wc, fr, fq);
        if (!has_next) break;
#pragma unroll
        for (int a = 0; a < 2; ++a)
#pragma unroll
            for (int b = 0; b < 2; ++b)
#pragma unroll
                for (int m = 0; m < 4; ++m)
#pragma unroll
                    for (int n = 0; n < 2; ++n) acc[a][b][m][n] = (f32x4){0.f, 0.f, 0.f, 0.f};
        cur = nxt; cA = nA; cB = nB; ++ui;
        if constexpr (GATHER) {
#pragma unroll
            for (int h = 0; h < 2; ++h)
#pragma unroll
                for (int i = 0; i < 2; ++i) ga[h][i] = na[h][i];
        }
        if (wr == 1) PG8_BAR;
    }
    PG8_WAIT_V(0);
    PG8_BAR;
#undef PG8_SA
#undef PG8_SB
#undef PG8_STAGE
#undef PG8_STAGEA
#undef PG8_LDA
#undef PG8_LDB
#undef PG8_MMA
#undef PG8_WAIT_V
#undef PG8_WAIT_L
#undef PG8_BAR
#undef PG8_SCHED
}

struct DenseOrder {
    static constexpr bool RAGGED = false;
    const char* A; const char* Bt; int K, nM, nN, nwg, G, c;
    DI void init(const void* A_, const void* Bt_, int M, int N, int K_, int G_, int c_) { A = (const char*)A_; Bt = (const char*)Bt_; K = K_; nM = M / BM; nN = N / BM; nwg = nM * nN; G = G_; c = c_; }
    DI bool next(int i, Unit& u) const {
        const long L = (long)i * G + c; if (L >= nwg) return false;
        int wgid = (int)L; { const int q = nwg / 8, r = nwg % 8, xcd = wgid % 8, off = wgid / 8; wgid = (xcd < r ? xcd * (q + 1) : r * (q + 1) + (xcd - r) * q) + off; }
        const int nig = 8 * nN, gid = wgid / nig, fm = gid * 8, gsz = (nM - fm) < 8 ? (nM - fm) : 8;
        u.pm = fm + ((wgid % nig) % gsz); u.pn = (wgid % nig) / gsz; u.rows = 256; u.aux = i % 3;
        u.A = A + (size_t)u.pm * 256 * K * 2; u.B = Bt + (size_t)u.pn * 256 * K * 2; return true;
    }
    DI unsigned row_off(const Unit&, int) const { return 0u; }
};
struct EpiStoreBf16 {
    static constexpr bool MID = false, PREP = false;
    bf16_t* O; int ld;
    DI void operator()(const f32x4 (&acc)[2][2][4][2], const Unit& u, int wr, int wc, int fr, int fq) const {
        bf16_t* base = O + (size_t)(u.pm * 256 + wr * 64 + fr) * ld + u.pn * 256 + wc * 32 + 8 * fq;
#pragma unroll
        for (int ai = 0; ai < 2; ++ai)
#pragma unroll
            for (int m = 0; m < 4; ++m) { bf16_t* rowp = base + (size_t)(ai * HALF + m * 16) * ld;
#pragma unroll
                for (int bj = 0; bj < 2; ++bj) { const f32x4 v0 = acc[ai][bj][m][0], v1 = acc[ai][bj][m][1];
                    *(u32x4*)(rowp + bj * HALF) = (u32x4){pk2(v0[0], v0[1]), pk2(v0[2], v0[3]), pk2(v1[0], v1[1]), pk2(v1[2], v1[3])}; } }
    }
};
}

DI void sincos_d(double ang, double& s, double& c) {
    const double r = ang * 0.63661977236758134308; const double q = __builtin_rint(r);
    const double y = (ang - q * 1.57079632679489655800) - q * 6.12323399573676603587e-17;
    const double y2 = y * y;
    double sp = -1.0 / 1307674368000.0; sp = sp * y2 + 1.0 / 6227020800.0; sp = sp * y2 - 1.0 / 39916800.0; sp = sp * y2 + 1.0 / 362880.0; sp = sp * y2 - 1.0 / 5040.0; sp = sp * y2 + 1.0 / 120.0; sp = sp * y2 - 1.0 / 6.0; sp = sp * y2 + 1.0;
    const double sy = y * sp;
    double cp = 1.0 / 87178291200.0; cp = cp * y2 - 1.0 / 479001600.0; cp = cp * y2 + 1.0 / 3628800.0; cp = cp * y2 - 1.0 / 40320.0; cp = cp * y2 + 1.0 / 720.0; cp = cp * y2 - 1.0 / 24.0; cp = cp * y2 + 0.5; const double cy = 1.0 - y2 * cp;
    const int qi = ((int)q) & 3;
    s = (qi == 0) ? sy : (qi == 1) ? cy : (qi == 2) ? -sy : -cy;
    c = (qi == 0) ? cy : (qi == 1) ? -sy : (qi == 2) ? -cy : sy;
}
DI void ssm_tables(const Params& P, int g, int p) {
    float* ABAR = (float*)(P.ws + WS_ABAR); float* ABARL = (float*)(P.ws + WS_ABARL); bf16_t* BCAT = (bf16_t*)(P.ws + WS_BCAT); bf16_t* CCAT = (bf16_t*)(P.ws + WS_CCAT);
    const double dt = (double)expf(P.log_dt[g]);
    const double ar = P.a_re[g * 64 + p], ai = P.a_im[g * 64 + p];
    double sn, cs; sincos_d(dt * ai, sn, cs);
    const double mag = (double)expf((float)(dt * ar));
    const double abr = mag * cs, abi = mag * sn;
    ABAR[g * 128 + p] = (float)abr; ABAR[g * 128 + 64 + p] = (float)abi;
    double snL, csL; sincos_d(128.0 * dt * ai, snL, csL);
    const double magL = (double)expf((float)(128.0 * dt * ar));
    ABARL[g * 128 + p] = (float)(magL * csL); ABARL[g * 128 + 64 + p] = (float)(magL * snL);
    const double xr = abr - 1.0, xi = abi, den = ar * ar + ai * ai;
    const double qr = (xr * ar + xi * ai) / den, qi = (xi * ar - xr * ai) / den;
    for (int c = 0; c < 16; ++c) {
        const double br = P.b_re[(g * 64 + p) * 16 + c], bi = P.b_im[(g * 64 + p) * 16 + c];
        BCAT[(g * 128 + p) * 16 + c] = f2bf((float)(qr * br - qi * bi));
        BCAT[(g * 128 + 64 + p) * 16 + c] = f2bf((float)(qr * bi + qi * br));
        CCAT[(g * 16 + c) * 128 + p] = f2bf(P.c_re[(g * 16 + c) * 64 + p]);
        CCAT[(g * 16 + c) * 128 + 64 + p] = f2bf(-P.c_im[(g * 16 + c) * 64 + p]);
    }
}
DI void ada_item(const Params& P, char* lds, int item) {
    float* red = (float*)lds; const int tid = opaque_tid(), lane = tid & 63, wid = tid >> 6;
    const int n = item * 64 + lane, k0 = wid * 128;
    float a0 = 0.f, a1 = 0.f, a2 = 0.f, a3 = 0.f;
#pragma unroll 1
    for (int kb = k0; kb < k0 + 128; kb += 32) {
        float w[32];
#pragma unroll
        for (int j = 0; j < 32; ++j) w[j] = P.w_ada[(size_t)(kb + j) * 6144 + n];
#pragma unroll
        for (int j = 0; j < 32; ++j) { const int k = kb + j; a0 += siluf_(P.c[k]) * w[j]; a1 += siluf_(P.c[1024 + k]) * w[j]; a2 += siluf_(P.c[2048 + k]) * w[j]; a3 += siluf_(P.c[3072 + k]) * w[j]; }
    }
    red[(wid * 4 + 0) * 64 + lane] = a0; red[(wid * 4 + 1) * 64 + lane] = a1; red[(wid * 4 + 2) * 64 + lane] = a2; red[(wid * 4 + 3) * 64 + lane] = a3;
    __syncthreads();
    if (tid < 256) {
        const int b = tid >> 6, l = tid & 63; float s = 0.f;
#pragma unroll
        for (int w = 0; w < 8; ++w) s += red[(w * 4 + b) * 64 + l];
        ((float*)(P.ws + WS_ADA))[b * 6144 + item * 64 + l] = s + P.b_ada[item * 64 + l];
    }
    asm volatile("s_waitcnt vmcnt(0)" ::: "memory");
    __syncthreads();
    if (tid == 0) {
        __builtin_amdgcn_fence(__ATOMIC_RELEASE, "agent"); asm volatile("s_waitcnt vmcnt(0)" ::: "memory");
        __hip_atomic_fetch_add((unsigned*)(P.ws + WS_ADACNT), 1u, __ATOMIC_RELAXED, __HIP_MEMORY_SCOPE_AGENT);
    }
}
DI void tr_item(const float* __restrict__ W, int K, int N, bf16_t* __restrict__ WT, int item, float* scr, int lane, int mode, int s, bool qscale, const float* ks0 = nullptr, const float* ks1 = nullptr) {
    const int nblk = N >> 6, kb = item / nblk, nb = item % nblk, k0 = 64 * kb, n0 = 64 * nb;
    const float* src = W + (size_t)(k0 + (lane >> 4)) * N + n0 + 4 * (lane & 15);
    f32x4 wv[16];
#pragma unroll
    for (int i = 0; i < 16; ++i) wv[i] = *(const f32x4*)(src + (size_t)(4 * i) * N);
    if (ks0) {
#pragma unroll
        for (int i = 0; i < 16; ++i) { const int k = k0 + 4 * i + (lane >> 4); wv[i] = wv[i] * ((k < 512) ? ks0[k] : ks1[k - 512]); }
    }
#pragma unroll
    for (int i = 0; i < 16; ++i) { float* d = scr + (4 * i + (lane >> 4)) * 65 + 4 * (lane & 15); d[0] = wv[i][0]; d[1] = wv[i][1]; d[2] = wv[i][2]; d[3] = wv[i][3]; }
    LDS_FENCE();
    const int c = lane & 7; const float sc = (qscale && n0 < 512) ? 0.125f : 1.f;
#pragma unroll
    for (int j = 0; j < 8; ++j) {
        const int n = (lane >> 3) + 8 * j; const float* sp = scr + (8 * c) * 65 + n;
        const u32x4 o = (u32x4){pk2(sp[0] * sc, sp[65] * sc), pk2(sp[130] * sc, sp[195] * sc), pk2(sp[260] * sc, sp[325] * sc), pk2(sp[390] * sc, sp[455] * sc)};
        const int nn = n0 + n; const int drow = mode == 0 ? nn : (mode == 1 ? (64 * (nn >> 5) + 32 * s + (nn & 31)) : (mode == 2 ? (256 * (nn >> 7) + 128 * s + (nn & 127)) :
            ((nn & ~255) + 128 * ((nn >> 3) & 1) + 32 * ((nn >> 6) & 3) + 8 * ((nn >> 4) & 3) + (nn & 7))));
        *(u32x4*)(WT + (size_t)drow * K + k0 + 8 * c) = o;
    }
    LDS_FENCE();
}
constexpr int CI_IN = 512, CI_GLU = 64, CI_OUT = 256, CI_R = 64, CI_SG = 64, CI_SU = 64, CI_SD = 64, CI_SMALL = CI_IN + CI_GLU + CI_OUT + CI_R + CI_SG + CI_SU + CI_SD;
DI void conv_item(const Params& P, int r, float* scr, int lane) {
    if (r < CI_IN) { tr_item(P.w_in, 1024, 2048, (bf16_t*)(P.ws + WS_WIN), r, scr, lane, 0, 0, true); return; } r -= CI_IN;
    if (r < CI_GLU) { tr_item(P.w_glu, 512, 512, (bf16_t*)(P.ws + WS_WGLU), r, scr, lane, 0, 0, false); return; } r -= CI_GLU;
    if (r < CI_OUT) { tr_item(P.w_out, 1024, 1024, (bf16_t*)(P.ws + WS_WOUT), r, scr, lane, 0, 0, false, P.g_att, P.g_ssm); return; } r -= CI_OUT;
    if (r < CI_R) { tr_item(P.w_router, 1024, 256, (bf16_t*)(P.ws + WS_WR), r, scr, lane, 0, 0, false); return; } r -= CI_R;
    if (r < CI_SG) { tr_item(P.w_s_gate, 1024, 256, (bf16_t*)(P.ws + WS_WSGU), r, scr, lane, 2, 0, false); return; } r -= CI_SG;
    if (r < CI_SU) { tr_item(P.w_s_up, 1024, 256, (bf16_t*)(P.ws + WS_WSGU), r, scr, lane, 2, 1, false); return; } r -= CI_SU;
    if (r < CI_SD) tr_item(P.w_s_down, 256, 1024, (bf16_t*)(P.ws + WS_WSD), r, scr, lane, 0, 0, false);
}
DI void p0_prologue(const Params& P, char* lds) {
    const int tid = opaque_tid(), lane = tid & 63, wid = tid >> 6, G = gridDim.x;
    { const int gt = blockIdx.x * NTHR + tid; if (gt < 2048) ssm_tables(P, gt >> 6, gt & 63); }
    for (int item = blockIdx.x; item < 96; item += G) ada_item(P, lds, item);
    float* scr = (float*)(lds + wid * 16640);
    const int gw = blockIdx.x * 8 + wid, NGW = G * 8;
    if (blockIdx.x >= 96 || G <= 96) { const int w0 = (G > 96) ? gw - 96 * 8 : gw, nw = (G > 96) ? (G - 96) * 8 : NGW; for (int it = w0; it < CI_SMALL; it += nw) conv_item(P, it, scr, lane); }
    if (tid == 0) {
        unsigned* ctr = (unsigned*)(P.ws + WS_ADACNT); unsigned sp = 0;
        while (__hip_atomic_load(ctr, __ATOMIC_RELAXED, __HIP_MEMORY_SCOPE_AGENT) < 96u) { __builtin_amdgcn_s_sleep(2); if (++sp > (1u << 22)) break; }
        __builtin_amdgcn_fence(__ATOMIC_ACQUIRE, "agent"); asm volatile("s_waitcnt vmcnt(0)" ::: "memory");
    }
    __syncthreads();
    {
        const float* ADA = (const float*)(P.ws + WS_ADA); bf16_t* H1 = (bf16_t*)(P.ws + WS_H1);
        for (int row = gw; row < T; row += NGW) {
            const float* xr = P.x + (size_t)row * 1024 + 4 * lane; const float* ad = ADA + (row >> 13) * 6144 + 4 * lane;
#pragma unroll
            for (int j = 0; j < 4; ++j) {
                const f32x4 xv = *(const f32x4*)(xr + 256 * j), sc = *(const f32x4*)(ad + 1024 + 256 * j), sh = *(const f32x4*)(ad + 256 * j);
                const f32x4 hv = xv * (1.f + sc) + sh;
                *(u32x2*)(H1 + (size_t)row * 1024 + 4 * lane + 256 * j) = (u32x2){pk2(hv[0], hv[1]), pk2(hv[2], hv[3])};
            }
        }
    }
}

DI void p1_inproj(const Params& P, char* lds) {
    pg8::DenseOrder S; S.init(P.ws + WS_H1, P.ws + WS_WIN, T, NPROJ, 1024, gridDim.x, blockIdx.x);
    pg8::EpiStoreBf16 E{(bf16_t*)(P.ws + WS_QKVU), NPROJ};
    pg8::gemm_phase<pg8::EpiStoreBf16, pg8::DenseOrder, false>((LAS unsigned char*)lds, 1024, S, E);
}

constexpr int CONV_NT = 3 * 256 * 16, CONV_TP = 257, FILL_TILES_PER_WG = 8;
struct ConvTile { const float* src; bf16_t* WT; int pitch, K, k0, n0, mode, s; };
DI ConvTile conv_tile(const Params& P, int t) {
    const int kind = t / 4096, e = (t % 4096) >> 4, sub = t & 15;
    if (kind < 2) return ConvTile{(kind ? P.w_e_up : P.w_e_gate) + (size_t)e * 262144 + (size_t)(64 * sub) * 256, (bf16_t*)(P.ws + WS_WEGU) + (size_t)e * 524288, 256, 1024, 64 * sub, 0, 2, kind};
    return ConvTile{P.w_e_down + (size_t)e * 262144 + (size_t)(64 * (sub >> 2)) * 1024 + 256 * (sub & 3), (bf16_t*)(P.ws + WS_WED) + (size_t)e * 262144, 1024, 256, 64 * (sub >> 2), 256 * (sub & 3), 3, 0};
}
DI void conv_tile_load(const ConvTile& d, int wid, int lane, f32x4 (&w)[8]) {
#pragma unroll
    for (int i = 0; i < 8; ++i) w[i] = __builtin_nontemporal_load((const f32x4*)(d.src + (size_t)(8 * wid + i) * d.pitch + 4 * lane));
}
DI void conv_experts_block(const Params& P, char* lds, int t, const int NT, const int stride) {
    const int tid = opaque_tid(), lane = tid & 63, wid = tid >> 6;
    if (t >= NT) return;
    float* buf0 = (float*)lds; float* buf1 = buf0 + 64 * CONV_TP;
    ConvTile d = conv_tile(P, t); f32x4 w[8]; conv_tile_load(d, wid, lane, w);
    int par = 0;
    for (;;) {
        float* buf = par ? buf1 : buf0;
#pragma unroll
        for (int i = 0; i < 8; ++i) { float* p = buf + (8 * wid + i) * CONV_TP + 4 * lane; p[0] = w[i][0]; p[1] = w[i][1]; p[2] = w[i][2]; p[3] = w[i][3]; }
        const int tn = t + stride; const ConvTile dn = conv_tile(P, tn < NT ? tn : t);
        conv_tile_load(dn, wid, lane, w);
        __syncthreads();
        const int c = lane & 7;
#pragma unroll
        for (int it = 0; it < 4; ++it) {
            const int n = 8 * wid + (lane >> 3) + 64 * it; const float* sp = buf + (8 * c) * CONV_TP + n;
            const u32x4 o = (u32x4){pk2(sp[0], sp[CONV_TP]), pk2(sp[2 * CONV_TP], sp[3 * CONV_TP]), pk2(sp[4 * CONV_TP], sp[5 * CONV_TP]), pk2(sp[6 * CONV_TP], sp[7 * CONV_TP])};
            const int nn = d.n0 + n; const int drow = d.mode == 2 ? (256 * (nn >> 7) + 128 * d.s + (nn & 127)) : ((nn & ~255) + 128 * ((nn >> 3) & 1) + 32 * ((nn >> 6) & 3) + 8 * ((nn >> 4) & 3) + (nn & 7));
            *(u32x4*)(d.WT + (size_t)drow * d.K + d.k0 + 8 * c) = o;
        }
        t = tn; if (t >= NT) break;
        d = dn; par ^= 1;
    }
    __syncthreads();
}
DI int fill_blocks() { const int G = gridDim.x, rounds = (384 + G - 1) / G; return rounds * G - 384; }
DI void p1_inproj_and_experts(const Params& P, char* lds) {
    const bool conv_first = ((blockIdx.x >> 3) & 1) == 0;
    const int nb = fill_blocks(), fill = (nb > 0 && nb < (int)gridDim.x) ? nb * FILL_TILES_PER_WG : 0;
    if (conv_first) conv_experts_block(P, lds, blockIdx.x, CONV_NT - fill, gridDim.x);
    p1_inproj(P, lds);
    if (!conv_first) conv_experts_block(P, lds, blockIdx.x, CONV_NT - fill, gridDim.x);
}

DI int t5_bucket(int dist) {
    if (dist < 16) return dist;
    const float v = logf((float)dist / 16.0f) / 4.852030263919617f * 16.0f;
    int l = 16 + (int)v; return l < 31 ? l : 31;
}
struct VFrag { u32x2 r[8]; };
DI VFrag v_tr_read(unsigned addr) {
    VFrag f;
    asm volatile("ds_read_b64_tr_b16 %0, %8\n\tds_read_b64_tr_b16 %1, %8 offset:1152\n\tds_read_b64_tr_b16 %2, %8 offset:64\n\tds_read_b64_tr_b16 %3, %8 offset:1216\n\t"
                 "ds_read_b64_tr_b16 %4, %8 offset:2304\n\tds_read_b64_tr_b16 %5, %8 offset:3456\n\tds_read_b64_tr_b16 %6, %8 offset:2368\n\tds_read_b64_tr_b16 %7, %8 offset:3520\n\ts_waitcnt lgkmcnt(0)"
                 : "=&v"(f.r[0]), "=&v"(f.r[1]), "=&v"(f.r[2]), "=&v"(f.r[3]), "=&v"(f.r[4]), "=&v"(f.r[5]), "=&v"(f.r[6]), "=&v"(f.r[7]) : "v"(addr) : "memory");
    return f;
}
DI void attn_task_params(int task, int wid, int& d, int& r, int& lqb, int& p) {
    p = task >> 1; const int tk = wid + 8 * (task & 1);
    if (p == 0) { d = 1; r = 0; lqb = 32 * tk; } else if (p == 1) { d = 4; r = tk >> 2; lqb = 32 * (tk & 3); } else { d = 16; r = tk; lqb = 0; }
}
struct ATask { int d, r, lqb, p, cb, ce; };
DI ATask attn_task(int task, int wid, int t0) {
    ATask a; attn_task_params(task, wid, a.d, a.r, a.lqb, a.p);
    a.ce = a.p > 0 ? 4 : 5;
    const int base = t0 + a.r + a.d * (a.lqb - 97);
    const int cb = base >= 0 ? 0 : ((-base + 32 * a.d - 1) >> (5 + 2 * a.p));
    a.cb = cb < a.ce ? cb : a.ce;
    return a;
}
DI void attn_unit(const Params& P, char* lds, int unit) {
    int tid = threadIdx.x; asm volatile("" : "+v"(tid));
    const int lane = tid & 63, wid = __builtin_amdgcn_readfirstlane(tid >> 6), c = lane & 31, hh = lane >> 5;
    const int b = unit >> 7, qb = (unit >> 3) & 15, h = unit & 7, t0 = qb * 512;
    char* st = lds;
    float* bt = (float*)(lds + 512 * 136);
    bf16_t* ksw = (bf16_t*)(bt + 3 * 192) + wid * (64 * LDP);
    bf16_t* vsw = ksw + 32 * LDP;
    const unsigned vtr = (unsigned)(size_t)vsw + (unsigned)(((4 * hh + ((lane & 15) >> 2)) * LDP + 16 * ((lane >> 4) & 1) + 4 * (lane & 3)) * 2);
    const bf16_t* qkv = (const bf16_t*)(P.ws + WS_QKVU) + (size_t)(b * SEQ) * NPROJ;
    constexpr float LOG2E = 1.4426950408889634f;
    for (int i = tid; i < 3 * 192; i += NTHR) {
        const int p = i / 192, j = i % 192 - 32; const int dist = (j < 0 ? 0 : j) << (2 * p); float v = NEG;
        if (j >= (p ? 33 : 0) && j <= 128) {
            const int mult = (p == 0) ? 1 + ((j & 3) == 0) + ((j & 15) == 0) : (p == 1 ? 1 + ((j & 3) == 0) : 1);
            v = P.rel_bias[t5_bucket(dist) * 8 + h] * LOG2E + (mult == 1 ? 0.f : (mult == 2 ? 1.f : 1.5849625007211562f));
        }
        bt[i] = v;
    }
    __syncthreads();
    bf16x8 kfN[4], vvN[4], qfN[4];
    auto issue_kv = [&](const ATask& a, int ch) __attribute__((always_inline)) {
        const int tkv = t0 + a.r + a.d * (a.lqb - 128 + 32 * ch) + ((lane >> 3) << (2 * a.p));
#pragma unroll
        for (int i = 0; i < 4; ++i) {
            int tk = tkv + 8 * i * a.d; tk = tk < 0 ? 0 : tk;
            const bf16_t* rp = qkv + (size_t)(unsigned)tk * NPROJ + 512 + h * 64 + 8 * (lane & 7);
            kfN[i] = *(const bf16x8*)rp; vvN[i] = *(const bf16x8*)(rp + 512);
        }
    };
    auto issue_q = [&](const ATask& a) __attribute__((always_inline)) {
        const bf16_t* qrow = qkv + (size_t)(unsigned)(t0 + a.d * (a.lqb + c) + a.r) * NPROJ + h * 64 + 8 * hh;
#pragma unroll
        for (int s = 0; s < 4; ++s) qfN[s] = *(const bf16x8*)(qrow + 16 * s);
    };
    { const ATask a0 = attn_task(0, wid, t0); issue_q(a0); issue_kv(a0, a0.cb); }
#pragma unroll 1
    for (int task = 0; task < 6; ++task) {
        const ATask cur = attn_task(task, wid, t0);
        if (cur.cb < cur.ce) {
            ATask nxt = cur;
#pragma unroll 1
            for (int t2 = task + 1; t2 < 6; ++t2) { const ATask c2 = attn_task(t2, wid, t0); if (c2.cb < c2.ce) { nxt = c2; break; } }
            const int d = cur.d, r = cur.r, lqb = cur.lqb, p = cur.p;
            int qidx = d * (lqb + c) + r; qidx ^= (qidx >> 5) & 15;
            bf16x8 qf[4];
#pragma unroll
            for (int s = 0; s < 4; ++s) qf[s] = qfN[s];
            issue_q(nxt);
            float m = NEG, l = 0.f; f32x16 o0, o1;
#pragma unroll
            for (int i = 0; i < 16; ++i) { o0[i] = 0.f; o1[i] = 0.f; }
            if (p > 0) {
                const char* sp = st + qidx * 136; const f32x2 ml = *(const f32x2*)(sp + 128); m = ml[0]; l = hh ? 0.f : ml[1];
#pragma unroll
                for (int g = 0; g < 4; ++g) { const u32x2 a = *(const u32x2*)(sp + (8 * g + 4 * hh) * 2), bb = *(const u32x2*)(sp + (32 + 8 * g + 4 * hh) * 2);
                    o0[4 * g] = bflo(a[0]); o0[4 * g + 1] = bfhi(a[0]); o0[4 * g + 2] = bflo(a[1]); o0[4 * g + 3] = bfhi(a[1]); o1[4 * g] = bflo(bb[0]); o1[4 * g + 1] = bfhi(bb[0]); o1[4 * g + 2] = bflo(bb[1]); o1[4 * g + 3] = bfhi(bb[1]); }
            }
#pragma unroll 1
            for (int ch = cur.cb; ch < cur.ce; ++ch) {
                const float* btp = bt + p * 192 + 32 + c + 128 - 32 * ch - 4 * hh;
                LDS_FENCE();
#pragma unroll
                for (int i = 0; i < 4; ++i) { *(bf16x8*)(ksw + (8 * i + (lane >> 3)) * LDP + 8 * (lane & 7)) = kfN[i]; *(bf16x8*)(vsw + (8 * i + (lane >> 3)) * LDP + 8 * (lane & 7)) = vvN[i]; }
                { const bool last = ch + 1 == cur.ce; ATask a = cur; int chn = ch + 1; if (last) { a = nxt; chn = nxt.cb; } issue_kv(a, chn); }
                LDS_FENCE();
                const int lk0 = lqb - 128 + 32 * ch;
                bf16x8 kf[4];
#pragma unroll
                for (int s = 0; s < 4; ++s) kf[s] = *(const bf16x8*)(ksw + c * LDP + 16 * s + 8 * hh);
                f32x16 sa;
#pragma unroll
                for (int i = 0; i < 16; ++i) sa[i] = 0.f;
#pragma unroll
                for (int s = 0; s < 4; ++s) sa = MFMA32(kf[s], qf[s], sa);
                float sc[16]; float mx = NEG;
#pragma unroll
                for (int i = 0; i < 16; ++i) sc[i] = btp[-((i & 3) + 8 * (i >> 2))];
                asm volatile("" : "+v"(sc[0]), "+v"(sc[1]), "+v"(sc[2]), "+v"(sc[3]), "+v"(sc[4]), "+v"(sc[5]), "+v"(sc[6]), "+v"(sc[7]), "+v"(sc[8]), "+v"(sc[9]), "+v"(sc[10]), "+v"(sc[11]), "+v"(sc[12]), "+v"(sc[13]), "+v"(sc[14]), "+v"(sc[15]));
                if (t0 + d * lk0 + r >= 0) {
#pragma unroll
                    for (int i = 0; i < 16; ++i) { const float v = fmaf(sa[i], LOG2E, sc[i]); sc[i] = v; mx = fmaxf(mx, v); }
                } else {
#pragma unroll
                    for (int i = 0; i < 16; ++i) {
                        const int kr = (i & 3) + 8 * (i >> 2) + 4 * hh;
                        const float v = (t0 + d * (lk0 + kr) + r >= 0) ? fmaf(sa[i], LOG2E, sc[i]) : NEG; sc[i] = v; mx = fmaxf(mx, v);
                    }
                }
                mx = xmax32(mx);
                if (!__all(mx - m <= 8.f)) {
                    const float mn = fmaxf(m, mx), alpha = __builtin_amdgcn_exp2f(m - mn); m = mn; l *= alpha;
#pragma unroll
                    for (int i = 0; i < 16; ++i) { o0[i] *= alpha; o1[i] *= alpha; }
                }
                float ps = 0.f;
#pragma unroll
                for (int i = 0; i < 16; ++i) { sc[i] = __builtin_amdgcn_exp2f(sc[i] - m); ps += sc[i]; }
                l += ps;
                const VFrag vf = v_tr_read(vtr);
#pragma unroll
                for (int s = 0; s < 2; ++s) {
                    const u32x4 pw = (u32x4){pk2(sc[8 * s], sc[8 * s + 1]), pk2(sc[8 * s + 2], sc[8 * s + 3]), pk2(sc[8 * s + 4], sc[8 * s + 5]), pk2(sc[8 * s + 6], sc[8 * s + 7])};
                    const bf16x8 pf = __builtin_bit_cast(bf16x8, pw);
                    const u32x4 v0 = (u32x4){vf.r[4 * s][0], vf.r[4 * s][1], vf.r[4 * s + 1][0], vf.r[4 * s + 1][1]}, v1 = (u32x4){vf.r[4 * s + 2][0], vf.r[4 * s + 2][1], vf.r[4 * s + 3][0], vf.r[4 * s + 3][1]};
                    o0 = MFMA32(__builtin_bit_cast(bf16x8, v0), pf, o0); o1 = MFMA32(__builtin_bit_cast(bf16x8, v1), pf, o1);
                }
            }
            l = xsum32(l);
            char* sp = st + qidx * 136;
            if (hh == 0) *(f32x2*)(sp + 128) = (f32x2){m, l};
#pragma unroll
            for (int g = 0; g < 4; ++g) { *(u32x2*)(sp + (8 * g + 4 * hh) * 2) = (u32x2){pk2(o0[4 * g], o0[4 * g + 1]), pk2(o0[4 * g + 2], o0[4 * g + 3])}; *(u32x2*)(sp + (32 + 8 * g + 4 * hh) * 2) = (u32x2){pk2(o1[4 * g], o1[4 * g + 1]), pk2(o1[4 * g + 2], o1[4 * g + 3])}; }
        }
        if (task & 1) __syncthreads();
    }
    {
        const char* sp = st + (tid ^ ((tid >> 5) & 15)) * 136; const float inv = 1.f / *(const float*)(sp + 132);
        bf16_t* op = (bf16_t*)(P.ws + WS_MERGED) + (size_t)(b * SEQ + t0 + tid) * 1024 + h * 64; float ss = 0.f;
#pragma unroll
        for (int i = 0; i < 8; ++i) { const u32x2 wa = *(const u32x2*)(sp + 16 * i), wb = *(const u32x2*)(sp + 16 * i + 8); const unsigned w[4] = {wa[0], wa[1], wb[0], wb[1]}; float v[8];
#pragma unroll
            for (int j = 0; j < 4; ++j) { v[2 * j] = bflo(w[j]) * inv; v[2 * j + 1] = bfhi(w[j]) * inv; ss += v[2 * j] * v[2 * j] + v[2 * j + 1] * v[2 * j + 1]; }
            *(u32x4*)(op + 8 * i) = (u32x4){pk2(v[0], v[1]), pk2(v[2], v[3]), pk2(v[4], v[5]), pk2(v[6], v[7])}; }
        ((float*)(P.ws + WS_ATTSQ))[(size_t)(b * SEQ + t0 + tid) * 8 + h] = ss;
    }
    __syncthreads();
}

DI u32x2 tr_read1(unsigned addr) { u32x2 r; asm volatile("ds_read_b64_tr_b16 %0, %1\n\ts_waitcnt lgkmcnt(0)" : "=&v"(r) : "v"(addr) : "memory"); return r; }
struct STr16 { u32x2 r[16]; };
DI STr16 s_tr_read(unsigned addr) {
    STr16 f;
    asm volatile("ds_read_b64_tr_b16 %0, %16\n\tds_read_b64_tr_b16 %1, %16 offset:576\n\tds_read_b64_tr_b16 %2, %16 offset:4608\n\tds_read_b64_tr_b16 %3, %16 offset:5184\n\t"
                 "ds_read_b64_tr_b16 %4, %16 offset:9216\n\tds_read_b64_tr_b16 %5, %16 offset:9792\n\tds_read_b64_tr_b16 %6, %16 offset:13824\n\tds_read_b64_tr_b16 %7, %16 offset:14400\n\t"
                 "ds_read_b64_tr_b16 %8, %16 offset:32\n\tds_read_b64_tr_b16 %9, %16 offset:608\n\tds_read_b64_tr_b16 %10, %16 offset:4640\n\tds_read_b64_tr_b16 %11, %16 offset:5216\n\t"
                 "ds_read_b64_tr_b16 %12, %16 offset:9248\n\tds_read_b64_tr_b16 %13, %16 offset:9824\n\tds_read_b64_tr_b16 %14, %16 offset:13856\n\tds_read_b64_tr_b16 %15, %16 offset:14432\n\ts_waitcnt lgkmcnt(0)"
                 : "=&v"(f.r[0]), "=&v"(f.r[1]), "=&v"(f.r[2]), "=&v"(f.r[3]), "=&v"(f.r[4]), "=&v"(f.r[5]), "=&v"(f.r[6]), "=&v"(f.r[7]),
                   "=&v"(f.r[8]), "=&v"(f.r[9]), "=&v"(f.r[10]), "=&v"(f.r[11]), "=&v"(f.r[12]), "=&v"(f.r[13]), "=&v"(f.r[14]), "=&v"(f.r[15]) : "v"(addr) : "memory");
    return f;
}
struct SsmConst { float a_re, a_im; bf16x8 bq[4], cq[4]; f32x4 dsk; };
struct SsmU { bf16x8 ufa[4]; u32x2 uwa[4][2]; };
template <bool FINAL>
DI void ssm_load_const(const Params& P, int g, int lane, SsmConst& C) {
    const int c32 = lane & 31, hh = lane >> 5, fr = lane & 15, fq = lane >> 4;
    const float* ABAR = (const float*)(P.ws + WS_ABAR);
    C.a_re = ABAR[g * 128 + lane]; C.a_im = ABAR[g * 128 + 64 + lane];
#pragma unroll
    for (int tau = 0; tau < 4; ++tau) C.bq[tau] = *(const bf16x8*)((const bf16_t*)(P.ws + WS_BCAT) + (size_t)(g * 128 + 32 * tau + c32) * 16 + 8 * hh);
    C.dsk = (f32x4){0.f, 0.f, 0.f, 0.f};
    if (FINAL) {
#pragma unroll
        for (int s = 0; s < 4; ++s) C.cq[s] = *(const bf16x8*)((const bf16_t*)(P.ws + WS_CCAT) + (size_t)(g * 16 + fr) * 128 + 32 * s + 8 * fq);
        C.dsk = *(const f32x4*)(P.ssm_d + g * 16 + 4 * fq);
    }
}
template <bool FINAL>
DI void ssm_load_u(const Params& P, int b, int k, int g, int lane, SsmU& U) {
    const int c32 = lane & 31, hh = lane >> 5, fr = lane & 15, fq = lane >> 4;
    const bf16_t* ubase = (const bf16_t*)(P.ws + WS_QKVU) + (size_t)(b * SEQ + k * 128) * NPROJ + 1536 + 16 * g;
#pragma unroll
    for (int sub = 0; sub < 4; ++sub) {
        U.ufa[sub] = *(const bf16x8*)(ubase + (size_t)(32 * sub + c32) * NPROJ + 8 * hh);
        if (FINAL) { U.uwa[sub][0] = *(const u32x2*)(ubase + (size_t)(32 * sub + fr) * NPROJ + 4 * fq); U.uwa[sub][1] = *(const u32x2*)(ubase + (size_t)(32 * sub + 16 + fr) * NPROJ + 4 * fq); }
    }
}
template <bool FINAL>
DI void ssm_task(const Params& P, float* buf, int b, int k, int g, int lane, float& s_re, float& s_im, const SsmConst& C, const SsmU& U) {
    const int c32 = lane & 31, hh = lane >> 5, fr = lane & 15, fq = lane >> 4;
    const float a_re = C.a_re, a_im = C.a_im;
    const unsigned str = (unsigned)(size_t)buf + (unsigned)((8 * fq + ((lane & 15) >> 2)) * (SSM_PITCH * 4) + (lane & 3) * 8);
#pragma unroll
    for (int sub = 0; sub < 4; ++sub) {
        const bf16x8 uf = U.ufa[sub];
        f32x16 zr0, zr1, zi0, zi1;
#pragma unroll
        for (int i = 0; i < 16; ++i) { zr0[i] = 0.f; zr1[i] = 0.f; zi0[i] = 0.f; zi1[i] = 0.f; }
        zr0 = MFMA32(uf, C.bq[0], zr0); zr1 = MFMA32(uf, C.bq[1], zr1); zi0 = MFMA32(uf, C.bq[2], zi0); zi1 = MFMA32(uf, C.bq[3], zi1);
        float* rre = buf + lane * SSM_PITCH; float* rim = buf + (64 + lane) * SSM_PITCH;
#pragma unroll
        for (int gq = 0; gq < 4; ++gq) {
            float re8[8], im8[8];
#pragma unroll
            for (int j = 0; j < 4; ++j) {
                const auto tr = __builtin_amdgcn_permlane32_swap(__float_as_uint(zr0[4 * gq + j]), __float_as_uint(zr1[4 * gq + j]), false, false);
                const auto ti = __builtin_amdgcn_permlane32_swap(__float_as_uint(zi0[4 * gq + j]), __float_as_uint(zi1[4 * gq + j]), false, false);
                re8[j] = __uint_as_float(tr[0]); re8[4 + j] = __uint_as_float(tr[1]); im8[j] = __uint_as_float(ti[0]); im8[4 + j] = __uint_as_float(ti[1]);
            }
#pragma unroll
            for (int half = 0; half < 2; ++half) {
                const int tq = 2 * gq + half; float sr[4], si[4];
#pragma unroll
                for (int j = 0; j < 4; ++j) { const float nr = fmaf(a_re, s_re, fmaf(-a_im, s_im, re8[4 * half + j])), ni = fmaf(a_re, s_im, fmaf(a_im, s_re, im8[4 * half + j])); s_re = nr; s_im = ni; sr[j] = nr; si[j] = ni; }
                if (FINAL) { *(u32x2*)((bf16_t*)rre + 4 * tq) = (u32x2){pk2(sr[0], sr[1]), pk2(sr[2], sr[3])}; *(u32x2*)((bf16_t*)rim + 4 * tq) = (u32x2){pk2(si[0], si[1]), pk2(si[2], si[3])}; }
            }
        }
        if (FINAL) {
            LDS_FENCE();
            const STr16 sf = s_tr_read(str);
#pragma unroll
            for (int tt = 0; tt < 2; ++tt) {
                f32x4 y = (f32x4){0.f, 0.f, 0.f, 0.f};
#pragma unroll
                for (int s = 0; s < 4; ++s) { const u32x4 w = (u32x4){sf.r[8 * tt + 2 * s][0], sf.r[8 * tt + 2 * s][1], sf.r[8 * tt + 2 * s + 1][0], sf.r[8 * tt + 2 * s + 1][1]}; y = MFMA16(C.cq[s], __builtin_bit_cast(bf16x8, w), y); }
                const int tl = 32 * sub + 16 * tt + fr;
                const u32x2 uw = U.uwa[sub][tt];
                const float v0 = gelu_tanh(y[0] + C.dsk[0] * bflo(uw[0])), v1 = gelu_tanh(y[1] + C.dsk[1] * bfhi(uw[0])), v2 = gelu_tanh(y[2] + C.dsk[2] * bflo(uw[1])), v3 = gelu_tanh(y[3] + C.dsk[3] * bfhi(uw[1]));
                *(u32x2*)((bf16_t*)(P.ws + WS_YGL) + (size_t)(b * SEQ + k * 128 + tl) * 512 + 16 * g + 4 * fq) = (u32x2){pk2(v0, v1), pk2(v2, v3)};
            }
        }
    }
    if (!FINAL) { float* E = (float*)(P.ws + WS_E) + (size_t)((b * 64 + k) * 32 + g) * 128; E[lane] = s_re; E[64 + lane] = s_im; }
    LDS_FENCE();
}

DI void p2_mixer(const Params& P, char* lds) {
    const int tid = opaque_tid(), lane = tid & 63, wid = tid >> 6, G = gridDim.x;
    for (int item = blockIdx.x; item < 512; item += G) attn_unit(P, lds, item < 256 ? item : (item ^ (15 << 3)));
    float* buf = (float*)(lds + wid * SSM_WAVE_LDS);
    int wt = blockIdx.x * 8 + wid;
    if (wt < 8192) {
        const int g = wt & 31; SsmConst C; ssm_load_const<false>(P, g, lane, C);
        SsmU U; ssm_load_u<false>(P, wt >> 11, (wt >> 5) & 63, g, lane, U);
#pragma unroll 1
        for (; wt < 8192; wt += G * 8) {
            const int wn = wt + G * 8 < 8192 ? wt + G * 8 : wt; SsmU Un; ssm_load_u<false>(P, wn >> 11, (wn >> 5) & 63, wn & 31, lane, Un);
            if ((G * 8) & 31) ssm_load_const<false>(P, wt & 31, lane, C);
            float z_re = 0.f, z_im = 0.f; ssm_task<false>(P, buf, wt >> 11, (wt >> 5) & 63, wt & 31, lane, z_re, z_im, C, U);
            U = Un;
        }
    }
}

DI void route_token(const float* srow, const float* rbias, int lane, int& e_out, float& g_out) {
    const f32x4 s4 = *(const f32x4*)(srow + 4 * lane); const f32x4 rb = *(const f32x4*)(rbias + 4 * lane);
    float w0 = s4[0] + rb[0], w1 = s4[1] + rb[1], w2 = s4[2] + rb[2], w3 = s4[3] + rb[3];
    float m1, m2;
    { const float a = fmaxf(w0, w1), bb = fminf(w0, w1), cc = fmaxf(w2, w3), dd = fminf(w2, w3); m1 = fmaxf(a, cc); m2 = fmaxf(fminf(a, cc), fmaxf(bb, dd)); }
#define ROUTE_MERGE2(CTRL) { const float o1 = dppf<CTRL>(m1), o2 = dppf<CTRL>(m2); const float n1 = fmaxf(m1, o1), n2 = fmaxf(fminf(m1, o1), fmaxf(m2, o2)); m1 = n1; m2 = n2; }
    ROUTE_MERGE2(DPP_X1) ROUTE_MERGE2(DPP_X2) ROUTE_MERGE2(DPP_HM)
#undef ROUTE_MERGE2
    const float gs = m1 + m2; const int mygrp = lane >> 3; int rank = 0;
#pragma unroll
    for (int j = 0; j < 8; ++j) { const float gj = rdlane(gs, 8 * j); rank += ((gj > gs) || (gj == gs && j < mygrp)) ? 1 : 0; }
    const float NINF = -__builtin_inff();
    if (rank >= 4) { w0 = NINF; w1 = NINF; w2 = NINF; w3 = NINF; }
    int my_e = 0; float my_s = 0.f;
#pragma unroll 1
    for (int k = 0; k < TOPK; ++k) {
        float bv = w0; int bi = 0;
        if (w1 > bv) { bv = w1; bi = 1; } if (w2 > bv) { bv = w2; bi = 2; } if (w3 > bv) { bv = w3; bi = 3; }
        float rm = bv; rm = fmaxf(rm, dppf<DPP_X1>(rm)); rm = fmaxf(rm, dppf<DPP_X2>(rm)); rm = fmaxf(rm, dppf<DPP_HM>(rm)); rm = fmaxf(rm, dppf<DPP_RM>(rm));
        const float wmax = fmaxf(fmaxf(rdlane(rm, 0), rdlane(rm, 16)), fmaxf(rdlane(rm, 32), rdlane(rm, 48)));
        const unsigned long long bal = __ballot(bv == wmax);
        const int owner = __builtin_amdgcn_readfirstlane((int)__ffsll((long long)bal) - 1);
        const int sub = __builtin_amdgcn_readlane(bi, owner), idx = 4 * owner + sub;
        const float mys = bi == 0 ? s4[0] : (bi == 1 ? s4[1] : (bi == 2 ? s4[2] : s4[3]));
        const float sval = rdlane(mys, owner);
        if (lane == owner) { if (sub == 0) w0 = NINF; else if (sub == 1) w1 = NINF; else if (sub == 2) w2 = NINF; else w3 = NINF; }
        if (lane == k) { my_e = idx; my_s = sval; }
    }
    float sum = (lane < 8) ? my_s : 0.f;
    sum += dppf<DPP_X1>(sum); sum += dppf<DPP_X2>(sum); sum += dppf<DPP_HM>(sum);
    e_out = my_e; g_out = my_s / sum * 2.5f;
}

DI void p3a_ssm(const Params& P, char* lds) {
    const int tid = opaque_tid(), lane = tid & 63, wid = tid >> 6;
    float* buf = (float*)(lds + wid * SSM_WAVE_LDS);
    const float* ABARL = (const float*)(P.ws + WS_ABARL); const float* E = (const float*)(P.ws + WS_E);
#pragma unroll 1
    for (int job = blockIdx.x * 8 + wid; job < 2048; job += gridDim.x * 8) {
        const int g = job & 31, m = (job >> 5) & 15, b = job >> 9, k4 = 4 * m;
        SsmConst C; ssm_load_const<true>(P, g, lane, C);
        SsmU U; ssm_load_u<true>(P, b, k4, g, lane, U);
        const float lr = ABARL[g * 128 + lane], li = ABARL[g * 128 + 64 + lane];
        float cr = 0.f, ci = 0.f; float er[16], ei[16], fr[16], fi[16];
        const float* eb = E + (size_t)(b * 64 * 32 + g) * 128 + lane;
#define SSM_CARRY_LOAD(R, I, K0) { _Pragma("unroll") for (int j = 0; j < 16; ++j) { const int kj = (K0) + j; const float* ep = eb + (size_t)(kj < 63 ? kj : 63) * (32 * 128); R[j] = ep[0]; I[j] = ep[64]; } }
#define SSM_CARRY_STEP(R, I, K0) { _Pragma("unroll") for (int j = 0; j < 16; ++j) { const bool ok = (K0) + j < k4; float nr = fmaf(lr, cr, fmaf(-li, ci, R[j])); asm volatile("" : "+v"(nr)); const float ni = fmaf(lr, ci, fmaf(li, cr, I[j])); cr = ok ? nr : cr; ci = ok ? ni : ci; } }
        if (k4 > 0) {
            SSM_CARRY_LOAD(er, ei, 0)
#pragma unroll 1
            for (int k0 = 0; k0 < k4; k0 += 32) {
                SSM_CARRY_LOAD(fr, fi, k0 + 16)
                SSM_CARRY_STEP(er, ei, k0)
                SSM_CARRY_LOAD(er, ei, k0 + 32)
                SSM_CARRY_STEP(fr, fi, k0 + 16)
            }
        }
#undef SSM_CARRY_LOAD
#undef SSM_CARRY_STEP
#pragma unroll 1
        for (int i = 0; i < 4; ++i) {
            SsmU Un; ssm_load_u<true>(P, b, k4 + (i < 3 ? i + 1 : i), g, lane, Un);
            ssm_task<true>(P, buf, b, k4 + i, g, lane, cr, ci, C, U);
            U = Un;
        }
    }
}
struct EpiGluE {
    static constexpr bool MID = false, PREP = false;
    const bf16_t* ygl; bf16_t* merged; const float* bglu; float* ssq;
    DI void operator()(const f32x4 (&acc)[2][2][4][2], const pg8::Unit& u, int wr, int wc, int fr, int fq) const {
        f32x4 bv[2][2];
#pragma unroll
        for (int bj = 0; bj < 2; ++bj)
#pragma unroll
            for (int n = 0; n < 2; ++n) bv[bj][n] = *(const f32x4*)(bglu + 256 * u.pn + 128 * bj + 32 * wc + 8 * fq + 4 * n);
#pragma unroll
        for (int ai = 0; ai < 2; ++ai)
#pragma unroll
            for (int m = 0; m < 4; ++m) {
                const size_t row = (size_t)256 * u.pm + 128 * ai + 64 * wr + 16 * m + fr; float ss = 0.f;
#pragma unroll
                for (int bj = 0; bj < 2; ++bj) {
                    const int col = 256 * u.pn + 128 * bj + 32 * wc + 8 * fq; const u32x4 yw = *(const u32x4*)(ygl + row * 512 + col);
                    const f32x4 z0 = acc[ai][bj][m][0] + bv[bj][0], z1 = acc[ai][bj][m][1] + bv[bj][1];
                    const float o0 = bflo(yw[0]) * sigmoidf_(z0[0]), o1 = bfhi(yw[0]) * sigmoidf_(z0[1]), o2 = bflo(yw[1]) * sigmoidf_(z0[2]), o3 = bfhi(yw[1]) * sigmoidf_(z0[3]);
                    const float o4 = bflo(yw[2]) * sigmoidf_(z1[0]), o5 = bfhi(yw[2]) * sigmoidf_(z1[1]), o6 = bflo(yw[3]) * sigmoidf_(z1[2]), o7 = bfhi(yw[3]) * sigmoidf_(z1[3]);
                    ss += (o0 * o0 + o1 * o1) + (o2 * o2 + o3 * o3) + (o4 * o4 + o5 * o5) + (o6 * o6 + o7 * o7);
                    *(u32x4*)(merged + row * 1024 + 512 + col) = (u32x4){pk2(o0, o1), pk2(o2, o3), pk2(o4, o5), pk2(o6, o7)};
                }
                ss = xsum16(ss); ss = xsum32(ss);
                if (fq == 0) ssq[row * 8 + u.pn * 4 + wc] = ss;
                asm volatile("" ::: "memory");
            }
    }
};
DI void p3b_glu(const Params& P, char* lds) {
    pg8::DenseOrder S; S.init(P.ws + WS_YGL, P.ws + WS_WGLU, T, 512, 512, gridDim.x, blockIdx.x);
    EpiGluE E{(const bf16_t*)(P.ws + WS_YGL), (bf16_t*)(P.ws + WS_MERGED), P.b_glu, (float*)(P.ws + WS_SSQ)};
    pg8::gemm_phase<EpiGluE, pg8::DenseOrder, false>((LAS unsigned char*)lds, 512, S, E);
}
struct EpiResidE {
    static constexpr bool MID = false, PREP = false;
    bf16_t* io; const float* ada; int goff;
    DI void operator()(const f32x4 (&acc)[2][2][4][2], const pg8::Unit& u, int wr, int wc, int fr, int fq) const {
        const float* gate = ada + ((256 * u.pm) >> 13) * 6144 + goff + 256 * u.pn + 32 * wc + 8 * fq;
        f32x4 gv[2][2];
#pragma unroll
        for (int bj = 0; bj < 2; ++bj)
#pragma unroll
            for (int n = 0; n < 2; ++n) gv[bj][n] = *(const f32x4*)(gate + 128 * bj + 4 * n);
#pragma unroll
        for (int ai = 0; ai < 2; ++ai)
#pragma unroll
            for (int m = 0; m < 4; ++m) {
                bf16_t* p = io + ((size_t)256 * u.pm + 128 * ai + 64 * wr + 16 * m + fr) * 1024 + 256 * u.pn + 32 * wc + 8 * fq; u32x4 xw[2];
#pragma unroll
                for (int bj = 0; bj < 2; ++bj) xw[bj] = *(const u32x4*)(p + 128 * bj);
#pragma unroll
                for (int bj = 0; bj < 2; ++bj) {
                    const f32x4 a0 = acc[ai][bj][m][0] * gv[bj][0], a1 = acc[ai][bj][m][1] * gv[bj][1]; const u32x4 w = xw[bj];
                    *(u32x4*)(p + 128 * bj) = (u32x4){pk2(ALPHA * bflo(w[0]) + a0[0], ALPHA * bfhi(w[0]) + a0[1]), pk2(ALPHA * bflo(w[1]) + a0[2], ALPHA * bfhi(w[1]) + a0[3]),
                                                      pk2(ALPHA * bflo(w[2]) + a1[0], ALPHA * bfhi(w[2]) + a1[1]), pk2(ALPHA * bflo(w[3]) + a1[2], ALPHA * bfhi(w[3]) + a1[3])};
                }
                asm volatile("" ::: "memory");
            }
    }
};
struct EpiOutProjE {
    static constexpr bool MID = true, PREP = true;
    const float* x; bf16_t* out; const float* ada; const float* attsq; const float* ssq; LAS float* tab;
    DI void prep(const pg8::Unit& u, int tid) const {
        if (tid < 256) {
            const size_t row = (size_t)256 * u.pm + tid;
            const f32x4 p0 = *(const f32x4*)(attsq + row * 8), p1 = *(const f32x4*)(attsq + row * 8 + 4), q0 = *(const f32x4*)(ssq + row * 8), q1 = *(const f32x4*)(ssq + row * 8 + 4);
            const float ra = rsqrtf((((p0[0] + p0[1]) + (p0[2] + p0[3])) + ((p1[0] + p1[1]) + (p1[2] + p1[3]))) * (1.f / 512.f) + EPS);
            const float rs = rsqrtf((((q0[0] + q0[1]) + (q0[2] + q0[3])) + ((q1[0] + q1[1]) + (q1[2] + q1[3]))) * (1.f / 512.f) + EPS);
            *(LAS f32x2*)(tab + (u.aux * 256 + tid) * 2) = (f32x2){ra, rs};
        }
    }
    DI void mid(f32x4 (&acc)[2][2][4][2], const pg8::Unit& u, int wr, int wc, int fr, int fq) const {
#pragma unroll
        for (int ai = 0; ai < 2; ++ai)
#pragma unroll
            for (int m = 0; m < 4; ++m) {
                const f32x2 r2 = *(const LAS f32x2*)(tab + (u.aux * 256 + 128 * ai + 64 * wr + 16 * m + fr) * 2); const float f = r2[0] * __builtin_amdgcn_rcpf(r2[1]);
#pragma unroll
                for (int bj = 0; bj < 2; ++bj)
#pragma unroll
                    for (int n = 0; n < 2; ++n) acc[ai][bj][m][n] *= f;
            }
    }
    DI void operator()(const f32x4 (&acc)[2][2][4][2], const pg8::Unit& u, int wr, int wc, int fr, int fq) const {
        const float* gate = ada + ((256 * u.pm) >> 13) * 6144 + 2048 + 256 * u.pn + 32 * wc + 8 * fq;
        f32x4 gv[2][2];
#pragma unroll
        for (int bj = 0; bj < 2; ++bj)
#pragma unroll
            for (int n = 0; n < 2; ++n) gv[bj][n] = *(const f32x4*)(gate + 128 * bj + 4 * n);
#pragma unroll
        for (int ai = 0; ai < 2; ++ai)
#pragma unroll
            for (int m = 0; m < 4; ++m) {
                const int rl = 128 * ai + 64 * wr + 16 * m + fr; const size_t row = (size_t)256 * u.pm + rl; const size_t o = row * 1024 + 256 * u.pn + 32 * wc + 8 * fq; f32x4 xv[2][2];
                const float r_s = tab[(u.aux * 256 + rl) * 2 + 1];
#pragma unroll
                for (int bj = 0; bj < 2; ++bj)
#pragma unroll
                    for (int n = 0; n < 2; ++n) xv[bj][n] = *(const f32x4*)(x + o + 128 * bj + 4 * n);
#pragma unroll
                for (int bj = 0; bj < 2; ++bj) {
                    const f32x4 v0 = ALPHA * xv[bj][0] + (gv[bj][0] * r_s) * acc[ai][bj][m][0], v1 = ALPHA * xv[bj][1] + (gv[bj][1] * r_s) * acc[ai][bj][m][1];
                    *(u32x4*)(out + o + 128 * bj) = (u32x4){pk2(v0[0], v0[1]), pk2(v0[2], v0[3]), pk2(v1[0], v1[1]), pk2(v1[2], v1[3])};
                }
                asm volatile("" ::: "memory");
            }
    }
};
DI void p3d_outproj(const Params& P, char* lds) {
    pg8::DenseOrder S; S.init(P.ws + WS_MERGED, P.ws + WS_WOUT, T, 1024, 1024, gridDim.x, blockIdx.x);
    EpiOutProjE E{P.x, (bf16_t*)(P.ws + WS_XZ), (const float*)(P.ws + WS_ADA), (const float*)(P.ws + WS_ATTSQ), (const float*)(P.ws + WS_SSQ), (LAS float*)((LAS unsigned char*)lds + P5TAB_OFF)};
    pg8::gemm_phase<EpiOutProjE, pg8::DenseOrder, false>((LAS unsigned char*)lds, 1024, S, E);
}
DI void p3e_ln1(const Params& P) {
    const int tid = opaque_tid(), lane = tid & 63, wid = tid >> 6;
    bf16_t* H2 = (bf16_t*)(P.ws + WS_H2); bf16_t* XZ = (bf16_t*)(P.ws + WS_XZ);
    for (int row = blockIdx.x * 8 + wid; row < T; row += gridDim.x * 8) {
        const float* ADA = (const float*)(P.ws + WS_ADA) + (row >> 13) * 6144;
        bf16_t* vp = XZ + (size_t)row * 1024 + 8 * lane; float v[16]; float s = 0.f;
#pragma unroll
        for (int j = 0; j < 2; ++j) { const u32x4 w = *(const u32x4*)(vp + 512 * j);
#pragma unroll
            for (int i = 0; i < 4; ++i) { v[8 * j + 2 * i] = bflo(w[i]); v[8 * j + 2 * i + 1] = bfhi(w[i]); s += v[8 * j + 2 * i] + v[8 * j + 2 * i + 1]; } }
        const float mean = wave_sum(s) * (1.f / 1024.f); float q = 0.f;
#pragma unroll
        for (int i = 0; i < 16; ++i) { v[i] -= mean; q += v[i] * v[i]; }
        const float rstd = rsqrtf(wave_sum(q) * (1.f / 1024.f) + EPS);
#pragma unroll
        for (int j = 0; j < 2; ++j) {
            const int col = 8 * lane + 512 * j; float x1[8], hv[8];
#pragma unroll
            for (int i = 0; i < 2; ++i) {
                const f32x4 g = *(const f32x4*)(P.ln1_g + col + 4 * i), bb = *(const f32x4*)(P.ln1_b + col + 4 * i), sc2 = *(const f32x4*)(ADA + 4096 + col + 4 * i), sh2 = *(const f32x4*)(ADA + 3072 + col + 4 * i);
#pragma unroll
                for (int t = 0; t < 4; ++t) { x1[4 * i + t] = v[8 * j + 4 * i + t] * rstd * g[t] + bb[t]; hv[4 * i + t] = x1[4 * i + t] * (1.f + sc2[t]) + sh2[t]; }
            }
            *(u32x4*)(vp + 512 * j) = (u32x4){pk2(x1[0], x1[1]), pk2(x1[2], x1[3]), pk2(x1[4], x1[5]), pk2(x1[6], x1[7])};
            *(u32x4*)(H2 + (size_t)row * 1024 + col) = (u32x4){pk2(hv[0], hv[1]), pk2(hv[2], hv[3]), pk2(hv[4], hv[5]), pk2(hv[6], hv[7])};
        }
    }
}
struct EpiRouterSharedE {
    static constexpr bool MID = false, PREP = false;
    float* sc; bf16_t* hids;
    DI void operator()(const f32x4 (&acc)[2][2][4][2], const pg8::Unit& u, int wr, int wc, int fr, int fq) const {
#pragma unroll
        for (int ai = 0; ai < 2; ++ai)
#pragma unroll
            for (int m = 0; m < 4; ++m) {
                const size_t row = (size_t)256 * u.pm + 128 * ai + 64 * wr + 16 * m + fr;
                if (u.pn == 0) {
#pragma unroll
                    for (int bj = 0; bj < 2; ++bj)
#pragma unroll
                        for (int n = 0; n < 2; ++n) { const f32x4 v = acc[ai][bj][m][n]; *(f32x4*)(sc + row * 256 + 128 * bj + 32 * wc + 8 * fq + 4 * n) = (f32x4){sigmoidf_(v[0]), sigmoidf_(v[1]), sigmoidf_(v[2]), sigmoidf_(v[3])}; }
                } else {
                    const f32x4 g0 = acc[ai][0][m][0], g1 = acc[ai][0][m][1], u0 = acc[ai][1][m][0], u1 = acc[ai][1][m][1];
                    *(u32x4*)(hids + row * 256 + 128 * (u.pn - 1) + 32 * wc + 8 * fq) = (u32x4){pk2(siluf_(g0[0]) * u0[0], siluf_(g0[1]) * u0[1]), pk2(siluf_(g0[2]) * u0[2], siluf_(g0[3]) * u0[3]),
                                                                                                 pk2(siluf_(g1[0]) * u1[0], siluf_(g1[1]) * u1[1]), pk2(siluf_(g1[2]) * u1[2], siluf_(g1[3]) * u1[3])};
                }
                asm volatile("" ::: "memory");
            }
    }
};
DI void p3f_router_shared(const Params& P, char* lds) {
    pg8::DenseOrder S; S.init(P.ws + WS_H2, P.ws + WS_WR, T, 768, 1024, gridDim.x, blockIdx.x);
    EpiRouterSharedE E{(float*)(P.ws + WS_SCORES), (bf16_t*)(P.ws + WS_HIDS)};
    pg8::gemm_phase<EpiRouterSharedE, pg8::DenseOrder, false>((LAS unsigned char*)lds, 1024, S, E);
    const int nb = fill_blocks(), G = gridDim.x;
    if (nb > 0 && nb < G && (int)blockIdx.x >= G - nb) conv_experts_block(P, lds, CONV_NT - nb * FILL_TILES_PER_WG + ((int)blockIdx.x - (G - nb)), CONV_NT, nb);
}
DI void p3g_route_shared_down(const Params& P, char* lds) {
    const int tid = opaque_tid(), lane = tid & 63, wid = tid >> 6;
    int* hist = (int*)(lds + P5TAB_OFF); int* base = hist + 256; int* hist2 = base + 256; int* rt_e = hist2 + 256; float* rt_g = (float*)(rt_e + 1024);
    for (int pm = blockIdx.x; pm < 256; pm += gridDim.x) {
        const int row0 = pm * 128; const float* SC = (const float*)(P.ws + WS_SCORES) + (size_t)row0 * 256;
        __syncthreads();
        if (tid < 256) hist[tid] = 0;
        __syncthreads();
        for (int tl = wid * 16; tl < wid * 16 + 16; ++tl) {
            int e; float gte; route_token(SC + (size_t)tl * 256, P.router_bias, lane, e, gte);
            if (lane < 8) { rt_e[tl * 8 + lane] = e; rt_g[tl * 8 + lane] = gte; atomicAdd(&hist[e], 1); }
        }
        __syncthreads();
        if (tid < 256) { const int cnt = hist[tid]; base[tid] = cnt ? atomicAdd((int*)(P.ws + WS_CNT) + tid, cnt) : 0; hist2[tid] = 0; }
        __syncthreads();
        for (int a = tid; a < 1024; a += NTHR) {
            const int e = rt_e[a]; const int pos = base[e] + atomicAdd(&hist2[e], 1); const int slot = (row0 + (a >> 3)) * 8 + (a & 7);
            ((int*)(P.ws + WS_BINS))[(size_t)e * T + pos] = slot; ((float*)(P.ws + WS_BING))[(size_t)e * T + pos] = rt_g[a]; ((int*)(P.ws + WS_EIDX))[slot] = e; ((int*)(P.ws + WS_EPOS))[slot] = pos;
        }
    }
    __syncthreads();
    pg8::DenseOrder S; S.init(P.ws + WS_HIDS, P.ws + WS_WSD, T, 1024, 256, gridDim.x, blockIdx.x);
    EpiResidE E{(bf16_t*)(P.ws + WS_XZ), (const float*)(P.ws + WS_ADA), 5120};
    pg8::gemm_phase<EpiResidE, pg8::DenseOrder, false>((LAS unsigned char*)lds, 256, S, E);
}

DI void moe_tables(const Params& P, char* lds) {
    LAS int* tstart = (LAS int*)((LAS unsigned char*)lds + P5TAB_OFF); LAS int* estart = tstart + 260;
    const int tid = opaque_tid();
    if (tid < 64) {
        const int* gc = (const int*)(P.ws + WS_CNT) + 4 * tid; const int c0 = gc[0], c1 = gc[1], c2 = gc[2], c3 = gc[3];
        const int t0 = (c0 + 255) >> 8, t1 = (c1 + 255) >> 8, t2 = (c2 + 255) >> 8, t3 = (c3 + 255) >> 8;
        int cs = c0 + c1 + c2 + c3, ts = t0 + t1 + t2 + t3; const int cown = cs, town = ts;
#pragma unroll
        for (int o = 1; o < 64; o <<= 1) { const int a = __shfl_up(cs, o), b = __shfl_up(ts, o); if (tid >= o) { cs += a; ts += b; } }
        int ce = cs - cown, te = ts - town;
        estart[4 * tid] = ce; tstart[4 * tid] = te; ce += c0; te += t0; estart[4 * tid + 1] = ce; tstart[4 * tid + 1] = te; ce += c1; te += t1;
        estart[4 * tid + 2] = ce; tstart[4 * tid + 2] = te; ce += c2; te += t2; estart[4 * tid + 3] = ce; tstart[4 * tid + 3] = te;
        if (tid == 63) { estart[256] = cs; tstart[256] = ts; }
    }
    __syncthreads();
}
struct MoeOrder {
    static constexpr bool RAGGED = true;
    const LAS int* tstart; const LAS int* estart; const char* Abase; const char* Bbase; const int* bins; int nunits, per, G, vb, mode;
    DI bool next(int i, pg8::Unit& u) const {
        const long L = (long)i * G + vb; if (L >= (long)nunits) return false;
        const int tile = (int)(L / per), sub = (int)(L % per);
        int lo = 0, hi = NEXP;
        while (hi - lo > 1) { const int mid = (lo + hi) >> 1; if (tstart[mid] <= tile) lo = mid; else hi = mid; }
        const int e = lo, rb = tile - tstart[e], cnt = estart[e + 1] - estart[e];
        u.rows = (cnt - 256 * rb) < 256 ? (cnt - 256 * rb) : 256; u.pm = estart[e] + 256 * rb; u.pn = sub; u.aux = e * T + 256 * rb;
        if (mode == 0) { u.A = Abase; u.B = Bbase + ((size_t)e * 512 + 256 * sub) * 2048; }
        else { u.A = Abase + (size_t)u.pm * 512; u.B = Bbase + ((size_t)e * 1024 + 256 * sub) * 512; }
        return true;
    }
    DI unsigned row_off(const pg8::Unit& u, int r) const { const int v = bins[u.aux + (r < u.rows ? r : u.rows - 1)]; return (unsigned)(v >> 3) * 2048u; }
};
struct EpiGateUp {
    static constexpr bool MID = false, PREP = false;
    bf16_t* H; const float* bing;
    DI void operator()(const f32x4 (&acc)[2][2][4][2], const pg8::Unit& u, int wr, int wc, int fr, int fq) const {
        float gt[2][4];
#pragma unroll
        for (int ai = 0; ai < 2; ++ai)
#pragma unroll
            for (int m = 0; m < 4; ++m) { const int r = 128 * ai + 64 * wr + 16 * m + fr; gt[ai][m] = bing[u.aux + (r < u.rows ? r : u.rows - 1)]; }
#pragma unroll
        for (int ai = 0; ai < 2; ++ai)
#pragma unroll
            for (int m = 0; m < 4; ++m) {
                const int r = 128 * ai + 64 * wr + 16 * m + fr; const float g = gt[ai][m];
                const f32x4 g0 = acc[ai][0][m][0], g1 = acc[ai][0][m][1], u0 = acc[ai][1][m][0], u1 = acc[ai][1][m][1];
                const u32x4 w = (u32x4){pk2(siluf_(g0[0]) * u0[0] * g, siluf_(g0[1]) * u0[1] * g), pk2(siluf_(g0[2]) * u0[2] * g, siluf_(g0[3]) * u0[3] * g),
                                        pk2(siluf_(g1[0]) * u1[0] * g, siluf_(g1[1]) * u1[1] * g), pk2(siluf_(g1[2]) * u1[2] * g, siluf_(g1[3]) * u1[3] * g)};
                if (r < u.rows) *(u32x4*)(H + (size_t)(u.pm + r) * 256 + 128 * u.pn + 32 * wc + 8 * fq) = w;
                asm volatile("" ::: "memory");
            }
    }
};
struct EpiDown {
    static constexpr bool MID = false, PREP = false;
    unsigned char* OA; unsigned char* OB;
    DI void operator()(const f32x4 (&acc)[2][2][4][2], const pg8::Unit& u, int wr, int wc, int fr, int fq) const {
#pragma unroll
        for (int ai = 0; ai < 2; ++ai)
#pragma unroll
            for (int m = 0; m < 4; ++m) {
                const int r = 128 * ai + 64 * wr + 16 * m + fr;
                if (r < u.rows) {
                    const int pos = u.pm + r; unsigned char* rowp = (pos < T * 4 ? OA + (size_t)pos * 1024 : OB + (size_t)(pos - T * 4) * 1024) + 256 * u.pn + 64 * wc + 16 * fq;
                    int pk[4];
#pragma unroll
                    for (int bj = 0; bj < 2; ++bj) {
                        f32x4 v0 = acc[ai][bj][m][0] * OUT_SCALE, v1 = acc[ai][bj][m][1] * OUT_SCALE;
#pragma unroll
                        for (int i = 0; i < 4; ++i) { v0[i] = fminf(fmaxf(v0[i], -448.f), 448.f); v1[i] = fminf(fmaxf(v1[i], -448.f), 448.f); }
                        int lo = 0, hi = 0;
                        lo = __builtin_amdgcn_cvt_pk_fp8_f32(v0[0], v0[1], lo, false); lo = __builtin_amdgcn_cvt_pk_fp8_f32(v0[2], v0[3], lo, true);
                        hi = __builtin_amdgcn_cvt_pk_fp8_f32(v1[0], v1[1], hi, false); hi = __builtin_amdgcn_cvt_pk_fp8_f32(v1[2], v1[3], hi, true);
                        pk[2 * bj] = lo; pk[2 * bj + 1] = hi;
                    }
                    *(u32x4*)rowp = (u32x4){(unsigned)pk[0], (unsigned)pk[1], (unsigned)pk[2], (unsigned)pk[3]};
                }
                asm volatile("" ::: "memory");
            }
    }
};
DI int xcd_vb() { const int G = gridDim.x; return (G % 8 == 0) ? (int)(blockIdx.x % 8) * (G / 8) + (int)(blockIdx.x / 8) : (int)blockIdx.x; }
DI void p5a_gateup(const Params& P, char* lds) {
    moe_tables(P, lds);
    const LAS int* tstart = (const LAS int*)((LAS unsigned char*)lds + P5TAB_OFF);
    MoeOrder S{tstart, tstart + 260, (const char*)(P.ws + WS_H2), (const char*)(P.ws + WS_WEGU), (const int*)(P.ws + WS_BINS), tstart[256] * 2, 2, (int)gridDim.x, xcd_vb(), 0};
    EpiGateUp E{(bf16_t*)(P.ws + WS_HIDALL), (const float*)(P.ws + WS_BING)};
    pg8::gemm_phase<EpiGateUp, MoeOrder, true>((LAS unsigned char*)lds, 1024, S, E);
}
DI void p5b_down(const Params& P, char* lds) {
    const LAS int* tstart = (const LAS int*)((LAS unsigned char*)lds + P5TAB_OFF);
    MoeOrder S{tstart, tstart + 260, (const char*)(P.ws + WS_HIDALL), (const char*)(P.ws + WS_WED), (const int*)(P.ws + WS_BINS), tstart[256] * 4, 4, (int)gridDim.x, xcd_vb(), 1};
    EpiDown E{P.ws + WS_OUTA, P.ws + WS_OUTB};
    pg8::gemm_phase<EpiDown, MoeOrder, false>((LAS unsigned char*)lds, 256, S, E);
}

DI void p6_combine(const Params& P, char* lds) {
    const LAS int* estart = (const LAS int*)((LAS unsigned char*)lds + P5TAB_OFF) + 260;
    const int tid = opaque_tid(), lane = tid & 63, wid = tid >> 6;
    const unsigned char* OA = P.ws + WS_OUTA; const unsigned char* OB = P.ws + WS_OUTB;
    for (int row = blockIdx.x * 8 + wid; row < T; row += gridDim.x * 8) {
        const float* ADA = (const float*)(P.ws + WS_ADA) + (row >> 13) * 6144 + 5120;
        int mypos = 0;
        if (lane < 8) { const int e = ((const int*)(P.ws + WS_EIDX))[row * 8 + lane]; mypos = estart[e] + ((const int*)(P.ws + WS_EPOS))[row * 8 + lane]; }
        u32x4 w[8];
#pragma unroll
        for (int s = 0; s < 8; ++s) { const int pos = __builtin_amdgcn_readlane(mypos, s); w[s] = *(const u32x4*)((pos < T * 4 ? OA + (size_t)pos * 1024 : OB + (size_t)(pos - T * 4) * 1024) + lane * 16); }
        float f[16];
#pragma unroll
        for (int i = 0; i < 16; ++i) f[i] = 0.f;
#pragma unroll
        for (int s = 0; s < 8; ++s)
#pragma unroll
            for (int q = 0; q < 4; ++q) { const f32x2 a = __builtin_amdgcn_cvt_pk_f32_fp8((int)w[s][q], false), bb = __builtin_amdgcn_cvt_pk_f32_fp8((int)w[s][q], true);
                f[4 * q] += a[0]; f[4 * q + 1] += a[1]; f[4 * q + 2] += bb[0]; f[4 * q + 3] += bb[1]; }
        float* op = P.out + (size_t)row * 1024 + 16 * lane; float z[16]; float sm = 0.f;
        const bf16_t* zp = (const bf16_t*)(P.ws + WS_XZ) + (size_t)row * 1024 + 16 * lane; const u32x4 zw0 = *(const u32x4*)zp, zw1 = *(const u32x4*)(zp + 8);
#pragma unroll
        for (int i = 0; i < 4; ++i) { const f32x4 g = *(const f32x4*)(ADA + 16 * lane + 4 * i); const unsigned wa = (i < 2 ? zw0 : zw1)[2 * (i & 1)], wb = (i < 2 ? zw0 : zw1)[2 * (i & 1) + 1];
            const f32x4 zs = (f32x4){bflo(wa), bfhi(wa), bflo(wb), bfhi(wb)};
#pragma unroll
            for (int q = 0; q < 4; ++q) { const float v = zs[q] + g[q] * (f[4 * i + q] * (1.f / OUT_SCALE)); z[4 * i + q] = v; sm += v; } }
        const float mean = wave_sum(sm) * (1.f / 1024.f); float qv = 0.f;
#pragma unroll
        for (int i = 0; i < 16; ++i) { z[i] -= mean; qv += z[i] * z[i]; }
        const float rstd = rsqrtf(wave_sum(qv) * (1.f / 1024.f) + EPS);
#pragma unroll
        for (int i = 0; i < 4; ++i) { const f32x4 g = *(const f32x4*)(P.ln2_g + 16 * lane + 4 * i), bb = *(const f32x4*)(P.ln2_b + 16 * lane + 4 * i);
            *(f32x4*)(op + 4 * i) = (f32x4){z[4 * i] * rstd * g[0] + bb[0], z[4 * i + 1] * rstd * g[1] + bb[1], z[4 * i + 2] * rstd * g[2] + bb[2], z[4 * i + 3] * rstd * g[3] + bb[3]}; }
    }
}

__global__ void __launch_bounds__(NTHR) fwd_megakernel(Params P) {
    extern __shared__ __attribute__((aligned(16))) char lds[];
    volatile LAS unsigned* bst = (volatile LAS unsigned*)((LAS unsigned char*)lds + BARLDS_OFF);
    if (threadIdx.x < 2) bst[threadIdx.x] = 0u;
    __syncthreads();
    const XcdBarrier bar = xcd_barrier_post((unsigned*)(P.ws + WS_BAR), bst);
    p0_prologue(P, lds);
    xcd_barrier(bar);
    p1_inproj_and_experts(P, lds);
    xcd_barrier(bar);
    p2_mixer(P, lds);
    xcd_barrier(bar);
    p3a_ssm(P, lds);
    xcd_barrier(bar);
    p3b_glu(P, lds);
    xcd_barrier(bar);
    p3d_outproj(P, lds);
    xcd_barrier(bar);
    p3e_ln1(P);
    xcd_barrier(bar);
    p3f_router_shared(P, lds);
    xcd_barrier(bar);
    p3g_route_shared_down(P, lds);
    xcd_barrier(bar);
    p5a_gateup(P, lds);
    xcd_barrier(bar);
    p5b_down(P, lds);
    xcd_barrier(bar);
    p6_combine(P, lds);
}


#ifdef ANALYZE_PHASES
template <int PH> __global__ void __launch_bounds__(NTHR) phase_kernel(Params P) {
    extern __shared__ __attribute__((aligned(16))) char lds[];
    if (PH == 0) p0_prologue(P, lds);
    if (PH == 1) p1_inproj_and_experts(P, lds);
    if (PH == 2) p2_mixer(P, lds);
    if (PH == 3) p3a_ssm(P, lds);
    if (PH == 7) p3b_glu(P, lds);
    if (PH == 9) p3d_outproj(P, lds);
    if (PH == 10) p3e_ln1(P);
    if (PH == 11) p3f_router_shared(P, lds);
    if (PH == 12) p3g_route_shared_down(P, lds);
    if (PH == 4) p5a_gateup(P, lds);
    if (PH == 5) p5b_down(P, lds);
    if (PH == 6) p6_combine(P, lds);
}
template __global__ void phase_kernel<0>(Params); template __global__ void phase_kernel<1>(Params); template __global__ void phase_kernel<2>(Params); template __global__ void phase_kernel<3>(Params);
template __global__ void phase_kernel<4>(Params); template __global__ void phase_kernel<5>(Params); template __global__ void phase_kernel<6>(Params);
template __global__ void phase_kernel<7>(Params); template __global__ void phase_kernel<8>(Params); template __global__ void phase_kernel<9>(Params); template __global__ void phase_kernel<10>(Params); template __global__ void phase_kernel<11>(Params); template __global__ void phase_kernel<12>(Params);
#endif

extern "C" void kernel_launch(void* const* d_in, const int* in_sizes, int n_in, void* d_out, int out_size, void* d_ws, size_t ws_size, hipStream_t stream) {
    static int grid = 0;
    if (grid == 0) {
        if (n_in != 31 || out_size != T * D || ws_size < WS_END) { fprintf(stderr, "kernel_launch: unexpected problem (n_in %d, out %d, ws %zu < %zu)\n", n_in, out_size, ws_size, (size_t)WS_END); grid = -1; return; }
        int dev = 0, cus = 0, per_cu = 0;
        (void)hipGetDevice(&dev); (void)hipDeviceGetAttribute(&cus, hipDeviceAttributeMultiprocessorCount, dev);
        (void)hipFuncSetAttribute((const void*)fwd_megakernel, hipFuncAttributeMaxDynamicSharedMemorySize, LDS_BYTES);
        (void)hipOccupancyMaxActiveBlocksPerMultiprocessor(&per_cu, (const void*)fwd_megakernel, NTHR, LDS_BYTES);
        if (per_cu < 1) { fprintf(stderr, "kernel_launch: occupancy query says %d blocks per CU\n", per_cu); grid = -1; return; }
        grid = cus * 1;
        if (grid > 256) grid = 256;
    }
    if (grid < 0) return;
    (void)hipMemsetAsync(d_ws, 0, 65536, stream);
    Params p{};
    const float** pf = (const float**)&p;
    for (int i = 0; i < 31; ++i) pf[i] = (const float*)d_in[i];
    p.out = (float*)d_out; p.ws = (unsigned char*)d_ws;
    void* args[] = {&p};
    hipError_t e = hipLaunchCooperativeKernel((const void*)fwd_megakernel, dim3(grid), dim3(NTHR), args, LDS_BYTES, stream);
    if (e != hipSuccess) fprintf(stderr, "cooperative launch failed: %s (grid %d)\n", hipGetErrorString(e), grid);
}
```

```cpp
#include <hip/hip_runtime.h>
#include <cstdio>
#include <cstdint>

#define DI __device__ __forceinline__
typedef unsigned short bf16_t;
typedef short bf16x8 __attribute__((ext_vector_type(8)));
typedef float f32x2 __attribute__((ext_vector_type(2)));
typedef float f32x4 __attribute__((ext_vector_type(4)));
typedef float f32x16 __attribute__((ext_vector_type(16)));
typedef unsigned u32x2 __attribute__((ext_vector_type(2)));
typedef unsigned u32x4 __attribute__((ext_vector_type(4)));
typedef __bf16 bf16v2 __attribute__((ext_vector_type(2)));

#define MFMA16(a, b, c) __builtin_amdgcn_mfma_f32_16x16x32_bf16((a), (b), (c), 0, 0, 0)
#define MFMA32(a, b, c) __builtin_amdgcn_mfma_f32_32x32x16_bf16((a), (b), (c), 0, 0, 0)
#define LDS_FENCE() asm volatile("s_waitcnt lgkmcnt(0)" ::: "memory")

constexpr int D = 1024, BATCH = 4, SEQ = 8192, T = BATCH * SEQ, NPROJ = 2048;
constexpr int NTHR = 512;
constexpr int NEXP = 256, TOPK = 8;
constexpr float ALPHA = 1.189207115002721f;
constexpr float EPS = 1e-5f;
constexpr float NEG = -1e30f;
constexpr float OUT_SCALE = 64.f;

constexpr size_t MiB = 1u << 20;
constexpr size_t WS_CNT = 0;
constexpr size_t WS_ADACNT = 2048;
constexpr size_t WS_BAR = 16384;
constexpr size_t WS_ADA = 64 * 1024;
constexpr size_t WS_ABAR = 192 * 1024;
constexpr size_t WS_ABARL = 208 * 1024;
constexpr size_t WS_BCAT = 256 * 1024;
constexpr size_t WS_CCAT = 384 * 1024;
constexpr size_t WS_WIN = 2 * MiB;
constexpr size_t WS_WGLU = 6 * MiB;
constexpr size_t WS_WR = 6 * MiB + 512 * 1024;
constexpr size_t WS_WSGU = 7 * MiB;
constexpr size_t WS_WOUT = 8 * MiB;
constexpr size_t WS_WSD = 10 * MiB;
constexpr size_t WS_EIDX = 11 * MiB;
constexpr size_t WS_EPOS = 12 * MiB;
constexpr size_t WS_HIDS = 14 * MiB;
constexpr size_t WS_BINS = 30 * MiB;
constexpr size_t WS_BING = 62 * MiB;
constexpr size_t WS_H2 = 94 * MiB;
constexpr size_t WS_WEGU = 158 * MiB;
constexpr size_t WS_WED = 414 * MiB;
constexpr size_t WS_H1 = 542 * MiB;
constexpr size_t WS_QKVU = 606 * MiB;
constexpr size_t WS_MERGED = 734 * MiB;
constexpr size_t WS_YGL = 798 * MiB;
constexpr size_t WS_SCORES = 830 * MiB;
constexpr size_t WS_E = 862 * MiB;
constexpr size_t WS_ATTSQ = 866 * MiB;
constexpr size_t WS_SSQ = 867 * MiB;
constexpr size_t WS_RS = 868 * MiB;
constexpr size_t WS_HIDALL = 542 * MiB;
constexpr size_t WS_OUTA = 158 * MiB;
constexpr size_t WS_OUTB = 670 * MiB;
constexpr size_t WS_XZ = 926 * MiB;
constexpr size_t WS_END = 1022 * MiB;

constexpr int LDP = 72;
constexpr int GEMM_LDS = (128 + 256) * LDP * 2;
constexpr int MISC_OFF = 57344;
constexpr int SSM_PITCH = 36;
constexpr int SSM_WAVE_LDS = 128 * SSM_PITCH * 4;
constexpr int P5TAB_OFF = 131072;
constexpr int BARLDS_OFF = 148 * 1024;
constexpr int LDS_BYTES = 148 * 1024 + 64;

struct Params {
    const float *x, *c, *rel_bias, *w_ada, *b_ada, *w_in, *a_re, *a_im, *b_re, *b_im, *c_re, *c_im, *ssm_d, *log_dt, *w_glu, *b_glu, *g_att, *g_ssm, *w_out,
        *ln1_g, *ln1_b, *w_router, *router_bias, *w_e_gate, *w_e_up, *w_e_down, *w_s_gate, *w_s_up, *w_s_down, *ln2_g, *ln2_b;
    float* out;
    unsigned char* ws;
};

DI int opaque_tid() { int t = threadIdx.x; asm volatile("" : "+v"(t)); return t; }
DI unsigned pk2(float a, float b) { f32x2 f = {a, b}; bf16v2 r = __builtin_convertvector(f, bf16v2); return __builtin_bit_cast(unsigned, r); }
DI bf16_t f2bf(float a) { return (bf16_t)(pk2(a, 0.f) & 0xffffu); }
DI float bflo(unsigned w) { return __uint_as_float(w << 16); }
DI float bfhi(unsigned w) { return __uint_as_float(w & 0xffff0000u); }
DI float sigmoidf_(float x) { return __builtin_amdgcn_rcpf(1.f + __expf(-x)); }
DI float siluf_(float x) { return x * __builtin_amdgcn_rcpf(1.f + __expf(-x)); }
DI float gelu_tanh(float x) { const float u = 0.7978845608028654f * (x + 0.044715f * x * x * x); const float e = __expf(2.f * u); const float th = 1.f - 2.f * __builtin_amdgcn_rcpf(e + 1.f); return 0.5f * x * (1.f + th); }
template <int CTRL> DI float dppf(float v) { return __builtin_bit_cast(float, __builtin_amdgcn_update_dpp(0, __builtin_bit_cast(int, v), CTRL, 0xF, 0xF, true)); }
DI float rdlane(float v, int l) { return __builtin_bit_cast(float, __builtin_amdgcn_readlane(__builtin_bit_cast(int, v), l)); }
constexpr int DPP_X1 = 0xB1, DPP_X2 = 0x4E, DPP_HM = 0x141, DPP_RM = 0x140;
DI float xsum16(float x) { auto t = __builtin_amdgcn_permlane16_swap(__float_as_uint(x), __float_as_uint(x), false, false); return __uint_as_float(t[0]) + __uint_as_float(t[1]); }
DI float xsum32(float x) { auto t = __builtin_amdgcn_permlane32_swap(__float_as_uint(x), __float_as_uint(x), false, false); return __uint_as_float(t[0]) + __uint_as_float(t[1]); }
DI float xmax32(float x) { auto t = __builtin_amdgcn_permlane32_swap(__float_as_uint(x), __float_as_uint(x), false, false); return fmaxf(__uint_as_float(t[0]), __uint_as_float(t[1])); }
DI float wave_sum(float v) {
    v += dppf<DPP_X1>(v); v += dppf<DPP_X2>(v); v += dppf<DPP_HM>(v); v += dppf<DPP_RM>(v); v = xsum16(v); return xsum32(v);
}

#define LAS __attribute__((address_space(3)))
#define XB_TMO      128
#define XB_XCNT(j)  (256  + 64 * (j))
#define XB_XSUB(j)  (1280 + 64 * (j))
#define XB_XGEN(j)  (2304 + 64 * (j))
#define XB_TOP      3328
#define XB_TOPGEN   3392
#define XB_SPIN_CAP (1u << 18)
DI unsigned xb_ld(unsigned* p) { return __hip_atomic_load(p, __ATOMIC_RELAXED, __HIP_MEMORY_SCOPE_AGENT); }
DI unsigned xb_add(unsigned* p, unsigned v) { return __hip_atomic_fetch_add(p, v, __ATOMIC_RELAXED, __HIP_MEMORY_SCOPE_AGENT); }
DI unsigned xb_xcc_id() { return (unsigned)__builtin_amdgcn_s_getreg((3 << 11) | 20) & 0xFu; }
#define XB_SPIN(cond, bar) do { unsigned _sp = 0; while (cond) { __builtin_amdgcn_s_sleep(1); \
    if ((++_sp & 255u) == 0u) { if (xb_ld(&(bar)[XB_TMO])) break; if (_sp > XB_SPIN_CAP) { atomicAdd(&(bar)[XB_TMO], 1u); break; } } } } while (0)
struct XcdBarrier { unsigned* bar; unsigned x; volatile LAS unsigned* st; };
DI XcdBarrier xcd_barrier_post(unsigned* bar, volatile LAS unsigned* st) {
    XcdBarrier b; b.bar = bar; b.x = xb_xcc_id(); b.st = st;
    if (threadIdx.x == 0) (void)xb_add(&bar[XB_XCNT(b.x)], 1u);
    return b;
}
DI void xcd_barrier_complete(unsigned* bar, unsigned x, unsigned& nloc, unsigned& nx) {
    const unsigned G = gridDim.x * gridDim.y * gridDim.z;
    unsigned sum, cnt, mine, sp = 0u;
    for (;;) {
        sum = 0u; cnt = 0u; mine = 0u;
#pragma unroll
        for (unsigned j = 0; j < 16; ++j) { const unsigned c = xb_ld(&bar[XB_XCNT(j)]); sum += c; cnt += (c > 0u) ? 1u : 0u; mine = (j == x) ? c : mine; }
        if (sum == G) break;
        __builtin_amdgcn_s_sleep(1);
        if ((++sp & 255u) == 0u) { if (xb_ld(&bar[XB_TMO])) break; if (sp > XB_SPIN_CAP) { atomicAdd(&bar[XB_TMO], 1u); break; } }
    }
    nloc = mine > 0u ? mine : 1u; nx = cnt > 0u ? cnt : 1u;
}
DI void xcd_barrier(const XcdBarrier& b) {
    asm volatile("s_waitcnt vmcnt(0)" ::: "memory");
    __syncthreads();
    if (threadIdx.x == 0) {
        unsigned* bar = b.bar;
        __builtin_amdgcn_s_waitcnt(0);
        unsigned nloc = b.st[0], nx = b.st[1];
        if (nloc == 0u) { xcd_barrier_complete(bar, b.x, nloc, nx); b.st[0] = nloc; b.st[1] = nx; }
        const unsigned old = xb_add(&bar[XB_XSUB(b.x)], 1u);
        const unsigned gen = old / nloc;
        if (old + 1u == (gen + 1u) * nloc) {
            __builtin_amdgcn_fence(__ATOMIC_RELEASE, "agent");
            asm volatile("s_waitcnt vmcnt(0)" ::: "memory");
            const unsigned og = xb_add(&bar[XB_TOP], 1u);
            const unsigned tg = og / nx;
            if (og + 1u == (tg + 1u) * nx) xb_add(&bar[XB_TOPGEN], 1u);
            else XB_SPIN(xb_ld(&bar[XB_TOPGEN]) == tg, bar);
            __builtin_amdgcn_fence(__ATOMIC_ACQUIRE, "agent");
            xb_add(&bar[XB_XGEN(b.x)], 1u);
            asm volatile("s_waitcnt vmcnt(0)" ::: "memory");
        } else {
            XB_SPIN(xb_ld(&bar[XB_XGEN(b.x)]) == gen, bar);
            __builtin_amdgcn_fence(__ATOMIC_ACQUIRE, "agent");
            asm volatile("s_waitcnt vmcnt(0)" ::: "memory");
        }
    }
    __syncthreads();
}

namespace pg8 {
constexpr int BM = 256, BK = 64, HALF = 128, HTB = HALF * BK * 2, STAGE_BYTES = 8 * HTB;
DI int lds_byte(int r, int c) { const int st = (r >> 4) * 2 + (c >> 5), rr = r & 15, cc = c & 31, ob = rr * 64 + cc * 2; return st * 1024 + (ob ^ (((ob >> 9) & 1) << 5)); }
DI void stage_rc(int b, int& R, int& C) { const int st = b / 1024, sb = b % 1024, swz = sb ^ (((sb >> 9) & 1) << 5); R = (st >> 1) * 16 + swz / 64; C = (st & 1) * 32 + (swz % 64) / 2; }
DI int perm32(int rho) { const int n = rho >> 4, i = rho & 15; return 8 * (i >> 2) + 4 * n + (i & 3); }
struct Unit { const char* A; const char* B; int pm, pn, rows, aux; };

template <class Epi, class Sched, bool GATHER>
DI void gemm_phase(LAS unsigned char* lds, const int K, const Sched& S, const Epi& E) {
    int tid = threadIdx.x; asm volatile("" : "+v"(tid));
    const int wid = __builtin_amdgcn_readfirstlane(tid >> 6), lane = tid & 63, wr = wid >> 2, wc = wid & 3, fr = lane & 15, fq = lane >> 4;
    const int nt = K / BK;
    unsigned voffA[2], voffB[2]; int Rr[2], Cc[2];
#pragma unroll
    for (int i = 0; i < 2; ++i) { int R, C; stage_rc(tid * 16 + i * 8192, R, C); const int Rb = (R & ~31) + perm32(R & 31); Rr[i] = R; Cc[i] = C;
        voffA[i] = (unsigned)(R * K + C) * 2u; voffB[i] = (unsigned)(Rb * K + C) * 2u; }
    const size_t kstep = (size_t)(BK * 2);
    const size_t hstep = (size_t)HALF * K * 2;
    const unsigned ldsw = (unsigned)wid * 1024u;
    const int aoff = lds_byte(wr * 64 + fr, fq * 8), boff = lds_byte(wc * 32 + fr, fq * 8);
#define PG8_SA(b, h) (((b) * 2 + (h)) * HTB)
#define PG8_SB(b, h) ((4 + (b) * 2 + (h)) * HTB)
#define PG8_STAGE(bufoff, gbase, voff) do { _Pragma("unroll") for (int _i = 0; _i < 2; ++_i) \
        __builtin_amdgcn_global_load_lds((const unsigned*)((const char*)(gbase) + (voff)[_i]), (LAS unsigned*)(lds + (bufoff) + ldsw + _i * 8192), 16, 0, 0); } while (0)
#define PG8_STAGEA(bufoff, gbase, h, nx) do { if constexpr (GATHER) { unsigned _o[2]; _o[0] = (nx) ? na[h][0] : ga[h][0]; _o[1] = (nx) ? na[h][1] : ga[h][1]; PG8_STAGE(bufoff, gbase, _o); } \
        else { PG8_STAGE(bufoff, (gbase) + (h) * hstep, voffA); } } while (0)
#define PG8_LDA(dst, b, h) do { _Pragma("unroll") for (int m = 0; m < 4; ++m) _Pragma("unroll") for (int k = 0; k < 2; ++k) dst[m][k] = *(const LAS bf16x8*)(lds + PG8_SA(b, h) + aoff + m * 2048 + k * 1024); } while (0)
#define PG8_LDB(dst, b, h) do { _Pragma("unroll") for (int n = 0; n < 2; ++n) _Pragma("unroll") for (int k = 0; k < 2; ++k) dst[n][k] = *(const LAS bf16x8*)(lds + PG8_SB(b, h) + boff + n * 2048 + k * 1024); } while (0)
#define PG8_MMA(ai, bj, At, Bt) do { __builtin_amdgcn_s_setprio(1); _Pragma("unroll") for (int m = 0; m < 4; ++m) _Pragma("unroll") for (int n = 0; n < 2; ++n) _Pragma("unroll") for (int k = 0; k < 2; ++k) \
        acc[ai][bj][m][n] = __builtin_amdgcn_mfma_f32_16x16x32_bf16(Bt[n][k], At[m][k], acc[ai][bj][m][n], 0, 0, 0); __builtin_amdgcn_s_setprio(0); } while (0)
#define PG8_WAIT_V(n) asm volatile("s_waitcnt vmcnt(" #n ")" ::: "memory")
#define PG8_WAIT_L(n) asm volatile("s_waitcnt lgkmcnt(" #n ")" ::: "memory")
#define PG8_BAR __builtin_amdgcn_s_barrier()
#define PG8_SCHED __builtin_amdgcn_sched_barrier(0)
    Unit cur, nxt; int ui = 0;
    if (!S.next(0, cur)) return;
    f32x4 acc[2][2][4][2];
#pragma unroll
    for (int a = 0; a < 2; ++a)
#pragma unroll
        for (int b = 0; b < 2; ++b)
#pragma unroll
            for (int m = 0; m < 4; ++m)
#pragma unroll
                for (int n = 0; n < 2; ++n) acc[a][b][m][n] = (f32x4){0.f, 0.f, 0.f, 0.f};
    bf16x8 At[4][2], B0[2][2], B1[2][2];
    const char* cA = cur.A; const char* cB = cur.B;
    if constexpr (Epi::PREP) E.prep(cur, tid);
    unsigned ga[2][2], na[2][2];
    if constexpr (GATHER) {
#pragma unroll
        for (int h = 0; h < 2; ++h)
#pragma unroll
            for (int i = 0; i < 2; ++i) { ga[h][i] = S.row_off(cur, 128 * h + Rr[i]) + (unsigned)Cc[i] * 2u; na[h][i] = ga[h][i]; }
    }
    PG8_STAGE(PG8_SB(0, 0), cB, voffB); PG8_STAGE(PG8_SB(0, 1), cB + hstep, voffB); PG8_STAGEA(PG8_SA(0, 0), cA, 0, false); PG8_STAGEA(PG8_SA(0, 1), cA, 1, false);
    if (wr == 1) PG8_BAR;
    PG8_WAIT_V(2); PG8_BAR;
    PG8_STAGE(PG8_SB(1, 0), cB + kstep, voffB); PG8_STAGEA(PG8_SA(1, 0), cA + kstep, 0, false); PG8_STAGE(PG8_SB(1, 1), cB + hstep + kstep, voffB);
    PG8_WAIT_V(6); PG8_BAR;
    for (;;) {
        const bool has_next = S.next(ui + 1, nxt);
        if constexpr (Epi::PREP) { if (has_next) E.prep(nxt, tid); }
        const char* nA = has_next ? nxt.A : cA; const char* nB = has_next ? nxt.B : cB;
        if constexpr (GATHER) {
            if (has_next) {
#pragma unroll
                for (int h = 0; h < 2; ++h)
#pragma unroll
                    for (int i = 0; i < 2; ++i) na[h][i] = S.row_off(nxt, 128 * h + Rr[i]) + (unsigned)Cc[i] * 2u;
            }
        }
        const bool do0 = !Sched::RAGGED || cur.rows > 64 * wr, do1 = !Sched::RAGGED || cur.rows > 128 + 64 * wr;
#pragma unroll 1
        for (int t = 0; t < nt; t += 2) {
            const bool last = (t == nt - 2);
            const char* a1 = cA + (size_t)(t + 1) * kstep;
            const char* a2 = last ? nA : cA + (size_t)(t + 2) * kstep; const char* b2 = last ? nB : cB + (size_t)(t + 2) * kstep;
            const char* a3 = a2 + kstep; const char* b3 = b2 + kstep;
            PG8_LDB(B0, 0, 0); PG8_LDB(B1, 0, 1); PG8_SCHED; PG8_LDA(At, 0, 0); PG8_STAGEA(PG8_SA(1, 1), a1, 1, false);
            PG8_WAIT_V(8); PG8_WAIT_L(0); PG8_BAR; if (do0) { PG8_MMA(0, 0, At, B0); PG8_MMA(0, 1, At, B1); } PG8_BAR; PG8_SCHED;
            PG8_LDA(At, 0, 1); PG8_STAGE(PG8_SB(0, 0), b2, voffB); PG8_STAGE(PG8_SB(0, 1), b2 + hstep, voffB); PG8_STAGEA(PG8_SA(0, 0), a2, 0, last);
            PG8_WAIT_V(8); PG8_WAIT_L(0); PG8_BAR; if (do1) { PG8_MMA(1, 0, At, B0); PG8_MMA(1, 1, At, B1); } PG8_BAR; PG8_SCHED;
            PG8_LDB(B0, 1, 0); PG8_LDB(B1, 1, 1); PG8_SCHED; PG8_LDA(At, 1, 0); PG8_STAGEA(PG8_SA(0, 1), a2, 1, last);
            PG8_WAIT_V(8); PG8_WAIT_L(0); PG8_BAR; if (do0) { PG8_MMA(0, 0, At, B0); PG8_MMA(0, 1, At, B1); } PG8_BAR; PG8_SCHED;
            PG8_LDA(At, 1, 1); PG8_STAGE(PG8_SB(1, 0), b3, voffB); PG8_STAGE(PG8_SB(1, 1), b3 + hstep, voffB); PG8_STAGEA(PG8_SA(1, 0), a3, 0, last);
            PG8_WAIT_V(8); PG8_WAIT_L(0); PG8_BAR; if (do1) { PG8_MMA(1, 0, At, B0); PG8_MMA(1, 1, At, B1); } PG8_BAR; PG8_SCHED;
            if constexpr (Epi::MID) { if (t == nt / 2 - 2) E.mid(acc, cur, wr, wc, fr, fq); }
        }
        if (wr == 0) PG8_BAR;
        E(acc, cur, wr, wc, fr, fq);
        if (!has_next) break;
#pragma unroll
        for (int a = 0; a < 2; ++a)
#pragma unroll
            for (int b = 0; b < 2; ++b)
#pragma unroll
                for (int m = 0; m < 4; ++m)
#pragma unroll
                    for (int n = 0; n < 2; ++n) acc[a][b][m][n] = (f32x4){0.f, 0.f, 0.f, 0.f};
        cur = nxt; cA = nA; cB = nB; ++ui;
        if constexpr (GATHER) {
#pragma unroll
            for (int h = 0; h < 2; ++h)
#pragma unroll
                for (int i = 0; i < 2; ++i) ga[h][i] = na[h][i];
        }
        if (wr == 1) PG8_BAR;
    }
    PG8_WAIT_V(0);
    PG8_BAR;
#undef PG8_SA
#undef PG8_SB
#undef PG8_STAGE
#undef PG8_STAGEA
#undef PG8_LDA
#undef PG8_LDB
#undef PG8_MMA
#undef PG8_WAIT_V
#undef PG8_WAIT_L
#undef PG8_BAR
#undef PG8_SCHED
}

struct DenseOrder {
    static constexpr bool RAGGED = false;
    const char* A; const char* Bt; int K, nM, nN, nwg, G, c;
    DI void init(const void* A_, const void* Bt_, int M, int N, int K_, int G_, int c_) { A = (const char*)A_; Bt = (const char*)Bt_; K = K_; nM = M / BM; nN = N / BM; nwg = nM * nN; G = G_; c = c_; }
    DI bool next(int i, Unit& u) const {
        const long L = (long)i * G + c; if (L >= nwg) return false;
        int wgid = (int)L; { const int q = nwg / 8, r = nwg % 8, xcd = wgid % 8, off = wgid / 8; wgid = (xcd < r ? xcd * (q + 1) : r * (q + 1) + (xcd - r) * q) + off; }
        const int nig = 8 * nN, gid = wgid / nig, fm = gid * 8, gsz = (nM - fm) < 8 ? (nM - fm) : 8;
        u.pm = fm + ((wgid % nig) % gsz); u.pn = (wgid % nig) / gsz; u.rows = 256; u.aux = i % 3;
        u.A = A + (size_t)u.pm * 256 * K * 2; u.B = Bt + (size_t)u.pn * 256 * K * 2; return true;
    }
    DI unsigned row_off(const Unit&, int) const { return 0u; }
};
struct EpiStoreBf16 {
    static constexpr bool MID = false, PREP = false;
    bf16_t* O; int ld;
    DI void operator()(const f32x4 (&acc)[2][2][4][2], const Unit& u, int wr, int wc, int fr, int fq) const {
        bf16_t* base = O + (size_t)(u.pm * 256 + wr * 64 + fr) * ld + u.pn * 256 + wc * 32 + 8 * fq;
#pragma unroll
        for (int ai = 0; ai < 2; ++ai)
#pragma unroll
            for (int m = 0; m < 4; ++m) { bf16_t* rowp = base + (size_t)(ai * HALF + m * 16) * ld;
#pragma unroll
                for (int bj = 0; bj < 2; ++bj) { const f32x4 v0 = acc[ai][bj][m][0], v1 = acc[ai][bj][m][1];
                    *(u32x4*)(rowp + bj * HALF) = (u32x4){pk2(v0[0], v0[1]), pk2(v0[2], v0[3]), pk2(v1[0], v1[1]), pk2(v1[2], v1[3])}; } }
    }
};
}

DI void sincos_d(double ang, double& s, double& c) {
    const double r = ang * 0.63661977236758134308; const double q = __builtin_rint(r);
    const double y = (ang - q * 1.57079632679489655800) - q * 6.12323399573676603587e-17;
    const double y2 = y * y;
    double sp = -1.0 / 1307674368000.0; sp = sp * y2 + 1.0 / 6227020800.0; sp = sp * y2 - 1.0 / 39916800.0; sp = sp * y2 + 1.0 / 362880.0; sp = sp * y2 - 1.0 / 5040.0; sp = sp * y2 + 1.0 / 120.0; sp = sp * y2 - 1.0 / 6.0; sp = sp * y2 + 1.0;
    const double sy = y * sp;
    double cp = 1.0 / 87178291200.0; cp = cp * y2 - 1.0 / 479001600.0; cp = cp * y2 + 1.0 / 3628800.0; cp = cp * y2 - 1.0 / 40320.0; cp = cp * y2 + 1.0 / 720.0; cp = cp * y2 - 1.0 / 24.0; cp = cp * y2 + 0.5; const double cy = 1.0 - y2 * cp;
    const int qi = ((int)q) & 3;
    s = (qi == 0) ? sy : (qi == 1) ? cy : (qi == 2) ? -sy : -cy;
    c = (qi == 0) ? cy : (qi == 1) ? -sy : (qi == 2) ? -cy : sy;
}
DI void ssm_tables(const Params& P, int g, int p) {
    float* ABAR = (float*)(P.ws + WS_ABAR); float* ABARL = (float*)(P.ws + WS_ABARL); bf16_t* BCAT = (bf16_t*)(P.ws + WS_BCAT); bf16_t* CCAT = (bf16_t*)(P.ws + WS_CCAT);
    const double dt = (double)expf(P.log_dt[g]);
    const double ar = P.a_re[g * 64 + p], ai = P.a_im[g * 64 + p];
    double sn, cs; sincos_d(dt * ai, sn, cs);
    const double mag = (double)expf((float)(dt * ar));
    const double abr = mag * cs, abi = mag * sn;
    ABAR[g * 128 + p] = (float)abr; ABAR[g * 128 + 64 + p] = (float)abi;
    double snL, csL; sincos_d(128.0 * dt * ai, snL, csL);
    const double magL = (double)expf((float)(128.0 * dt * ar));
    ABARL[g * 128 + p] = (float)(magL * csL); ABARL[g * 128 + 64 + p] = (float)(magL * snL);
    const double xr = abr - 1.0, xi = abi, den = ar * ar + ai * ai;
    const double qr = (xr * ar + xi * ai) / den, qi = (xi * ar - xr * ai) / den;
    for (int c = 0; c < 16; ++c) {
        const double br = P.b_re[(g * 64 + p) * 16 + c], bi = P.b_im[(g * 64 + p) * 16 + c];
        BCAT[(g * 128 + p) * 16 + c] = f2bf((float)(qr * br - qi * bi));
        BCAT[(g * 128 + 64 + p) * 16 + c] = f2bf((float)(qr * bi + qi * br));
        CCAT[(g * 16 + c) * 128 + p] = f2bf(P.c_re[(g * 16 + c) * 64 + p]);
        CCAT[(g * 16 + c) * 128 + 64 + p] = f2bf(-P.c_im[(g * 16 + c) * 64 + p]);
    }
}
DI void ada_item(const Params& P, char* lds, int item) {
    float* red = (float*)lds; const int tid = opaque_tid(), lane = tid & 63, wid = tid >> 6;
    const int n = item * 64 + lane, k0 = wid * 128;
    float a0 = 0.f, a1 = 0.f, a2 = 0.f, a3 = 0.f;
#pragma unroll 1
    for (int kb = k0; kb < k0 + 128; kb += 32) {
        float w[32];
#pragma unroll
        for (int j = 0; j < 32; ++j) w[j] = P.w_ada[(size_t)(kb + j) * 6144 + n];
#pragma unroll
        for (int j = 0; j < 32; ++j) { const int k = kb + j; a0 += siluf_(P.c[k]) * w[j]; a1 += siluf_(P.c[1024 + k]) * w[j]; a2 += siluf_(P.c[2048 + k]) * w[j]; a3 += siluf_(P.c[3072 + k]) * w[j]; }
    }
    red[(wid * 4 + 0) * 64 + lane] = a0; red[(wid * 4 + 1) * 64 + lane] = a1; red[(wid * 4 + 2) * 64 + lane] = a2; red[(wid * 4 + 3) * 64 + lane] = a3;
    __syncthreads();
    if (tid < 256) {
        const int b = tid >> 6, l = tid & 63; float s = 0.f;
#pragma unroll
        for (int w = 0; w < 8; ++w) s += red[(w * 4 + b) * 64 + l];
        ((float*)(P.ws + WS_ADA))[b * 6144 + item * 64 + l] = s + P.b_ada[item * 64 + l];
    }
    asm volatile("s_waitcnt vmcnt(0)" ::: "memory");
    __syncthreads();
    if (tid == 0) {
        __builtin_amdgcn_fence(__ATOMIC_RELEASE, "agent"); asm volatile("s_waitcnt vmcnt(0)" ::: "memory");
        __hip_atomic_fetch_add((unsigned*)(P.ws + WS_ADACNT), 1u, __ATOMIC_RELAXED, __HIP_MEMORY_SCOPE_AGENT);
    }
}
DI void tr_item(const float* __restrict__ W, int K, int N, bf16_t* __restrict__ WT, int item, float* scr, int lane, int mode, int s, bool qscale, const float* ks0 = nullptr, const float* ks1 = nullptr) {
    const int nblk = N >> 6, kb = item / nblk, nb = item % nblk, k0 = 64 * kb, n0 = 64 * nb;
    const float* src = W + (size_t)(k0 + (lane >> 4)) * N + n0 + 4 * (lane & 15);
    f32x4 wv[16];
#pragma unroll
    for (int i = 0; i < 16; ++i) wv[i] = *(const f32x4*)(src + (size_t)(4 * i) * N);
    if (ks0) {
#pragma unroll
        for (int i = 0; i < 16; ++i) { const int k = k0 + 4 * i + (lane >> 4); wv[i] = wv[i] * ((k < 512) ? ks0[k] : ks1[k - 512]); }
    }
#pragma unroll
    for (int i = 0; i < 16; ++i) { float* d = scr + (4 * i + (lane >> 4)) * 65 + 4 * (lane & 15); d[0] = wv[i][0]; d[1] = wv[i][1]; d[2] = wv[i][2]; d[3] = wv[i][3]; }
    LDS_FENCE();
    const int c = lane & 7; const float sc = (qscale && n0 < 512) ? 0.125f : 1.f;
#pragma unroll
    for (int j = 0; j < 8; ++j) {
        const int n = (lane >> 3) + 8 * j; const float* sp = scr + (8 * c) * 65 + n;
        const u32x4 o = (u32x4){pk2(sp[0] * sc, sp[65] * sc), pk2(sp[130] * sc, sp[195] * sc), pk2(sp[260] * sc, sp[325] * sc), pk2(sp[390] * sc, sp[455] * sc)};
        const int nn = n0 + n; const int drow = mode == 0 ? nn : (mode == 1 ? (64 * (nn >> 5) + 32 * s + (nn & 31)) : (mode == 2 ? (256 * (nn >> 7) + 128 * s + (nn & 127)) :
            ((nn & ~255) + 128 * ((nn >> 3) & 1) + 32 * ((nn >> 6) & 3) + 8 * ((nn >> 4) & 3) + (nn & 7))));
        *(u32x4*)(WT + (size_t)drow * K + k0 + 8 * c) = o;
    }
    LDS_FENCE();
}
constexpr int CI_IN = 512, CI_GLU = 64, CI_OUT = 256, CI_R = 64, CI_SG = 64, CI_SU = 64, CI_SD = 64, CI_SMALL = CI_IN + CI_GLU + CI_OUT + CI_R + CI_SG + CI_SU + CI_SD;
DI void conv_item(const Params& P, int r, float* scr, int lane) {
    if (r < CI_IN) { tr_item(P.w_in, 1024, 2048, (bf16_t*)(P.ws + WS_WIN), r, scr, lane, 0, 0, true); return; } r -= CI_IN;
    if (r < CI_GLU) { tr_item(P.w_glu, 512, 512, (bf16_t*)(P.ws + WS_WGLU), r, scr, lane, 0, 0, false); return; } r -= CI_GLU;
    if (r < CI_OUT) { tr_item(P.w_out, 1024, 1024, (bf16_t*)(P.ws + WS_WOUT), r, scr, lane, 0, 0, false, P.g_att, P.g_ssm); return; } r -= CI_OUT;
    if (r < CI_R) { tr_item(P.w_router, 1024, 256, (bf16_t*)(P.ws + WS_WR), r, scr, lane, 0, 0, false); return; } r -= CI_R;
    if (r < CI_SG) { tr_item(P.w_s_gate, 1024, 256, (bf16_t*)(P.ws + WS_WSGU), r, scr, lane, 2, 0, false); return; } r -= CI_SG;
    if (r < CI_SU) { tr_item(P.w_s_up, 1024, 256, (bf16_t*)(P.ws + WS_WSGU), r, scr, lane, 2, 1, false); return; } r -= CI_SU;
    if (r < CI_SD) tr_item(P.w_s_down, 256, 1024, (bf16_t*)(P.ws + WS_WSD), r, scr, lane, 0, 0, false);
}
DI void p0_prologue(const Params& P, char* lds) {
    const int tid = opaque_tid(), lane = tid & 63, wid = tid >> 6, G = gridDim.x;
    { const int gt = blockIdx.x * NTHR + tid; if (gt < 2048) ssm_tables(P, gt >> 6, gt & 63); }
    for (int item = blockIdx.x; item < 96; item += G) ada_item(P, lds, item);
    float* scr = (float*)(lds + wid * 16640);
    const int gw = blockIdx.x * 8 + wid, NGW = G * 8;
    if (blockIdx.x >= 96 || G <= 96) { const int w0 = (G > 96) ? gw - 96 * 8 : gw, nw = (G > 96) ? (G - 96) * 8 : NGW; for (int it = w0; it < CI_SMALL; it += nw) conv_item(P, it, scr, lane); }
    if (tid == 0) {
        unsigned* ctr = (unsigned*)(P.ws + WS_ADACNT); unsigned sp = 0;
        while (__hip_atomic_load(ctr, __ATOMIC_RELAXED, __HIP_MEMORY_SCOPE_AGENT) < 96u) { __builtin_amdgcn_s_sleep(2); if (++sp > (1u << 22)) break; }
        __builtin_amdgcn_fence(__ATOMIC_ACQUIRE, "agent"); asm volatile("s_waitcnt vmcnt(0)" ::: "memory");
    }
    __syncthreads();
    {
        const float* ADA = (const float*)(P.ws + WS_ADA); bf16_t* H1 = (bf16_t*)(P.ws + WS_H1);
        for (int row = gw; row < T; row += NGW) {
            const float* xr = P.x + (size_t)row * 1024 + 4 * lane; const float* ad = ADA + (row >> 13) * 6144 + 4 * lane;
#pragma unroll
            for (int j = 0; j < 4; ++j) {
                const f32x4 xv = *(const f32x4*)(xr + 256 * j), sc = *(const f32x4*)(ad + 1024 + 256 * j), sh = *(const f32x4*)(ad + 256 * j);
                const f32x4 hv = xv * (1.f + sc) + sh;
                *(u32x2*)(H1 + (size_t)row * 1024 + 4 * lane + 256 * j) = (u32x2){pk2(hv[0], hv[1]), pk2(hv[2], hv[3])};
            }
        }
    }
}

DI void p1_inproj(const Params& P, char* lds) {
    pg8::DenseOrder S; S.init(P.ws + WS_H1, P.ws + WS_WIN, T, NPROJ, 1024, gridDim.x, blockIdx.x);
    pg8::EpiStoreBf16 E{(bf16_t*)(P.ws + WS_QKVU), NPROJ};
    pg8::gemm_phase<pg8::EpiStoreBf16, pg8::DenseOrder, false>((LAS unsigned char*)lds, 1024, S, E);
}

constexpr int CONV_NT = 3 * 256 * 16, CONV_TP = 257, FILL_TILES_PER_WG = 8;
struct ConvTile { const float* src; bf16_t* WT; int pitch, K, k0, n0, mode, s; };
DI ConvTile conv_tile(const Params& P, int t) {
    const int kind = t / 4096, e = (t % 4096) >> 4, sub = t & 15;
    if (kind < 2) return ConvTile{(kind ? P.w_e_up : P.w_e_gate) + (size_t)e * 262144 + (size_t)(64 * sub) * 256, (bf16_t*)(P.ws + WS_WEGU) + (size_t)e * 524288, 256, 1024, 64 * sub, 0, 2, kind};
    return ConvTile{P.w_e_down + (size_t)e * 262144 + (size_t)(64 * (sub >> 2)) * 1024 + 256 * (sub & 3), (bf16_t*)(P.ws + WS_WED) + (size_t)e * 262144, 1024, 256, 64 * (sub >> 2), 256 * (sub & 3), 3, 0};
}
DI void conv_tile_load(const ConvTile& d, int wid, int lane, f32x4 (&w)[8]) {
#pragma unroll
    for (int i = 0; i < 8; ++i) w[i] = __builtin_nontemporal_load((const f32x4*)(d.src + (size_t)(8 * wid + i) * d.pitch + 4 * lane));
}
DI void conv_experts_block(const Params& P, char* lds, int t, const int NT, const int stride) {
    const int tid = opaque_tid(), lane = tid & 63, wid = tid >> 6;
    if (t >= NT) return;
    float* buf0 = (float*)lds; float* buf1 = buf0 + 64 * CONV_TP;
    ConvTile d = conv_tile(P, t); f32x4 w[8]; conv_tile_load(d, wid, lane, w);
    int par = 0;
    for (;;) {
        float* buf = par ? buf1 : buf0;
#pragma unroll
        for (int i = 0; i < 8; ++i) { float* p = buf + (8 * wid + i) * CONV_TP + 4 * lane; p[0] = w[i][0]; p[1] = w[i][1]; p[2] = w[i][2]; p[3] = w[i][3]; }
        const int tn = t + stride; const ConvTile dn = conv_tile(P, tn < NT ? tn : t);
        conv_tile_load(dn, wid, lane, w);
        __syncthreads();
        const int c = lane & 7;
#pragma unroll
        for (int it = 0; it < 4; ++it) {
            const int n = 8 * wid + (lane >> 3) + 64 * it; const float* sp = buf + (8 * c) * CONV_TP + n;
            const u32x4 o = (u32x4){pk2(sp[0], sp[CONV_TP]), pk2(sp[2 * CONV_TP], sp[3 * CONV_TP]), pk2(sp[4 * CONV_TP], sp[5 * CONV_TP]), pk2(sp[6 * CONV_TP], sp[7 * CONV_TP])};
            const int nn = d.n0 + n; const int drow = d.mode == 2 ? (256 * (nn >> 7) + 128 * d.s + (nn & 127)) : ((nn & ~255) + 128 * ((nn >> 3) & 1) + 32 * ((nn >> 6) & 3) + 8 * ((nn >> 4) & 3) + (nn & 7));
            *(u32x4*)(d.WT + (size_t)drow * d.K + d.k0 + 8 * c) = o;
        }
        t = tn; if (t >= NT) break;
        d = dn; par ^= 1;
    }
    __syncthreads();
}
DI int fill_blocks() { const int G = gridDim.x, rounds = (384 + G - 1) / G; return rounds * G - 384; }
DI void p1_inproj_and_experts(const Params& P, char* lds) {
    const bool conv_first = ((blockIdx.x >> 3) & 1) == 0;
    const int nb = fill_blocks(), fill = (nb > 0 && nb < (int)gridDim.x) ? nb * FILL_TILES_PER_WG : 0;
    if (conv_first) conv_experts_block(P, lds, blockIdx.x, CONV_NT - fill, gridDim.x);
    p1_inproj(P, lds);
    if (!conv_first) conv_experts_block(P, lds, blockIdx.x, CONV_NT - fill, gridDim.x);
}

DI int t5_bucket(int dist) {
    if (dist < 16) return dist;
    const float v = logf((float)dist / 16.0f) / 4.852030263919617f * 16.0f;
    int l = 16 + (int)v; return l < 31 ? l : 31;
}
struct VFrag { u32x2 r[8]; };
DI VFrag v_tr_read(unsigned addr) {
    VFrag f;
    asm volatile("ds_read_b64_tr_b16 %0, %8\n\tds_read_b64_tr_b16 %1, %8 offset:1152\n\tds_read_b64_tr_b16 %2, %8 offset:64\n\tds_read_b64_tr_b16 %3, %8 offset:1216\n\t"
                 "ds_read_b64_tr_b16 %4, %8 offset:2304\n\tds_read_b64_tr_b16 %5, %8 offset:3456\n\tds_read_b64_tr_b16 %6, %8 offset:2368\n\tds_read_b64_tr_b16 %7, %8 offset:3520\n\ts_waitcnt lgkmcnt(0)"
                 : "=&v"(f.r[0]), "=&v"(f.r[1]), "=&v"(f.r[2]), "=&v"(f.r[3]), "=&v"(f.r[4]), "=&v"(f.r[5]), "=&v"(f.r[6]), "=&v"(f.r[7]) : "v"(addr) : "memory");
    return f;
}
DI void attn_task_params(int task, int wid, int& d, int& r, int& lqb, int& p) {
    p = task >> 1; const int tk = wid + 8 * (task & 1);
    if (p == 0) { d = 1; r = 0; lqb = 32 * tk; } else if (p == 1) { d = 4; r = tk >> 2; lqb = 32 * (tk & 3); } else { d = 16; r = tk; lqb = 0; }
}
struct ATask { int d, r, lqb, p, cb, ce; };
DI ATask attn_task(int task, int wid, int t0) {
    ATask a; attn_task_params(task, wid, a.d, a.r, a.lqb, a.p);
    a.ce = a.p > 0 ? 4 : 5;
    const int base = t0 + a.r + a.d * (a.lqb - 97);
    const int cb = base >= 0 ? 0 : ((-base + 32 * a.d - 1) >> (5 + 2 * a.p));
    a.cb = cb < a.ce ? cb : a.ce;
    return a;
}
DI void attn_unit(const Params& P, char* lds, int unit) {
    int tid = threadIdx.x; asm volatile("" : "+v"(tid));
    const int lane = tid & 63, wid = __builtin_amdgcn_readfirstlane(tid >> 6), c = lane & 31, hh = lane >> 5;
    const int b = unit >> 7, qb = (unit >> 3) & 15, h = unit & 7, t0 = qb * 512;
    char* st = lds;
    float* bt = (float*)(lds + 512 * 136);
    bf16_t* ksw = (bf16_t*)(bt + 3 * 192) + wid * (64 * LDP);
    bf16_t* vsw = ksw + 32 * LDP;
    const unsigned vtr = (unsigned)(size_t)vsw + (unsigned)(((4 * hh + ((lane & 15) >> 2)) * LDP + 16 * ((lane >> 4) & 1) + 4 * (lane & 3)) * 2);
    const bf16_t* qkv = (const bf16_t*)(P.ws + WS_QKVU) + (size_t)(b * SEQ) * NPROJ;
    constexpr float LOG2E = 1.4426950408889634f;
    for (int i = tid; i < 3 * 192; i += NTHR) {
        const int p = i / 192, j = i % 192 - 32; const int dist = (j < 0 ? 0 : j) << (2 * p); float v = NEG;
        if (j >= (p ? 33 : 0) && j <= 128) {
            const int mult = (p == 0) ? 1 + ((j & 3) == 0) + ((j & 15) == 0) : (p == 1 ? 1 + ((j & 3) == 0) : 1);
            v = P.rel_bias[t5_bucket(dist) * 8 + h] * LOG2E + (mult == 1 ? 0.f : (mult == 2 ? 1.f : 1.5849625007211562f));
        }
        bt[i] = v;
    }
    __syncthreads();
    bf16x8 kfN[4], vvN[4], qfN[4];
    auto issue_kv = [&](const ATask& a, int ch) __attribute__((always_inline)) {
        const int tkv = t0 + a.r + a.d * (a.lqb - 128 + 32 * ch) + ((lane >> 3) << (2 * a.p));
#pragma unroll
        for (int i = 0; i < 4; ++i) {
            int tk = tkv + 8 * i * a.d; tk = tk < 0 ? 0 : tk;
            const bf16_t* rp = qkv + (size_t)(unsigned)tk * NPROJ + 512 + h * 64 + 8 * (lane & 7);
            kfN[i] = *(const bf16x8*)rp; vvN[i] = *(const bf16x8*)(rp + 512);
        }
    };
    auto issue_q = [&](const ATask& a) __attribute__((always_inline)) {
        const bf16_t* qrow = qkv + (size_t)(unsigned)(t0 + a.d * (a.lqb + c) + a.r) * NPROJ + h * 64 + 8 * hh;
#pragma unroll
        for (int s = 0; s < 4; ++s) qfN[s] = *(const bf16x8*)(qrow + 16 * s);
    };
    { const ATask a0 = attn_task(0, wid, t0); issue_q(a0); issue_kv(a0, a0.cb); }
#pragma unroll 1
    for (int task = 0; task < 6; ++task) {
        const ATask cur = attn_task(task, wid, t0);
        if (cur.cb < cur.ce) {
            ATask nxt = cur;
#pragma unroll 1
            for (int t2 = task + 1; t2 < 6; ++t2) { const ATask c2 = attn_task(t2, wid, t0); if (c2.cb < c2.ce) { nxt = c2; break; } }
            const int d = cur.d, r = cur.r, lqb = cur.lqb, p = cur.p;
            int qidx = d * (lqb + c) + r; qidx ^= (qidx >> 5) & 15;
            bf16x8 qf[4];
#pragma unroll
            for (int s = 0; s < 4; ++s) qf[s] = qfN[s];
            issue_q(nxt);
            float m = NEG, l = 0.f; f32x16 o0, o1;
#pragma unroll
            for (int i = 0; i < 16; ++i) { o0[i] = 0.f; o1[i] = 0.f; }
            if (p > 0) {
                const char* sp = st + qidx * 136; const f32x2 ml = *(const f32x2*)(sp + 128); m = ml[0]; l = hh ? 0.f : ml[1];
#pragma unroll
                for (int g = 0; g < 4; ++g) { const u32x2 a = *(const u32x2*)(sp + (8 * g + 4 * hh) * 2), bb = *(const u32x2*)(sp + (32 + 8 * g + 4 * hh) * 2);
                    o0[4 * g] = bflo(a[0]); o0[4 * g + 1] = bfhi(a[0]); o0[4 * g + 2] = bflo(a[1]); o0[4 * g + 3] = bfhi(a[1]); o1[4 * g] = bflo(bb[0]); o1[4 * g + 1] = bfhi(bb[0]); o1[4 * g + 2] = bflo(bb[1]); o1[4 * g + 3] = bfhi(bb[1]); }
            }
#pragma unroll 1
            for (int ch = cur.cb; ch < cur.ce; ++ch) {
                const float* btp = bt + p * 192 + 32 + c + 128 - 32 * ch - 4 * hh;
                LDS_FENCE();
#pragma unroll
                for (int i = 0; i < 4; ++i) { *(bf16x8*)(ksw + (8 * i + (lane >> 3)) * LDP + 8 * (lane & 7)) = kfN[i]; *(bf16x8*)(vsw + (8 * i + (lane >> 3)) * LDP + 8 * (lane & 7)) = vvN[i]; }
                { const bool last = ch + 1 == cur.ce; ATask a = cur; int chn = ch + 1; if (last) { a = nxt; chn = nxt.cb; } issue_kv(a, chn); }
                LDS_FENCE();
                const int lk0 = lqb - 128 + 32 * ch;
                bf16x8 kf[4];
#pragma unroll
                for (int s = 0; s < 4; ++s) kf[s] = *(const bf16x8*)(ksw + c * LDP + 16 * s + 8 * hh);
                f32x16 sa;
#pragma unroll
                for (int i = 0; i < 16; ++i) sa[i] = 0.f;
#pragma unroll
                for (int s = 0; s < 4; ++s) sa = MFMA32(kf[s], qf[s], sa);
                float sc[16]; float mx = NEG;
#pragma unroll
                for (int i = 0; i < 16; ++i) sc[i] = btp[-((i & 3) + 8 * (i >> 2))];
                asm volatile("" : "+v"(sc[0]), "+v"(sc[1]), "+v"(sc[2]), "+v"(sc[3]), "+v"(sc[4]), "+v"(sc[5]), "+v"(sc[6]), "+v"(sc[7]), "+v"(sc[8]), "+v"(sc[9]), "+v"(sc[10]), "+v"(sc[11]), "+v"(sc[12]), "+v"(sc[13]), "+v"(sc[14]), "+v"(sc[15]));
                if (t0 + d * lk0 + r >= 0) {
#pragma unroll
                    for (int i = 0; i < 16; ++i) { const float v = fmaf(sa[i], LOG2E, sc[i]); sc[i] = v; mx = fmaxf(mx, v); }
                } else {
#pragma unroll
                    for (int i = 0; i < 16; ++i) {
                        const int kr = (i & 3) + 8 * (i >> 2) + 4 * hh;
                        const float v = (t0 + d * (lk0 + kr) + r >= 0) ? fmaf(sa[i], LOG2E, sc[i]) : NEG; sc[i] = v; mx = fmaxf(mx, v);
                    }
                }
                mx = xmax32(mx);
                if (!__all(mx - m <= 8.f)) {
                    const float mn = fmaxf(m, mx), alpha = __builtin_amdgcn_exp2f(m - mn); m = mn; l *= alpha;
#pragma unroll
                    for (int i = 0; i < 16; ++i) { o0[i] *= alpha; o1[i] *= alpha; }
                }
                float ps = 0.f;
#pragma unroll
                for (int i = 0; i < 16; ++i) { sc[i] = __builtin_amdgcn_exp2f(sc[i] - m); ps += sc[i]; }
                l += ps;
                const VFrag vf = v_tr_read(vtr);
#pragma unroll
                for (int s = 0; s < 2; ++s) {
                    const u32x4 pw = (u32x4){pk2(sc[8 * s], sc[8 * s + 1]), pk2(sc[8 * s + 2], sc[8 * s + 3]), pk2(sc[8 * s + 4], sc[8 * s + 5]), pk2(sc[8 * s + 6], sc[8 * s + 7])};
                    const bf16x8 pf = __builtin_bit_cast(bf16x8, pw);
                    const u32x4 v0 = (u32x4){vf.r[4 * s][0], vf.r[4 * s][1], vf.r[4 * s + 1][0], vf.r[4 * s + 1][1]}, v1 = (u32x4){vf.r[4 * s + 2][0], vf.r[4 * s + 2][1], vf.r[4 * s + 3][0], vf.r[4 * s + 3][1]};
                    o0 = MFMA32(__builtin_bit_cast(bf16x8, v0), pf, o0); o1 = MFMA32(__builtin_bit_cast(bf16x8, v1), pf, o1);
                }
            }
            l = xsum32(l);
            char* sp = st + qidx * 136;
            if (hh == 0) *(f32x2*)(sp + 128) = (f32x2){m, l};
#pragma unroll
            for (int g = 0; g < 4; ++g) { *(u32x2*)(sp + (8 * g + 4 * hh) * 2) = (u32x2){pk2(o0[4 * g], o0[4 * g + 1]), pk2(o0[4 * g + 2], o0[4 * g + 3])}; *(u32x2*)(sp + (32 + 8 * g + 4 * hh) * 2) = (u32x2){pk2(o1[4 * g], o1[4 * g + 1]), pk2(o1[4 * g + 2], o1[4 * g + 3])}; }
        }
        if (task & 1) __syncthreads();
    }
    {
        const char* sp = st + (tid ^ ((tid >> 5) & 15)) * 136; const float inv = 1.f / *(const float*)(sp + 132);
        bf16_t* op = (bf16_t*)(P.ws + WS_MERGED) + (size_t)(b * SEQ + t0 + tid) * 1024 + h * 64; float ss = 0.f;
#pragma unroll
        for (int i = 0; i < 8; ++i) { const u32x2 wa = *(const u32x2*)(sp + 16 * i), wb = *(const u32x2*)(sp + 16 * i + 8); const unsigned w[4] = {wa[0], wa[1], wb[0], wb[1]}; float v[8];
#pragma unroll
            for (int j = 0; j < 4; ++j) { v[2 * j] = bflo(w[j]) * inv; v[2 * j + 1] = bfhi(w[j]) * inv; ss += v[2 * j] * v[2 * j] + v[2 * j + 1] * v[2 * j + 1]; }
            *(u32x4*)(op + 8 * i) = (u32x4){pk2(v[0], v[1]), pk2(v[2], v[3]), pk2(v[4], v[5]), pk2(v[6], v[7])}; }
        ((float*)(P.ws + WS_ATTSQ))[(size_t)(b * SEQ + t0 + tid) * 8 + h] = ss;
    }
    __syncthreads();
}

DI u32x2 tr_read1(unsigned addr) { u32x2 r; asm volatile("ds_read_b64_tr_b16 %0, %1\n\ts_waitcnt lgkmcnt(0)" : "=&v"(r) : "v"(addr) : "memory"); return r; }
struct STr16 { u32x2 r[16]; };
DI STr16 s_tr_read(unsigned addr) {
    STr16 f;
    asm volatile("ds_read_b64_tr_b16 %0, %16\n\tds_read_b64_tr_b16 %1, %16 offset:576\n\tds_read_b64_tr_b16 %2, %16 offset:4608\n\tds_read_b64_tr_b16 %3, %16 offset:5184\n\t"
                 "ds_read_b64_tr_b16 %4, %16 offset:9216\n\tds_read_b64_tr_b16 %5, %16 offset:9792\n\tds_read_b64_tr_b16 %6, %16 offset:13824\n\tds_read_b64_tr_b16 %7, %16 offset:14400\n\t"
                 "ds_read_b64_tr_b16 %8, %16 offset:32\n\tds_read_b64_tr_b16 %9, %16 offset:608\n\tds_read_b64_tr_b16 %10, %16 offset:4640\n\tds_read_b64_tr_b16 %11, %16 offset:5216\n\t"
                 "ds_read_b64_tr_b16 %12, %16 offset:9248\n\tds_read_b64_tr_b16 %13, %16 offset:9824\n\tds_read_b64_tr_b16 %14, %16 offset:13856\n\tds_read_b64_tr_b16 %15, %16 offset:14432\n\ts_waitcnt lgkmcnt(0)"
                 : "=&v"(f.r[0]), "=&v"(f.r[1]), "=&v"(f.r[2]), "=&v"(f.r[3]), "=&v"(f.r[4]), "=&v"(f.r[5]), "=&v"(f.r[6]), "=&v"(f.r[7]),
                   "=&v"(f.r[8]), "=&v"(f.r[9]), "=&v"(f.r[10]), "=&v"(f.r[11]), "=&v"(f.r[12]), "=&v"(f.r[13]), "=&v"(f.r[14]), "=&v"(f.r[15]) : "v"(addr) : "memory");
    return f;
}
struct SsmConst { float a_re, a_im; bf16x8 bq[4], cq[4]; f32x4 dsk; };
struct SsmU { bf16x8 ufa[4]; u32x2 uwa[4][2]; };
template <bool FINAL>
DI void ssm_load_const(const Params& P, int g, int lane, SsmConst& C) {
    const int c32 = lane & 31, hh = lane >> 5, fr = lane & 15, fq = lane >> 4;
    const float* ABAR = (const float*)(P.ws + WS_ABAR);
    C.a_re = ABAR[g * 128 + lane]; C.a_im = ABAR[g * 128 + 64 + lane];
#pragma unroll
    for (int tau = 0; tau < 4; ++tau) C.bq[tau] = *(const bf16x8*)((const bf16_t*)(P.ws + WS_BCAT) + (size_t)(g * 128 + 32 * tau + c32) * 16 + 8 * hh);
    C.dsk = (f32x4){0.f, 0.f, 0.f, 0.f};
    if (FINAL) {
#pragma unroll
        for (int s = 0; s < 4; ++s) C.cq[s] = *(const bf16x8*)((const bf16_t*)(P.ws + WS_CCAT) + (size_t)(g * 16 + fr) * 128 + 32 * s + 8 * fq);
        C.dsk = *(const f32x4*)(P.ssm_d + g * 16 + 4 * fq);
    }
}
template <bool FINAL>
DI void ssm_load_u(const Params& P, int b, int k, int g, int lane, SsmU& U) {
    const int c32 = lane & 31, hh = lane >> 5, fr = lane & 15, fq = lane >> 4;
    const bf16_t* ubase = (const bf16_t*)(P.ws + WS_QKVU) + (size_t)(b * SEQ + k * 128) * NPROJ + 1536 + 16 * g;
#pragma unroll
    for (int sub = 0; sub < 4; ++sub) {
        U.ufa[sub] = *(const bf16x8*)(ubase + (size_t)(32 * sub + c32) * NPROJ + 8 * hh);
        if (FINAL) { U.uwa[sub][0] = *(const u32x2*)(ubase + (size_t)(32 * sub + fr) * NPROJ + 4 * fq); U.uwa[sub][1] = *(const u32x2*)(ubase + (size_t)(32 * sub + 16 + fr) * NPROJ + 4 * fq); }
    }
}
template <bool FINAL>
DI void ssm_task(const Params& P, float* buf, int b, int k, int g, int lane, float& s_re, float& s_im, const SsmConst& C, const SsmU& U) {
    const int c32 = lane & 31, hh = lane >> 5, fr = lane & 15, fq = lane >> 4;
    const float a_re = C.a_re, a_im = C.a_im;
    const unsigned str = (unsigned)(size_t)buf + (unsigned)((8 * fq + ((lane & 15) >> 2)) * (SSM_PITCH * 4) + (lane & 3) * 8);
#pragma unroll
    for (int sub = 0; sub < 4; ++sub) {
        const bf16x8 uf = U.ufa[sub];
        f32x16 zr0, zr1, zi0, zi1;
#pragma unroll
        for (int i = 0; i < 16; ++i) { zr0[i] = 0.f; zr1[i] = 0.f; zi0[i] = 0.f; zi1[i] = 0.f; }
        zr0 = MFMA32(uf, C.bq[0], zr0); zr1 = MFMA32(uf, C.bq[1], zr1); zi0 = MFMA32(uf, C.bq[2], zi0); zi1 = MFMA32(uf, C.bq[3], zi1);
        float* rre = buf + lane * SSM_PITCH; float* rim = buf + (64 + lane) * SSM_PITCH;
#pragma unroll
        for (int gq = 0; gq < 4; ++gq) {
            float re8[8], im8[8];
#pragma unroll
            for (int j = 0; j < 4; ++j) {
                const auto tr = __builtin_amdgcn_permlane32_swap(__float_as_uint(zr0[4 * gq + j]), __float_as_uint(zr1[4 * gq + j]), false, false);
                const auto ti = __builtin_amdgcn_permlane32_swap(__float_as_uint(zi0[4 * gq + j]), __float_as_uint(zi1[4 * gq + j]), false, false);
                re8[j] = __uint_as_float(tr[0]); re8[4 + j] = __uint_as_float(tr[1]); im8[j] = __uint_as_float(ti[0]); im8[4 + j] = __uint_as_float(ti[1]);
            }
#pragma unroll
            for (int half = 0; half < 2; ++half) {
                const int tq = 2 * gq + half; float sr[4], si[4];
#pragma unroll
                for (int j = 0; j < 4; ++j) { const float nr = fmaf(a_re, s_re, fmaf(-a_im, s_im, re8[4 * half + j])), ni = fmaf(a_re, s_im, fmaf(a_im, s_re, im8[4 * half + j])); s_re = nr; s_im = ni; sr[j] = nr; si[j] = ni; }
                if (FINAL) { *(u32x2*)((bf16_t*)rre + 4 * tq) = (u32x2){pk2(sr[0], sr[1]), pk2(sr[2], sr[3])}; *(u32x2*)((bf16_t*)rim + 4 * tq) = (u32x2){pk2(si[0], si[1]), pk2(si[2], si[3])}; }
            }
        }
        if (FINAL) {
            LDS_FENCE();
            const STr16 sf = s_tr_read(str);
#pragma unroll
            for (int tt = 0; tt < 2; ++tt) {
                f32x4 y = (f32x4){0.f, 0.f, 0.f, 0.f};
#pragma unroll
                for (int s = 0; s < 4; ++s) { const u32x4 w = (u32x4){sf.r[8 * tt + 2 * s][0], sf.r[8 * tt + 2 * s][1], sf.r[8 * tt + 2 * s + 1][0], sf.r[8 * tt + 2 * s + 1][1]}; y = MFMA16(C.cq[s], __builtin_bit_cast(bf16x8, w), y); }
                const int tl = 32 * sub + 16 * tt + fr;
                const u32x2 uw = U.uwa[sub][tt];
                const float v0 = gelu_tanh(y[0] + C.dsk[0] * bflo(uw[0])), v1 = gelu_tanh(y[1] + C.dsk[1] * bfhi(uw[0])), v2 = gelu_tanh(y[2] + C.dsk[2] * bflo(uw[1])), v3 = gelu_tanh(y[3] + C.dsk[3] * bfhi(uw[1]));
                *(u32x2*)((bf16_t*)(P.ws + WS_YGL) + (size_t)(b * SEQ + k * 128 + tl) * 512 + 16 * g + 4 * fq) = (u32x2){pk2(v0, v1), pk2(v2, v3)};
            }
        }
    }
    if (!FINAL) { float* E = (float*)(P.ws + WS_E) + (size_t)((b * 64 + k) * 32 + g) * 128; E[lane] = s_re; E[64 + lane] = s_im; }
    LDS_FENCE();
}

DI void p2_mixer(const Params& P, char* lds) {
    const int tid = opaque_tid(), lane = tid & 63, wid = tid >> 6, G = gridDim.x;
    for (int item = blockIdx.x; item < 512; item += G) attn_unit(P, lds, item < 256 ? item : (item ^ (15 << 3)));
    float* buf = (float*)(lds + wid * SSM_WAVE_LDS);
    int wt = blockIdx.x * 8 + wid;
    if (wt < 8192) {
        const int g = wt & 31; SsmConst C; ssm_load_const<false>(P, g, lane, C);
        SsmU U; ssm_load_u<false>(P, wt >> 11, (wt >> 5) & 63, g, lane, U);
#pragma unroll 1
        for (; wt < 8192; wt += G * 8) {
            const int wn = wt + G * 8 < 8192 ? wt + G * 8 : wt; SsmU Un; ssm_load_u<false>(P, wn >> 11, (wn >> 5) & 63, wn & 31, lane, Un);
            if ((G * 8) & 31) ssm_load_const<false>(P, wt & 31, lane, C);
            float z_re = 0.f, z_im = 0.f; ssm_task<false>(P, buf, wt >> 11, (wt >> 5) & 63, wt & 31, lane, z_re, z_im, C, U);
            U = Un;
        }
    }
}

DI void route_token(const f32x4 s4, const f32x4 rb, int lane, int& e_out, float& g_out) {
    float w0 = s4[0] + rb[0], w1 = s4[1] + rb[1], w2 = s4[2] + rb[2], w3 = s4[3] + rb[3];
    float m1, m2;
    { const float a = fmaxf(w0, w1), bb = fminf(w0, w1), cc = fmaxf(w2, w3), dd = fminf(w2, w3); m1 = fmaxf(a, cc); m2 = fmaxf(fminf(a, cc), fmaxf(bb, dd)); }
#define ROUTE_MERGE2(CTRL) { const float o1 = dppf<CTRL>(m1), o2 = dppf<CTRL>(m2); const float n1 = fmaxf(m1, o1), n2 = fmaxf(fminf(m1, o1), fmaxf(m2, o2)); m1 = n1; m2 = n2; }
    ROUTE_MERGE2(DPP_X1) ROUTE_MERGE2(DPP_X2) ROUTE_MERGE2(DPP_HM)
#undef ROUTE_MERGE2
    const float gs = m1 + m2; const int mygrp = lane >> 3; int rank = 0;
#pragma unroll
    for (int j = 0; j < 8; ++j) { const float gj = rdlane(gs, 8 * j); rank += ((gj > gs) || (gj == gs && j < mygrp)) ? 1 : 0; }
    const float NINF = -__builtin_inff();
    if (rank >= 4) { w0 = NINF; w1 = NINF; w2 = NINF; w3 = NINF; }
    int my_e = 0; float my_s = 0.f;
#pragma unroll 1
    for (int k = 0; k < TOPK; ++k) {
        float bv = w0; int bi = 0;
        if (w1 > bv) { bv = w1; bi = 1; } if (w2 > bv) { bv = w2; bi = 2; } if (w3 > bv) { bv = w3; bi = 3; }
        float rm = bv; rm = fmaxf(rm, dppf<DPP_X1>(rm)); rm = fmaxf(rm, dppf<DPP_X2>(rm)); rm = fmaxf(rm, dppf<DPP_HM>(rm)); rm = fmaxf(rm, dppf<DPP_RM>(rm));
        const float wmax = fmaxf(fmaxf(rdlane(rm, 0), rdlane(rm, 16)), fmaxf(rdlane(rm, 32), rdlane(rm, 48)));
        const unsigned long long bal = __ballot(bv == wmax);
        const int owner = __builtin_amdgcn_readfirstlane((int)__ffsll((long long)bal) - 1);
        const int sub = __builtin_amdgcn_readlane(bi, owner), idx = 4 * owner + sub;
        const float mys = bi == 0 ? s4[0] : (bi == 1 ? s4[1] : (bi == 2 ? s4[2] : s4[3]));
        const float sval = rdlane(mys, owner);
        if (lane == owner) { if (sub == 0) w0 = NINF; else if (sub == 1) w1 = NINF; else if (sub == 2) w2 = NINF; else w3 = NINF; }
        if (lane == k) { my_e = idx; my_s = sval; }
    }
    float sum = (lane < 8) ? my_s : 0.f;
    sum += dppf<DPP_X1>(sum); sum += dppf<DPP_X2>(sum); sum += dppf<DPP_HM>(sum);
    e_out = my_e; g_out = my_s / sum * 2.5f;
}

DI void p3a_ssm(const Params& P, char* lds) {
    const int tid = opaque_tid(), lane = tid & 63, wid = tid >> 6;
    float* buf = (float*)(lds + wid * SSM_WAVE_LDS);
    const float* ABARL = (const float*)(P.ws + WS_ABARL); const float* E = (const float*)(P.ws + WS_E);
#pragma unroll 1
    for (int job = blockIdx.x * 8 + wid; job < 2048; job += gridDim.x * 8) {
        const int g = job & 31, m = (job >> 5) & 15, b = job >> 9, k4 = 4 * m;
        SsmConst C; ssm_load_const<true>(P, g, lane, C);
        SsmU U; ssm_load_u<true>(P, b, k4, g, lane, U);
        const float lr = ABARL[g * 128 + lane], li = ABARL[g * 128 + 64 + lane];
        float cr = 0.f, ci = 0.f; float er[16], ei[16], fr[16], fi[16];
        const float* eb = E + (size_t)(b * 64 * 32 + g) * 128 + lane;
#define SSM_CARRY_LOAD(R, I, K0) { _Pragma("unroll") for (int j = 0; j < 16; ++j) { const int kj = (K0) + j; const float* ep = eb + (size_t)(kj < 63 ? kj : 63) * (32 * 128); R[j] = ep[0]; I[j] = ep[64]; } }
#define SSM_CARRY_STEP(R, I, K0) { _Pragma("unroll") for (int j = 0; j < 16; ++j) { const bool ok = (K0) + j < k4; float nr = fmaf(lr, cr, fmaf(-li, ci, R[j])); asm volatile("" : "+v"(nr)); const float ni = fmaf(lr, ci, fmaf(li, cr, I[j])); cr = ok ? nr : cr; ci = ok ? ni : ci; } }
        if (k4 > 0) {
            SSM_CARRY_LOAD(er, ei, 0)
#pragma unroll 1
            for (int k0 = 0; k0 < k4; k0 += 32) {
                SSM_CARRY_LOAD(fr, fi, k0 + 16)
                SSM_CARRY_STEP(er, ei, k0)
                SSM_CARRY_LOAD(er, ei, k0 + 32)
                SSM_CARRY_STEP(fr, fi, k0 + 16)
            }
        }
#undef SSM_CARRY_LOAD
#undef SSM_CARRY_STEP
#pragma unroll 1
        for (int i = 0; i < 4; ++i) {
            SsmU Un; ssm_load_u<true>(P, b, k4 + (i < 3 ? i + 1 : i), g, lane, Un);
            ssm_task<true>(P, buf, b, k4 + i, g, lane, cr, ci, C, U);
            U = Un;
        }
    }
}
struct EpiGluE {
    static constexpr bool MID = false, PREP = false;
    const bf16_t* ygl; bf16_t* merged; const float* bglu; float* ssq;
    DI void operator()(const f32x4 (&acc)[2][2][4][2], const pg8::Unit& u, int wr, int wc, int fr, int fq) const {
        f32x4 bv[2][2];
#pragma unroll
        for (int bj = 0; bj < 2; ++bj)
#pragma unroll
            for (int n = 0; n < 2; ++n) bv[bj][n] = *(const f32x4*)(bglu + 256 * u.pn + 128 * bj + 32 * wc + 8 * fq + 4 * n);
#pragma unroll
        for (int ai = 0; ai < 2; ++ai)
#pragma unroll
            for (int m = 0; m < 4; ++m) {
                const size_t row = (size_t)256 * u.pm + 128 * ai + 64 * wr + 16 * m + fr; float ss = 0.f;
#pragma unroll
                for (int bj = 0; bj < 2; ++bj) {
                    const int col = 256 * u.pn + 128 * bj + 32 * wc + 8 * fq; const u32x4 yw = *(const u32x4*)(ygl + row * 512 + col);
                    const f32x4 z0 = acc[ai][bj][m][0] + bv[bj][0], z1 = acc[ai][bj][m][1] + bv[bj][1];
                    const float o0 = bflo(yw[0]) * sigmoidf_(z0[0]), o1 = bfhi(yw[0]) * sigmoidf_(z0[1]), o2 = bflo(yw[1]) * sigmoidf_(z0[2]), o3 = bfhi(yw[1]) * sigmoidf_(z0[3]);
                    const float o4 = bflo(yw[2]) * sigmoidf_(z1[0]), o5 = bfhi(yw[2]) * sigmoidf_(z1[1]), o6 = bflo(yw[3]) * sigmoidf_(z1[2]), o7 = bfhi(yw[3]) * sigmoidf_(z1[3]);
                    ss += (o0 * o0 + o1 * o1) + (o2 * o2 + o3 * o3) + (o4 * o4 + o5 * o5) + (o6 * o6 + o7 * o7);
                    *(u32x4*)(merged + row * 1024 + 512 + col) = (u32x4){pk2(o0, o1), pk2(o2, o3), pk2(o4, o5), pk2(o6, o7)};
                }
                ss = xsum16(ss); ss = xsum32(ss);
                if (fq == 0) ssq[row * 8 + u.pn * 4 + wc] = ss;
                asm volatile("" ::: "memory");
            }
    }
};
DI void p3b_glu(const Params& P, char* lds) {
    pg8::DenseOrder S; S.init(P.ws + WS_YGL, P.ws + WS_WGLU, T, 512, 512, gridDim.x, blockIdx.x);
    EpiGluE E{(const bf16_t*)(P.ws + WS_YGL), (bf16_t*)(P.ws + WS_MERGED), P.b_glu, (float*)(P.ws + WS_SSQ)};
    pg8::gemm_phase<EpiGluE, pg8::DenseOrder, false>((LAS unsigned char*)lds, 512, S, E);
}
struct EpiResidE {
    static constexpr bool MID = false, PREP = false;
    bf16_t* io; const float* ada; int goff;
    DI void operator()(const f32x4 (&acc)[2][2][4][2], const pg8::Unit& u, int wr, int wc, int fr, int fq) const {
        const float* gate = ada + ((256 * u.pm) >> 13) * 6144 + goff + 256 * u.pn + 32 * wc + 8 * fq;
        f32x4 gv[2][2];
#pragma unroll
        for (int bj = 0; bj < 2; ++bj)
#pragma unroll
            for (int n = 0; n < 2; ++n) gv[bj][n] = *(const f32x4*)(gate + 128 * bj + 4 * n);
#pragma unroll
        for (int ai = 0; ai < 2; ++ai)
#pragma unroll
            for (int m = 0; m < 4; ++m) {
                bf16_t* p = io + ((size_t)256 * u.pm + 128 * ai + 64 * wr + 16 * m + fr) * 1024 + 256 * u.pn + 32 * wc + 8 * fq; u32x4 xw[2];
#pragma unroll
                for (int bj = 0; bj < 2; ++bj) xw[bj] = *(const u32x4*)(p + 128 * bj);
#pragma unroll
                for (int bj = 0; bj < 2; ++bj) {
                    const f32x4 a0 = acc[ai][bj][m][0] * gv[bj][0], a1 = acc[ai][bj][m][1] * gv[bj][1]; const u32x4 w = xw[bj];
                    *(u32x4*)(p + 128 * bj) = (u32x4){pk2(ALPHA * bflo(w[0]) + a0[0], ALPHA * bfhi(w[0]) + a0[1]), pk2(ALPHA * bflo(w[1]) + a0[2], ALPHA * bfhi(w[1]) + a0[3]),
                                                      pk2(ALPHA * bflo(w[2]) + a1[0], ALPHA * bfhi(w[2]) + a1[1]), pk2(ALPHA * bflo(w[3]) + a1[2], ALPHA * bfhi(w[3]) + a1[3])};
                }
                asm volatile("" ::: "memory");
            }
    }
};
struct EpiOutProjE {
    static constexpr bool MID = true, PREP = true;
    const float* x; bf16_t* out; const float* ada; const float* attsq; const float* ssq; LAS float* tab;
    DI void prep(const pg8::Unit& u, int tid) const {
        if (tid < 256) {
            const size_t row = (size_t)256 * u.pm + tid;
            const f32x4 p0 = *(const f32x4*)(attsq + row * 8), p1 = *(const f32x4*)(attsq + row * 8 + 4), q0 = *(const f32x4*)(ssq + row * 8), q1 = *(const f32x4*)(ssq + row * 8 + 4);
            const float ra = rsqrtf((((p0[0] + p0[1]) + (p0[2] + p0[3])) + ((p1[0] + p1[1]) + (p1[2] + p1[3]))) * (1.f / 512.f) + EPS);
            const float rs = rsqrtf((((q0[0] + q0[1]) + (q0[2] + q0[3])) + ((q1[0] + q1[1]) + (q1[2] + q1[3]))) * (1.f / 512.f) + EPS);
            *(LAS f32x2*)(tab + (u.aux * 256 + tid) * 2) = (f32x2){ra, rs};
        }
    }
    DI void mid(f32x4 (&acc)[2][2][4][2], const pg8::Unit& u, int wr, int wc, int fr, int fq) const {
#pragma unroll
        for (int ai = 0; ai < 2; ++ai)
#pragma unroll
            for (int m = 0; m < 4; ++m) {
                const f32x2 r2 = *(const LAS f32x2*)(tab + (u.aux * 256 + 128 * ai + 64 * wr + 16 * m + fr) * 2); const float f = r2[0] * __builtin_amdgcn_rcpf(r2[1]);
#pragma unroll
                for (int bj = 0; bj < 2; ++bj)
#pragma unroll
                    for (int n = 0; n < 2; ++n) acc[ai][bj][m][n] *= f;
            }
    }
    DI void operator()(const f32x4 (&acc)[2][2][4][2], const pg8::Unit& u, int wr, int wc, int fr, int fq) const {
        const float* gate = ada + ((256 * u.pm) >> 13) * 6144 + 2048 + 256 * u.pn + 32 * wc + 8 * fq;
        f32x4 gv[2][2];
#pragma unroll
        for (int bj = 0; bj < 2; ++bj)
#pragma unroll
            for (int n = 0; n < 2; ++n) gv[bj][n] = *(const f32x4*)(gate + 128 * bj + 4 * n);
#pragma unroll
        for (int ai = 0; ai < 2; ++ai)
#pragma unroll
            for (int m = 0; m < 4; ++m) {
                const int rl = 128 * ai + 64 * wr + 16 * m + fr; const size_t row = (size_t)256 * u.pm + rl; const size_t o = row * 1024 + 256 * u.pn + 32 * wc + 8 * fq; f32x4 xv[2][2];
                const float r_s = tab[(u.aux * 256 + rl) * 2 + 1];
#pragma unroll
                for (int bj = 0; bj < 2; ++bj)
#pragma unroll
                    for (int n = 0; n < 2; ++n) xv[bj][n] = *(const f32x4*)(x + o + 128 * bj + 4 * n);
#pragma unroll
                for (int bj = 0; bj < 2; ++bj) {
                    const f32x4 v0 = ALPHA * xv[bj][0] + (gv[bj][0] * r_s) * acc[ai][bj][m][0], v1 = ALPHA * xv[bj][1] + (gv[bj][1] * r_s) * acc[ai][bj][m][1];
                    *(u32x4*)(out + o + 128 * bj) = (u32x4){pk2(v0[0], v0[1]), pk2(v0[2], v0[3]), pk2(v1[0], v1[1]), pk2(v1[2], v1[3])};
                }
                asm volatile("" ::: "memory");
            }
    }
};
DI void p3d_outproj(const Params& P, char* lds) {
    pg8::DenseOrder S; S.init(P.ws + WS_MERGED, P.ws + WS_WOUT, T, 1024, 1024, gridDim.x, blockIdx.x);
    EpiOutProjE E{P.x, (bf16_t*)(P.ws + WS_XZ), (const float*)(P.ws + WS_ADA), (const float*)(P.ws + WS_ATTSQ), (const float*)(P.ws + WS_SSQ), (LAS float*)((LAS unsigned char*)lds + P5TAB_OFF)};
    pg8::gemm_phase<EpiOutProjE, pg8::DenseOrder, false>((LAS unsigned char*)lds, 1024, S, E);
}
DI void p3e_ln1(const Params& P) {
    const int tid = opaque_tid(), lane = tid & 63, wid = tid >> 6;
    bf16_t* H2 = (bf16_t*)(P.ws + WS_H2); bf16_t* XZ = (bf16_t*)(P.ws + WS_XZ);
    for (int row = blockIdx.x * 8 + wid; row < T; row += gridDim.x * 8) {
        const float* ADA = (const float*)(P.ws + WS_ADA) + (row >> 13) * 6144;
        bf16_t* vp = XZ + (size_t)row * 1024 + 8 * lane; float v[16]; float s = 0.f;
#pragma unroll
        for (int j = 0; j < 2; ++j) { const u32x4 w = *(const u32x4*)(vp + 512 * j);
#pragma unroll
            for (int i = 0; i < 4; ++i) { v[8 * j + 2 * i] = bflo(w[i]); v[8 * j + 2 * i + 1] = bfhi(w[i]); s += v[8 * j + 2 * i] + v[8 * j + 2 * i + 1]; } }
        const float mean = wave_sum(s) * (1.f / 1024.f); float q = 0.f;
#pragma unroll
        for (int i = 0; i < 16; ++i) { v[i] -= mean; q += v[i] * v[i]; }
        const float rstd = rsqrtf(wave_sum(q) * (1.f / 1024.f) + EPS);
#pragma unroll
        for (int j = 0; j < 2; ++j) {
            const int col = 8 * lane + 512 * j; float x1[8], hv[8];
#pragma unroll
            for (int i = 0; i < 2; ++i) {
                const f32x4 g = *(const f32x4*)(P.ln1_g + col + 4 * i), bb = *(const f32x4*)(P.ln1_b + col + 4 * i), sc2 = *(const f32x4*)(ADA + 4096 + col + 4 * i), sh2 = *(const f32x4*)(ADA + 3072 + col + 4 * i);
#pragma unroll
                for (int t = 0; t < 4; ++t) { x1[4 * i + t] = v[8 * j + 4 * i + t] * rstd * g[t] + bb[t]; hv[4 * i + t] = x1[4 * i + t] * (1.f + sc2[t]) + sh2[t]; }
            }
            *(u32x4*)(vp + 512 * j) = (u32x4){pk2(x1[0], x1[1]), pk2(x1[2], x1[3]), pk2(x1[4], x1[5]), pk2(x1[6], x1[7])};
            *(u32x4*)(H2 + (size_t)row * 1024 + col) = (u32x4){pk2(hv[0], hv[1]), pk2(hv[2], hv[3]), pk2(hv[4], hv[5]), pk2(hv[6], hv[7])};
        }
    }
}
struct EpiRouterSharedE {
    static constexpr bool MID = false, PREP = false;
    float* sc; bf16_t* hids;
    DI void operator()(const f32x4 (&acc)[2][2][4][2], const pg8::Unit& u, int wr, int wc, int fr, int fq) const {
#pragma unroll
        for (int ai = 0; ai < 2; ++ai)
#pragma unroll
            for (int m = 0; m < 4; ++m) {
                const size_t row = (size_t)256 * u.pm + 128 * ai + 64 * wr + 16 * m + fr;
                if (u.pn == 0) {
#pragma unroll
                    for (int bj = 0; bj < 2; ++bj)
#pragma unroll
                        for (int n = 0; n < 2; ++n) { const f32x4 v = acc[ai][bj][m][n]; *(f32x4*)(sc + row * 256 + 128 * bj + 32 * wc + 8 * fq + 4 * n) = (f32x4){sigmoidf_(v[0]), sigmoidf_(v[1]), sigmoidf_(v[2]), sigmoidf_(v[3])}; }
                } else {
                    const f32x4 g0 = acc[ai][0][m][0], g1 = acc[ai][0][m][1], u0 = acc[ai][1][m][0], u1 = acc[ai][1][m][1];
                    *(u32x4*)(hids + row * 256 + 128 * (u.pn - 1) + 32 * wc + 8 * fq) = (u32x4){pk2(siluf_(g0[0]) * u0[0], siluf_(g0[1]) * u0[1]), pk2(siluf_(g0[2]) * u0[2], siluf_(g0[3]) * u0[3]),
                                                                                                 pk2(siluf_(g1[0]) * u1[0], siluf_(g1[1]) * u1[1]), pk2(siluf_(g1[2]) * u1[2], siluf_(g1[3]) * u1[3])};
                }
                asm volatile("" ::: "memory");
            }
    }
};
DI void p3f_router_shared(const Params& P, char* lds) {
    pg8::DenseOrder S; S.init(P.ws + WS_H2, P.ws + WS_WR, T, 768, 1024, gridDim.x, blockIdx.x);
    EpiRouterSharedE E{(float*)(P.ws + WS_SCORES), (bf16_t*)(P.ws + WS_HIDS)};
    pg8::gemm_phase<EpiRouterSharedE, pg8::DenseOrder, false>((LAS unsigned char*)lds, 1024, S, E);
    const int nb = fill_blocks(), G = gridDim.x;
    if (nb > 0 && nb < G && (int)blockIdx.x >= G - nb) conv_experts_block(P, lds, CONV_NT - nb * FILL_TILES_PER_WG + ((int)blockIdx.x - (G - nb)), CONV_NT, nb);
}
DI void p3g_route_shared_down(const Params& P, char* lds) {
    const int tid = opaque_tid(), lane = tid & 63, wid = tid >> 6;
    int* hist = (int*)(lds + P5TAB_OFF); int* base = hist + 256; int* hist2 = base + 256; int* rt_e = hist2 + 256; float* rt_g = (float*)(rt_e + 1024);
    for (int pm = blockIdx.x; pm < 256; pm += gridDim.x) {
        const int row0 = pm * 128; const float* SC = (const float*)(P.ws + WS_SCORES) + (size_t)row0 * 256;
        __syncthreads();
        if (tid < 256) hist[tid] = 0;
        __syncthreads();
        {
            const f32x4 rb = *(const f32x4*)(P.router_bias + 4 * lane); const float* sp = SC + (size_t)(wid * 16) * 256 + 4 * lane;
            f32x4 n1 = *(const f32x4*)sp, n2 = *(const f32x4*)(sp + 256);
#pragma unroll 1
            for (int i = 0; i < 16; ++i) {
                const f32x4 cur = n1; n1 = n2; n2 = *(const f32x4*)(sp + (size_t)(i + 2 < 16 ? i + 2 : 15) * 256);
                const int tl = wid * 16 + i; int e; float gte; route_token(cur, rb, lane, e, gte);
                if (lane < 8) { rt_e[tl * 8 + lane] = e; rt_g[tl * 8 + lane] = gte; atomicAdd(&hist[e], 1); }
            }
        }
        __syncthreads();
        if (tid < 256) { const int cnt = hist[tid]; base[tid] = cnt ? atomicAdd((int*)(P.ws + WS_CNT) + tid, cnt) : 0; hist2[tid] = 0; }
        __syncthreads();
        for (int a = tid; a < 1024; a += NTHR) {
            const int e = rt_e[a]; const int pos = base[e] + atomicAdd(&hist2[e], 1); const int slot = (row0 + (a >> 3)) * 8 + (a & 7);
            ((int*)(P.ws + WS_BINS))[(size_t)e * T + pos] = slot; ((float*)(P.ws + WS_BING))[(size_t)e * T + pos] = rt_g[a]; ((int*)(P.ws + WS_EIDX))[slot] = e; ((int*)(P.ws + WS_EPOS))[slot] = pos;
        }
    }
    __syncthreads();
    pg8::DenseOrder S; S.init(P.ws + WS_HIDS, P.ws + WS_WSD, T, 1024, 256, gridDim.x, blockIdx.x);
    EpiResidE E{(bf16_t*)(P.ws + WS_XZ), (const float*)(P.ws + WS_ADA), 5120};
    pg8::gemm_phase<EpiResidE, pg8::DenseOrder, false>((LAS unsigned char*)lds, 256, S, E);
}

DI void moe_tables(const Params& P, char* lds) {
    LAS int* tstart = (LAS int*)((LAS unsigned char*)lds + P5TAB_OFF); LAS int* estart = tstart + 260;
    const int tid = opaque_tid();
    if (tid < 64) {
        const int* gc = (const int*)(P.ws + WS_CNT) + 4 * tid; const int c0 = gc[0], c1 = gc[1], c2 = gc[2], c3 = gc[3];
        const int t0 = (c0 + 255) >> 8, t1 = (c1 + 255) >> 8, t2 = (c2 + 255) >> 8, t3 = (c3 + 255) >> 8;
        int cs = c0 + c1 + c2 + c3, ts = t0 + t1 + t2 + t3; const int cown = cs, town = ts;
#pragma unroll
        for (int o = 1; o < 64; o <<= 1) { const int a = __shfl_up(cs, o), b = __shfl_up(ts, o); if (tid >= o) { cs += a; ts += b; } }
        int ce = cs - cown, te = ts - town;
        estart[4 * tid] = ce; tstart[4 * tid] = te; ce += c0; te += t0; estart[4 * tid + 1] = ce; tstart[4 * tid + 1] = te; ce += c1; te += t1;
        estart[4 * tid + 2] = ce; tstart[4 * tid + 2] = te; ce += c2; te += t2; estart[4 * tid + 3] = ce; tstart[4 * tid + 3] = te;
        if (tid == 63) { estart[256] = cs; tstart[256] = ts; }
    }
    __syncthreads();
}
struct MoeOrder {
    static constexpr bool RAGGED = true;
    const LAS int* tstart; const LAS int* estart; const char* Abase; const char* Bbase; const int* bins; int nunits, per, G, vb, mode;
    DI bool next(int i, pg8::Unit& u) const {
        const long L = (long)i * G + vb; if (L >= (long)nunits) return false;
        const int tile = (int)(L / per), sub = (int)(L % per);
        int lo = 0, hi = NEXP;
        while (hi - lo > 1) { const int mid = (lo + hi) >> 1; if (tstart[mid] <= tile) lo = mid; else hi = mid; }
        const int e = lo, rb = tile - tstart[e], cnt = estart[e + 1] - estart[e];
        u.rows = (cnt - 256 * rb) < 256 ? (cnt - 256 * rb) : 256; u.pm = estart[e] + 256 * rb; u.pn = sub; u.aux = e * T + 256 * rb;
        if (mode == 0) { u.A = Abase; u.B = Bbase + ((size_t)e * 512 + 256 * sub) * 2048; }
        else { u.A = Abase + (size_t)u.pm * 512; u.B = Bbase + ((size_t)e * 1024 + 256 * sub) * 512; }
        return true;
    }
    DI unsigned row_off(const pg8::Unit& u, int r) const { const int v = bins[u.aux + (r < u.rows ? r : u.rows - 1)]; return (unsigned)(v >> 3) * 2048u; }
};
struct EpiGateUp {
    static constexpr bool MID = false, PREP = false;
    bf16_t* H; const float* bing;
    DI void operator()(const f32x4 (&acc)[2][2][4][2], const pg8::Unit& u, int wr, int wc, int fr, int fq) const {
        float gt[2][4];
#pragma unroll
        for (int ai = 0; ai < 2; ++ai)
#pragma unroll
            for (int m = 0; m < 4; ++m) { const int r = 128 * ai + 64 * wr + 16 * m + fr; gt[ai][m] = bing[u.aux + (r < u.rows ? r : u.rows - 1)]; }
#pragma unroll
        for (int ai = 0; ai < 2; ++ai)
#pragma unroll
            for (int m = 0; m < 4; ++m) {
                const int r = 128 * ai + 64 * wr + 16 * m + fr; const float g = gt[ai][m];
                const f32x4 g0 = acc[ai][0][m][0], g1 = acc[ai][0][m][1], u0 = acc[ai][1][m][0], u1 = acc[ai][1][m][1];
                const u32x4 w = (u32x4){pk2(siluf_(g0[0]) * u0[0] * g, siluf_(g0[1]) * u0[1] * g), pk2(siluf_(g0[2]) * u0[2] * g, siluf_(g0[3]) * u0[3] * g),
                                        pk2(siluf_(g1[0]) * u1[0] * g, siluf_(g1[1]) * u1[1] * g), pk2(siluf_(g1[2]) * u1[2] * g, siluf_(g1[3]) * u1[3] * g)};
                if (r < u.rows) *(u32x4*)(H + (size_t)(u.pm + r) * 256 + 128 * u.pn + 32 * wc + 8 * fq) = w;
                asm volatile("" ::: "memory");
            }
    }
};
struct EpiDown {
    static constexpr bool MID = false, PREP = false;
    unsigned char* OA; unsigned char* OB;
    DI void operator()(const f32x4 (&acc)[2][2][4][2], const pg8::Unit& u, int wr, int wc, int fr, int fq) const {
#pragma unroll
        for (int ai = 0; ai < 2; ++ai)
#pragma unroll
            for (int m = 0; m < 4; ++m) {
                const int r = 128 * ai + 64 * wr + 16 * m + fr;
                if (r < u.rows) {
                    const int pos = u.pm + r; unsigned char* rowp = (pos < T * 4 ? OA + (size_t)pos * 1024 : OB + (size_t)(pos - T * 4) * 1024) + 256 * u.pn + 64 * wc + 16 * fq;
                    int pk[4];
#pragma unroll
                    for (int bj = 0; bj < 2; ++bj) {
                        f32x4 v0 = acc[ai][bj][m][0] * OUT_SCALE, v1 = acc[ai][bj][m][1] * OUT_SCALE;
#pragma unroll
                        for (int i = 0; i < 4; ++i) { v0[i] = fminf(fmaxf(v0[i], -448.f), 448.f); v1[i] = fminf(fmaxf(v1[i], -448.f), 448.f); }
                        int lo = 0, hi = 0;
                        lo = __builtin_amdgcn_cvt_pk_fp8_f32(v0[0], v0[1], lo, false); lo = __builtin_amdgcn_cvt_pk_fp8_f32(v0[2], v0[3], lo, true);
                        hi = __builtin_amdgcn_cvt_pk_fp8_f32(v1[0], v1[1], hi, false); hi = __builtin_amdgcn_cvt_pk_fp8_f32(v1[2], v1[3], hi, true);
                        pk[2 * bj] = lo; pk[2 * bj + 1] = hi;
                    }
                    *(u32x4*)rowp = (u32x4){(unsigned)pk[0], (unsigned)pk[1], (unsigned)pk[2], (unsigned)pk[3]};
                }
                asm volatile("" ::: "memory");
            }
    }
};
DI int xcd_vb() { const int G = gridDim.x; return (G % 8 == 0) ? (int)(blockIdx.x % 8) * (G / 8) + (int)(blockIdx.x / 8) : (int)blockIdx.x; }
DI void p5a_gateup(const Params& P, char* lds) {
    moe_tables(P, lds);
    const LAS int* tstart = (const LAS int*)((LAS unsigned char*)lds + P5TAB_OFF);
    MoeOrder S{tstart, tstart + 260, (const char*)(P.ws + WS_H2), (const char*)(P.ws + WS_WEGU), (const int*)(P.ws + WS_BINS), tstart[256] * 2, 2, (int)gridDim.x, xcd_vb(), 0};
    EpiGateUp E{(bf16_t*)(P.ws + WS_HIDALL), (const float*)(P.ws + WS_BING)};
    pg8::gemm_phase<EpiGateUp, MoeOrder, true>((LAS unsigned char*)lds, 1024, S, E);
}
DI void p5b_down(const Params& P, char* lds) {
    const LAS int* tstart = (const LAS int*)((LAS unsigned char*)lds + P5TAB_OFF);
    MoeOrder S{tstart, tstart + 260, (const char*)(P.ws + WS_HIDALL), (const char*)(P.ws + WS_WED), (const int*)(P.ws + WS_BINS), tstart[256] * 4, 4, (int)gridDim.x, xcd_vb(), 1};
    EpiDown E{P.ws + WS_OUTA, P.ws + WS_OUTB};
    pg8::gemm_phase<EpiDown, MoeOrder, false>((LAS unsigned char*)lds, 256, S, E);
}

struct P6In { u32x4 w[8]; u32x4 zw0, zw1; f32x4 g[4]; };
DI void p6_combine(const Params& P, char* lds) {
    const LAS int* estart = (const LAS int*)((LAS unsigned char*)lds + P5TAB_OFF) + 260;
    const int tid = opaque_tid(), lane = tid & 63, wid = tid >> 6;
    const unsigned char* OA = P.ws + WS_OUTA; const unsigned char* OB = P.ws + WS_OUTB;
    auto load_pos = [&](int row) __attribute__((always_inline)) { int mp = 0; if (lane < 8) { const int e = ((const int*)(P.ws + WS_EIDX))[row * 8 + lane]; mp = estart[e] + ((const int*)(P.ws + WS_EPOS))[row * 8 + lane]; } return mp; };
    auto gather = [&](int row, int mypos, P6In& I) __attribute__((always_inline)) {
#pragma unroll
        for (int s = 0; s < 8; ++s) { const int pos = __builtin_amdgcn_readlane(mypos, s); I.w[s] = *(const u32x4*)((pos < T * 4 ? OA + (size_t)pos * 1024 : OB + (size_t)(pos - T * 4) * 1024) + lane * 16); }
        const bf16_t* zp = (const bf16_t*)(P.ws + WS_XZ) + (size_t)row * 1024 + 16 * lane; I.zw0 = *(const u32x4*)zp; I.zw1 = *(const u32x4*)(zp + 8);
        const float* ADA = (const float*)(P.ws + WS_ADA) + (row >> 13) * 6144 + 5120;
#pragma unroll
        for (int i = 0; i < 4; ++i) I.g[i] = *(const f32x4*)(ADA + 16 * lane + 4 * i);
    };
    const int S = gridDim.x * 8; int row = blockIdx.x * 8 + wid;
    if (row >= T) return;
    f32x4 lg[4], lb[4];
#pragma unroll
    for (int i = 0; i < 4; ++i) { lg[i] = *(const f32x4*)(P.ln2_g + 16 * lane + 4 * i); lb[i] = *(const f32x4*)(P.ln2_b + 16 * lane + 4 * i); }
    P6In nx; int pos_n;
    { const int p0 = load_pos(row); pos_n = load_pos(row + S < T ? row + S : row); gather(row, p0, nx); }
#pragma unroll 1
    for (; row < T; row += S) {
        const P6In cu = nx;
        const int rn = row + S < T ? row + S : row; gather(rn, pos_n, nx);
        pos_n = load_pos(rn + S < T ? rn + S : rn);
        float f[16];
#pragma unroll
        for (int i = 0; i < 16; ++i) f[i] = 0.f;
#pragma unroll
        for (int s = 0; s < 8; ++s)
#pragma unroll
            for (int q = 0; q < 4; ++q) { const f32x2 a = __builtin_amdgcn_cvt_pk_f32_fp8((int)cu.w[s][q], false), bb = __builtin_amdgcn_cvt_pk_f32_fp8((int)cu.w[s][q], true);
                f[4 * q] += a[0]; f[4 * q + 1] += a[1]; f[4 * q + 2] += bb[0]; f[4 * q + 3] += bb[1]; }
        float* op = P.out + (size_t)row * 1024 + 16 * lane; float z[16]; float sm = 0.f;
#pragma unroll
        for (int i = 0; i < 4; ++i) { const f32x4 g = cu.g[i]; const unsigned wa = (i < 2 ? cu.zw0 : cu.zw1)[2 * (i & 1)], wb = (i < 2 ? cu.zw0 : cu.zw1)[2 * (i & 1) + 1];
            const f32x4 zs = (f32x4){bflo(wa), bfhi(wa), bflo(wb), bfhi(wb)};
#pragma unroll
            for (int q = 0; q < 4; ++q) { const float v = zs[q] + g[q] * (f[4 * i + q] * (1.f / OUT_SCALE)); z[4 * i + q] = v; sm += v; } }
        const float mean = wave_sum(sm) * (1.f / 1024.f); float qv = 0.f;
#pragma unroll
        for (int i = 0; i < 16; ++i) { z[i] -= mean; qv += z[i] * z[i]; }
        const float rstd = rsqrtf(wave_sum(qv) * (1.f / 1024.f) + EPS);
#pragma unroll
        for (int i = 0; i < 4; ++i) { const f32x4 g = lg[i], bb = lb[i];
            *(f32x4*)(op + 4 * i) = (f32x4){z[4 * i] * rstd * g[0] + bb[0], z[4 * i + 1] * rstd * g[1] + bb[1], z[4 * i + 2] * rstd * g[2] + bb[2], z[4 * i + 3] * rstd * g[3] + bb[3]}; }
    }
}

__global__ void __launch_bounds__(NTHR) fwd_megakernel(Params P) {
    extern __shared__ __attribute__((aligned(16))) char lds[];
    volatile LAS unsigned* bst = (volatile LAS unsigned*)((LAS unsigned char*)lds + BARLDS_OFF);
    if (threadIdx.x < 2) bst[threadIdx.x] = 0u;
    __syncthreads();
    const XcdBarrier bar = xcd_barrier_post((unsigned*)(P.ws + WS_BAR), bst);
    p0_prologue(P, lds);
    xcd_barrier(bar);
    p1_inproj_and_experts(P, lds);
    xcd_barrier(bar);
    p2_mixer(P, lds);
    xcd_barrier(bar);
    p3a_ssm(P, lds);
    xcd_barrier(bar);
    p3b_glu(P, lds);
    xcd_barrier(bar);
    p3d_outproj(P, lds);
    xcd_barrier(bar);
    p3e_ln1(P);
    xcd_barrier(bar);
    p3f_router_shared(P, lds);
    xcd_barrier(bar);
    p3g_route_shared_down(P, lds);
    xcd_barrier(bar);
    p5a_gateup(P, lds);
    xcd_barrier(bar);
    p5b_down(P, lds);
    xcd_barrier(bar);
    p6_combine(P, lds);
}


#ifdef ANALYZE_PHASES
template <int PH> __global__ void __launch_bounds__(NTHR) phase_kernel(Params P) {
    extern __shared__ __attribute__((aligned(16))) char lds[];
    if (PH == 0) p0_prologue(P, lds);
    if (PH == 1) p1_inproj_and_experts(P, lds);
    if (PH == 2) p2_mixer(P, lds);
    if (PH == 3) p3a_ssm(P, lds);
    if (PH == 7) p3b_glu(P, lds);
    if (PH == 9) p3d_outproj(P, lds);
    if (PH == 10) p3e_ln1(P);
    if (PH == 11) p3f_router_shared(P, lds);
    if (PH == 12) p3g_route_shared_down(P, lds);
    if (PH == 4) p5a_gateup(P, lds);
    if (PH == 5) p5b_down(P, lds);
    if (PH == 6) p6_combine(P, lds);
}
template __global__ void phase_kernel<0>(Params); template __global__ void phase_kernel<1>(Params); template __global__ void phase_kernel<2>(Params); template __global__ void phase_kernel<3>(Params);
template __global__ void phase_kernel<4>(Params); template __global__ void phase_kernel<5>(Params); template __global__ void phase_kernel<6>(Params);
template __global__ void phase_kernel<7>(Params); template __global__ void phase_kernel<8>(Params); template __global__ void phase_kernel<9>(Params); template __global__ void phase_kernel<10>(Params); template __global__ void phase_kernel<11>(Params); template __global__ void phase_kernel<12>(Params);
#endif

extern "C" void kernel_launch(void* const* d_in, const int* in_sizes, int n_in, void* d_out, int out_size, void* d_ws, size_t ws_size, hipStream_t stream) {
    static int grid = 0;
    if (grid == 0) {
        if (n_in != 31 || out_size != T * D || ws_size < WS_END) { fprintf(stderr, "kernel_launch: unexpected problem (n_in %d, out %d, ws %zu < %zu)\n", n_in, out_size, ws_size, (size_t)WS_END); grid = -1; return; }
        int dev = 0, cus = 0, per_cu = 0;
        (void)hipGetDevice(&dev); (void)hipDeviceGetAttribute(&cus, hipDeviceAttributeMultiprocessorCount, dev);
        (void)hipFuncSetAttribute((const void*)fwd_megakernel, hipFuncAttributeMaxDynamicSharedMemorySize, LDS_BYTES);
        (void)hipOccupancyMaxActiveBlocksPerMultiprocessor(&per_cu, (const void*)fwd_megakernel, NTHR, LDS_BYTES);
        if (per_cu < 1) { fprintf(stderr, "kernel_launch: occupancy query says %d blocks per CU\n", per_cu); grid = -1; return; }
        grid = cus * 1;
        if (grid > 256) grid = 256;
    }
    if (grid < 0) return;
    (void)hipMemsetAsync(d_ws, 0, 65536, stream);
    Params p{};
    const float** pf = (const float**)&p;
    for (int i = 0; i < 31; ++i) pf[i] = (const float*)d_in[i];
    p.out = (float*)d_out; p.ws = (unsigned char*)d_ws;
    void* args[] = {&p};
    hipError_t e = hipLaunchCooperativeKernel((const void*)fwd_megakernel, dim3(grid), dim3(NTHR), args, LDS_BYTES, stream);
    if (e != hipSuccess) fprintf(stderr, "cooperative launch failed: %s (grid %d)\n", hipGetErrorString(e), grid);
}
```
